# Optimizing an MI355X kernel written in HIP

```python
import jax
import jax.numpy as jnp
from jax import lax
import numpy as np

D_MODEL = 2048
BATCH = 4
SEQ = 4096
DEPTH = 2

GRID_W = 64
CTX_LEN = 256
HEAD_DIM = 128
A_HEADS = 8
A_KV_HEADS = 2
WINDOW = 128
WBLK = 128
B_HEADS = 8
Q_LORA = 512
KV_LORA = 256
NOPE_DIM = 128
ROPE_DIM = 64
V_DIM = 128
QK_DIM = NOPE_DIM + ROPE_DIM
QBLK = 128
IN_SPLITS = (A_HEADS * HEAD_DIM, A_KV_HEADS * HEAD_DIM, A_KV_HEADS * HEAD_DIM, Q_LORA, KV_LORA, ROPE_DIM)
IN_WIDTH = sum(IN_SPLITS)
MIX_WIDTH = A_HEADS * HEAD_DIM + B_HEADS * V_DIM
F_GROUPS = 8
F_GROUP_DIM = D_MODEL // F_GROUPS
N_EXPERTS = 16
N_GROUPS = 4
EXP_PER_GROUP = N_EXPERTS // N_GROUPS
TOP_K = 2
D_EXPERT = 1024
MOE_BLK = 512
ROPE_BASE = 10000.0
EPS = 1e-6
F32 = jnp.float32

kernel_name = 'hybrid_swa_mla_fourier_moe_dit'


def rmsnorm(x, g):
    xf = x.astype(F32)
    y = xf * lax.rsqrt(jnp.mean(xf * xf, axis=-1, keepdims=True) + EPS)
    return y.astype(x.dtype) * g


def modulate(h, shift, scale):
    return h * (1 + scale) + shift


def rope_half(x, ang):
    cos = jnp.cos(ang)[None, :, None, :]
    sin = jnp.sin(ang)[None, :, None, :]
    x1, x2 = jnp.split(x.astype(F32), 2, axis=-1)
    return jnp.concatenate([x1 * cos - x2 * sin, x1 * sin + x2 * cos], axis=-1)


def axial_rope(x, row, col):
    half = x.shape[-1] // 2
    freqs = ROPE_BASE ** (-jnp.arange(0, half, 2, dtype=F32) / half)
    xr = rope_half(x[..., :half], row[:, None] * freqs[None, :])
    xc = rope_half(x[..., half:], col[:, None] * freqs[None, :])
    return jnp.concatenate([xr, xc], axis=-1).astype(x.dtype)


def dense_attn(q, k, v):
    s = jnp.einsum('bqhd,bkhd->bhqk', q, k).astype(F32) * (q.shape[-1] ** -0.5)
    p = jax.nn.softmax(s, axis=-1).astype(v.dtype)
    return jnp.einsum('bhqk,bkhd->bqhd', p, v)


def window_gqa(q, k, v, kc, vc, sink):
    B, S, Hq, dh = q.shape
    Hkv = k.shape[2]
    G = Hq // Hkv
    nb = S // WBLK
    C = kc.shape[1]
    L = 3 * WBLK
    scale = dh ** -0.5
    qb = q.reshape(B, nb, WBLK, Hkv, G, dh)

    def band(t):
        tp = jnp.pad(t, ((0, 0), (WBLK, WBLK), (0, 0), (0, 0))).reshape(B, nb + 2, WBLK, Hkv, dh)
        return jnp.concatenate([tp[:, :-2], tp[:, 1:-1], tp[:, 2:]], axis=2)

    kw, vw = band(k), band(v)
    s_loc = jnp.einsum('bnqkgd,bnskd->bnkgqs', qb, kw).astype(F32) * scale
    s_ctx = jnp.einsum('bnqkgd,bckd->bnkgqc', qb, kc).astype(F32) * scale
    blk = jnp.arange(nb)[:, None, None] * WBLK
    qpos = blk + jnp.arange(WBLK)[None, :, None]
    kpos = blk - WBLK + jnp.arange(L)[None, None, :]
    valid = (jnp.abs(qpos - kpos) <= WINDOW) & (kpos >= 0) & (kpos < S)
    s_loc = jnp.where(valid[None, :, None, None], s_loc, -jnp.inf)
    s_sink = jnp.broadcast_to(sink.astype(F32).reshape(Hkv, G)[None, None, :, :, None, None], s_loc.shape[:-1] + (1,))
    p = jax.nn.softmax(jnp.concatenate([s_loc, s_ctx, s_sink], axis=-1), axis=-1).astype(v.dtype)
    o = jnp.einsum('bnkgqs,bnskd->bnqkgd', p[..., :L], vw) + jnp.einsum('bnkgqc,bckd->bnqkgd', p[..., L:L + C], vc)
    return o.reshape(B, S, Hq, dh)


def ctx_gqa(qc, kc, vc, sink):
    B, C, Hq, dh = qc.shape
    Hkv = kc.shape[2]
    G = Hq // Hkv
    s = jnp.einsum('bqkgd,bckd->bkgqc', qc.reshape(B, C, Hkv, G, dh), kc).astype(F32) * (dh ** -0.5)
    s_sink = jnp.broadcast_to(sink.astype(F32).reshape(Hkv, G)[None, :, :, None, None], s.shape[:-1] + (1,))
    p = jax.nn.softmax(jnp.concatenate([s, s_sink], axis=-1), axis=-1).astype(vc.dtype)
    return jnp.einsum('bkgqc,bckd->bqkgd', p[..., :C], vc).reshape(B, C, Hq, dh)


def mla_attn(q, k, v, kc, vc):
    B, S, H, dq = q.shape
    nb = S // QBLK
    k_all = jnp.concatenate([kc, k], axis=1)
    v_all = jnp.concatenate([vc, v], axis=1)
    qb = jnp.moveaxis(q.reshape(B, nb, QBLK, H, dq), 1, 0)
    o = lax.map(lambda qblk: dense_attn(qblk, k_all, v_all), qb)
    return jnp.moveaxis(o, 0, 1).reshape(B, S, H, v.shape[-1])


def mixer_ab(h, hc, row, col, w_in, g_aqn, g_akn, g_bq_lat, w_bq_up, g_bkv_lat, w_bkv_up, g_bqn, g_bkn, sink, w_o, ctx_out):
    cuts = np.cumsum(IN_SPLITS)[:-1].tolist()

    def project(t, with_q):
        lead = t.shape[:2]
        aq, ak, av, bqd, bkvd, bkr = jnp.split(t @ w_in, cuts, axis=-1)
        ak = rmsnorm(ak.reshape(lead + (A_KV_HEADS, HEAD_DIM)), g_akn)
        av = av.reshape(lead + (A_KV_HEADS, HEAD_DIM))
        kv = (rmsnorm(bkvd, g_bkv_lat) @ w_bkv_up).reshape(lead + (B_HEADS, NOPE_DIM + V_DIM))
        k_rope = jnp.broadcast_to(bkr[:, :, None, :], lead + (B_HEADS, ROPE_DIM))
        bk = rmsnorm(jnp.concatenate([kv[..., :NOPE_DIM], k_rope], axis=-1), g_bkn)
        bv = kv[..., NOPE_DIM:]
        if not with_q:
            return None, ak, av, None, bk, bv
        aq = rmsnorm(aq.reshape(lead + (A_HEADS, HEAD_DIM)), g_aqn)
        bq = rmsnorm((rmsnorm(bqd, g_bq_lat) @ w_bq_up).reshape(lead + (B_HEADS, QK_DIM)), g_bqn)
        return aq, ak, av, bq, bk, bv

    def rope_tail(t):
        return jnp.concatenate([t[..., :NOPE_DIM], axial_rope(t[..., NOPE_DIM:], row, col)], axis=-1)

    aq, ak, av, bq, bk, bv = project(h, True)
    aq, ak = axial_rope(aq, row, col), axial_rope(ak, row, col)
    bq, bk = rope_tail(bq), rope_tail(bk)
    aqc, akc, avc, bqc, bkc, bvc = project(hc, ctx_out)
    B, S = h.shape[:2]
    ya = window_gqa(aq, ak, av, akc, avc, sink)
    yb = mla_attn(bq, bk, bv, bkc, bvc)
    y = jnp.concatenate([ya.reshape(B, S, -1), yb.reshape(B, S, -1)], axis=-1) @ w_o
    if not ctx_out:
        return y, None
    C = hc.shape[1]
    yac = ctx_gqa(aqc, akc, avc, sink)
    ybc = dense_attn(bqc, bkc, bvc)
    yc = jnp.concatenate([yac.reshape(B, C, -1), ybc.reshape(B, C, -1)], axis=-1) @ w_o
    return y, yc


def fourier_mix(h, w_fo, b_fo):
    B, S, D = h.shape
    hg = h.astype(F32).reshape(B, S, F_GROUPS, F_GROUP_DIM)
    f = jnp.fft.fft2(hg, axes=(1, 3), norm='ortho').real.astype(h.dtype).reshape(B, S, D)
    return f @ w_fo + b_fo


def moe_ffn(h, w_router, b_router, w_gate, w_up, w_down):
    T, D = h.shape
    aff = jax.nn.sigmoid(h.astype(F32) @ w_router.astype(F32))
    sel = aff + b_router.astype(F32)
    grp_score = lax.top_k(sel.reshape(T, N_GROUPS, EXP_PER_GROUP), 2)[0].sum(-1)
    grp = jnp.argmax(grp_score, axis=-1)
    in_grp = (jnp.arange(N_EXPERTS) // EXP_PER_GROUP)[None, :] == grp[:, None]
    _, idx = lax.top_k(jnp.where(in_grp, sel, -jnp.inf), TOP_K)
    wts = jnp.take_along_axis(aff, idx, axis=-1)
    wts = wts / jnp.sum(wts, axis=-1, keepdims=True)
    A = T * TOP_K
    e_flat = idx.reshape(-1)
    tok_flat = jnp.arange(A) // TOP_K
    w_flat = wts.reshape(-1)
    order = jnp.argsort(e_flat)
    e_sorted = e_flat[order]
    counts = jnp.bincount(e_flat, length=N_EXPERTS)
    padded = (counts + MOE_BLK - 1) // MOE_BLK * MOE_BLK
    pad_end = jnp.cumsum(padded)
    pad_start = pad_end - padded
    start = jnp.cumsum(counts) - counts
    dest = pad_start[e_sorted] + jnp.arange(A) - start[e_sorted]
    n_blocks = -(-A // MOE_BLK) + N_EXPERTS
    buf_tok = jnp.full((n_blocks * MOE_BLK,), T, jnp.int32).at[dest].set(tok_flat[order])
    buf_w = jnp.zeros((n_blocks * MOE_BLK,), F32).at[dest].set(w_flat[order])
    blk_e = jnp.minimum(jnp.searchsorted(pad_end, jnp.arange(n_blocks) * MOE_BLK, side='right'), N_EXPERTS - 1)
    h_pad = jnp.concatenate([h, jnp.zeros((1, D), h.dtype)], axis=0)
    xb = h_pad[buf_tok].reshape(n_blocks, MOE_BLK, D)

    def expert(args):
        xe, e = args
        return (jax.nn.silu(xe @ w_gate[e]) * (xe @ w_up[e])) @ w_down[e]

    yb = lax.map(expert, (xb, blk_e)).reshape(-1, D)
    y = jnp.zeros((T + 1, D), h.dtype).at[buf_tok].add(yb * buf_w[:, None].astype(yb.dtype))
    return y[:T]


def setup_inputs(seed: int = 0) -> dict:
    key = jax.random.key(seed)
    ks = jax.random.split(key, 25)
    n_attn = (DEPTH + 1) // 2
    n_four = DEPTH // 2
    D = D_MODEL

    def nrm(k, shape, fan_in, gain=1.0):
        return jax.random.normal(k, shape, F32) * (gain * fan_in ** -0.5)

    def gain(k, shape):
        return 1.0 + 0.05 * jax.random.normal(k, shape, F32)

    return {
        'x': jax.random.normal(ks[0], (BATCH, SEQ, D), F32),
        'c': jax.random.normal(ks[1], (BATCH, D), F32),
        'ctx': jax.random.normal(ks[2], (BATCH, CTX_LEN, D), F32),
        'c_ctx': jax.random.normal(ks[3], (D,), F32),
        'w_ada': nrm(ks[4], (DEPTH, D, 6 * D), D, 0.5),
        'b_ada': 0.02 * jax.random.normal(ks[5], (DEPTH, 6 * D), F32),
        'g_norm': gain(ks[6], (DEPTH, 2, D)),
        'w_in': nrm(ks[7], (n_attn, D, IN_WIDTH), D),
        'g_aqn': gain(ks[8], (n_attn, HEAD_DIM)),
        'g_akn': gain(ks[9], (n_attn, HEAD_DIM)),
        'g_bq_lat': gain(ks[10], (n_attn, Q_LORA)),
        'w_bq_up': nrm(ks[11], (n_attn, Q_LORA, B_HEADS * QK_DIM), Q_LORA),
        'g_bkv_lat': gain(ks[12], (n_attn, KV_LORA)),
        'w_bkv_up': nrm(ks[13], (n_attn, KV_LORA, B_HEADS * (NOPE_DIM + V_DIM)), KV_LORA),
        'g_bqn': gain(ks[14], (n_attn, QK_DIM)),
        'g_bkn': gain(ks[15], (n_attn, QK_DIM)),
        'sink': 0.5 * jax.random.normal(ks[16], (n_attn, A_HEADS), F32),
        'w_o_ab': nrm(ks[17], (n_attn, MIX_WIDTH, D), MIX_WIDTH),
        'w_fo': nrm(ks[18], (n_four, D, D), D),
        'b_fo': 0.02 * jax.random.normal(ks[19], (n_four, D), F32),
        'w_router': nrm(ks[20], (D, N_EXPERTS), D),
        'b_router': 0.01 * jax.random.normal(ks[21], (N_EXPERTS,), F32),
        'w_gate': nrm(ks[22], (DEPTH, N_EXPERTS, D, D_EXPERT), D),
        'w_up': nrm(ks[23], (DEPTH, N_EXPERTS, D, D_EXPERT), D),
        'w_down': nrm(ks[24], (DEPTH, N_EXPERTS, D_EXPERT, D), D_EXPERT),
    }


def reference(x, c, ctx, c_ctx, w_ada, b_ada, g_norm, w_in, g_aqn, g_akn, g_bq_lat, w_bq_up, g_bkv_lat, w_bkv_up, g_bqn, g_bkn, sink, w_o_ab, w_fo, b_fo, w_router, b_router, w_gate, w_up, w_down):
    B, S, D = x.shape
    rows = S // GRID_W
    row = jnp.repeat(jnp.arange(rows, dtype=F32), GRID_W)
    col = jnp.tile(jnp.arange(GRID_W, dtype=F32), rows)
    xc = ctx
    for l in range(DEPTH):
        is_attn = l % 2 == 0
        i = l // 2
        ctx_out = any(j % 2 == 0 for j in range(l + 1, DEPTH))
        mod = jnp.split(jax.nn.silu(c) @ w_ada[l] + b_ada[l], 6, axis=-1)
        sh_a, sc_a, gt_a, sh_m, sc_m, gt_m = [m[:, None, :] for m in mod]
        h = modulate(rmsnorm(x, g_norm[l, 0]), sh_a, sc_a)
        if is_attn or ctx_out:
            sh_ac, sc_ac, gt_ac, sh_mc, sc_mc, gt_mc = jnp.split(jax.nn.silu(c_ctx) @ w_ada[l] + b_ada[l], 6, axis=-1)
            hc = modulate(rmsnorm(xc, g_norm[l, 0]), sh_ac, sc_ac)
        if is_attn:
            y, yc = mixer_ab(h, hc, row, col, w_in[i], g_aqn[i], g_akn[i], g_bq_lat[i], w_bq_up[i], g_bkv_lat[i], w_bkv_up[i], g_bqn[i], g_bkn[i], sink[i], w_o_ab[i], ctx_out)
        else:
            y = fourier_mix(h, w_fo[i], b_fo[i])
            yc = fourier_mix(hc, w_fo[i], b_fo[i]) if ctx_out else None
        x = x + gt_a * y
        h2 = modulate(rmsnorm(x, g_norm[l, 1]), sh_m, sc_m)
        x = x + gt_m * moe_ffn(h2.reshape(B * S, D), w_router, b_router, w_gate[l], w_up[l], w_down[l]).reshape(B, S, D)
        if ctx_out:
            xc = xc + gt_ac * yc
            h2c = modulate(rmsnorm(xc, g_norm[l, 1]), sh_mc, sc_mc)
            xc = xc + gt_mc * moe_ffn(h2c.reshape(-1, D), w_router, b_router, w_gate[l], w_up[l], w_down[l]).reshape(xc.shape)
    return x
```

```cpp
#define MK_SINGLE 0
#define MK_LAST 21
#include <hip/hip_runtime.h>
#include <cstdio>
#include <cstdint>

#define LAS __attribute__((address_space(3)))
#define GAS __attribute__((address_space(1)))
typedef unsigned short bf16_t;
typedef short bf16x8 __attribute__((ext_vector_type(8)));
typedef short s16x4 __attribute__((ext_vector_type(4)));
typedef float f32x4 __attribute__((ext_vector_type(4)));
typedef float f32x2 __attribute__((ext_vector_type(2)));
typedef float f32x16 __attribute__((ext_vector_type(16)));
typedef unsigned u32x4 __attribute__((ext_vector_type(4)));
typedef unsigned u32x2 __attribute__((ext_vector_type(2)));

constexpr int DM = 2048, NB = 4, SEQ = 4096, T = NB * SEQ, CTX = 256, TC = NB * CTX, TT = T + TC, KVLEN = CTX + SEQ;
constexpr int INW = 2368, INWP = 2560, NE = 16, DE = 1024, APAD = 2 * T + NE * 256;
constexpr float EPS = 1e-6f;
constexpr int NWAVES = 8, NTHR = 512;

constexpr size_t MiB = 1u << 20;
constexpr size_t WS_CTL = 0, CTL_ZERO_BYTES = 1 * MiB;
constexpr size_t WS_MOD = 1 * MiB;
constexpr size_t WS_ROUTE = 2 * MiB;
constexpr size_t WS_WIN_T = 4 * MiB, WS_WBQ_T = 14 * MiB, WS_WBKV_T = 16 * MiB, WS_WO_T = 18 * MiB, WS_WFO_T = 26 * MiB, WS_WC = 34 * MiB, WS_KR = 35 * MiB;
constexpr size_t WS_WS = 38 * MiB, WS_WGU_T = 102 * MiB, WS_WD_T = 358 * MiB;
constexpr size_t WS_H = 486 * MiB, WS_RA = 554 * MiB, WS_RC = 714 * MiB, WS_RD = 790 * MiB, WS_END = 924 * MiB;
constexpr size_t WS_P = WS_RA, WS_BQ = WS_RA, WS_KV = WS_RA + 48 * MiB, WS_Y = WS_RA, WS_YS = WS_RA, WS_ZT = WS_RA;
constexpr size_t WS_QA = WS_RC, WS_KA = WS_RC + 32 * MiB, WS_VA = WS_RC + 41 * MiB, WS_BQL = WS_RC + 50 * MiB, WS_KVL = WS_RC + 66 * MiB, WS_F = WS_RC;
constexpr size_t WS_QB = WS_RD, WS_KB = WS_RD + 48 * MiB, WS_VB = WS_RD + 99 * MiB, WS_HS = WS_RD;
static_assert((size_t)TT * INWP * 2 <= 160 * MiB && (size_t)APAD * DM * 2 <= 160 * MiB && (size_t)NB * DM * 8192 * 2 <= 160 * MiB, "region A");
static_assert((size_t)T * 1536 * 2 <= 48 * MiB && WS_KV + (size_t)TT * DM * 2 <= WS_RC, "BQ/KV");
static_assert((size_t)T * 1024 * 2 <= 32 * MiB && (size_t)NB * 2 * KVLEN * 128 * 2 <= 9 * MiB && (size_t)T * 512 * 2 <= 16 * MiB && WS_KVL + (size_t)TT * 256 * 2 <= WS_RD, "region C");
static_assert((size_t)T * 1536 * 2 <= 48 * MiB && (size_t)NB * 8 * KVLEN * 192 * 2 <= 51 * MiB && WS_VB + (size_t)NB * 8 * KVLEN * 128 * 2 <= WS_END && (size_t)APAD * DE * 2 <= 134 * MiB, "region D");
static_assert((size_t)TT * DM * 2 <= 68 * MiB && (size_t)TT * 64 * 2 <= 3 * MiB, "H/KR");
constexpr int CW_BAR = 4096;
constexpr int CW_CNT = 8192;

constexpr int RING_BYTES = 131072;
constexpr int MISC_OFF = RING_BYTES + 320;
constexpr int LDS_BYTES = 147456;

#define RLX_AGENT __ATOMIC_RELAXED, __HIP_MEMORY_SCOPE_AGENT
#define LDS_WAIT() asm volatile("s_waitcnt lgkmcnt(0)" ::: "memory")
#define VM_WAIT() asm volatile("s_waitcnt vmcnt(0)" ::: "memory")
__device__ __forceinline__ unsigned f2bf(float f) { unsigned u = __builtin_bit_cast(unsigned, f); return (u + 0x7fffu + ((u >> 16) & 1u)) >> 16; }
__device__ __forceinline__ unsigned pk2(float lo, float hi) { return f2bf(lo) | (f2bf(hi) << 16); }
__device__ __forceinline__ float bf2f(unsigned b) { return __builtin_bit_cast(float, b << 16); }
__device__ __forceinline__ float bflo(unsigned w) { return __builtin_bit_cast(float, w << 16); }
__device__ __forceinline__ float bfhi(unsigned w) { return __builtin_bit_cast(float, w & 0xffff0000u); }
__device__ __forceinline__ unsigned cvt_pk_bf16(float lo, float hi) { unsigned r; asm volatile("v_cvt_pk_bf16_f32 %0, %1, %2" : "=v"(r) : "v"(lo), "v"(hi)); return r; }
__device__ __forceinline__ float wave_sum(float v) {
#pragma unroll
    for (int o = 1; o < 64; o <<= 1) v += __shfl_xor(v, o);
    return v;
}
__device__ __forceinline__ float half_sum(float v) {
#pragma unroll
    for (int o = 1; o < 32; o <<= 1) v += __shfl_xor(v, o);
    return v;
}
__device__ __forceinline__ float silu_f(float v) { return v / (1.0f + __expf(-v)); }

#define XB_TMO      128
#define XB_XCNT(j)  (256  + 64 * (j))
#define XB_XSUB(j)  (1280 + 64 * (j))
#define XB_XGEN(j)  (2304 + 64 * (j))
#define XB_TOP      3328
#define XB_TOPGEN   3392
#define XCD_BAR_WORDS 3456
#define XB_SPIN_CAP (1u << 18)
__device__ __forceinline__ unsigned xb_ld(unsigned* p)              { return __hip_atomic_load(p, __ATOMIC_RELAXED, __HIP_MEMORY_SCOPE_AGENT); }
__device__ __forceinline__ unsigned xb_add(unsigned* p, unsigned v) { return __hip_atomic_fetch_add(p, v, __ATOMIC_RELAXED, __HIP_MEMORY_SCOPE_AGENT); }
__device__ __forceinline__ unsigned xb_xcc_id() { return (unsigned)__builtin_amdgcn_s_getreg((3 << 11) | 20) & 0xFu; }
#define XB_SPIN(cond, bar) do { unsigned _sp = 0; while (cond) { __builtin_amdgcn_s_sleep(1); \
    if ((++_sp & 255u) == 0u) { if (xb_ld(&(bar)[XB_TMO])) break; if (_sp > XB_SPIN_CAP) { atomicAdd(&(bar)[XB_TMO], 1u); break; } } } } while (0)
struct XcdBarrier { unsigned* bar; unsigned x; volatile LAS unsigned* st; };
__device__ __forceinline__ XcdBarrier xcd_barrier_post(unsigned* bar, volatile LAS unsigned* st) {
    XcdBarrier b; b.bar = bar; b.x = xb_xcc_id(); b.st = st;
    if (threadIdx.x == 0) (void)xb_add(&bar[XB_XCNT(b.x)], 1u);
    return b;
}
__device__ __forceinline__ void xcd_barrier_complete(unsigned* bar, unsigned x, unsigned& nloc, unsigned& nx) {
    const unsigned G = gridDim.x * gridDim.y * gridDim.z;
    unsigned sum, cnt, mine, sp = 0u;
    for (;;) {
        sum = 0u; cnt = 0u; mine = 0u;
#pragma unroll
        for (unsigned j = 0; j < 16; ++j) { const unsigned c = xb_ld(&bar[XB_XCNT(j)]); sum += c; cnt += (c > 0u) ? 1u : 0u; mine = (j == x) ? c : mine; }
        if (sum == G) break;
        __builtin_amdgcn_s_sleep(1);
        if ((++sp & 255u) == 0u) { if (xb_ld(&bar[XB_TMO])) break; if (sp > XB_SPIN_CAP) { atomicAdd(&bar[XB_TMO], 1u); break; } }
    }
    nloc = mine > 0u ? mine : 1u; nx = cnt > 0u ? cnt : 1u;
}
__device__ __forceinline__ void xcd_barrier(const XcdBarrier& b) {
    asm volatile("s_waitcnt vmcnt(0)" ::: "memory");
    __syncthreads();
    if (threadIdx.x == 0) {
        unsigned* bar = b.bar;
        __builtin_amdgcn_s_waitcnt(0);
        unsigned nloc = b.st[0], nx = b.st[1];
        if (nloc == 0u) { xcd_barrier_complete(bar, b.x, nloc, nx); b.st[0] = nloc; b.st[1] = nx; }
        const unsigned old = xb_add(&bar[XB_XSUB(b.x)], 1u);
        const unsigned gen = old / nloc;
        if (old + 1u == (gen + 1u) * nloc) {
            __builtin_amdgcn_fence(__ATOMIC_RELEASE, "agent");
            asm volatile("s_waitcnt vmcnt(0)" ::: "memory");
            const unsigned og = xb_add(&bar[XB_TOP], 1u);
            const unsigned tg = og / nx;
            if (og + 1u == (tg + 1u) * nx) xb_add(&bar[XB_TOPGEN], 1u);
            else XB_SPIN(xb_ld(&bar[XB_TOPGEN]) == tg, bar);
            __builtin_amdgcn_fence(__ATOMIC_ACQUIRE, "agent");
            xb_add(&bar[XB_XGEN(b.x)], 1u);
            asm volatile("s_waitcnt vmcnt(0)" ::: "memory");
        } else {
            XB_SPIN(xb_ld(&bar[XB_XGEN(b.x)]) == gen, bar);
            __builtin_amdgcn_fence(__ATOMIC_ACQUIRE, "agent");
            asm volatile("s_waitcnt vmcnt(0)" ::: "memory");
        }
    }
    __syncthreads();
}
namespace pg8 {
constexpr int BM = 256, BK = 64, HALF = 128, HTB = HALF * BK * 2, STAGE_BYTES = 8 * HTB, NXCD = 8, WGM = 8;
__host__ __device__ __forceinline__ int lds_byte(int r, int c) { const int st = (r >> 4) * 2 + (c >> 5), rr = r & 15, cc = c & 31, ob = rr * 64 + cc * 2; return st * 1024 + (ob ^ (((ob >> 9) & 1) << 5)); }
__host__ __device__ __forceinline__ void stage_rc(int b, int& R, int& C) { const int st = b / 1024, sb = b % 1024, swz = sb ^ (((sb >> 9) & 1) << 5); R = (st >> 1) * 16 + swz / 64; C = (st & 1) * 32 + (swz % 64) / 2; }
__host__ __device__ __forceinline__ int perm32(int rho) { const int n = rho >> 4, i = rho & 15; return 8 * (i >> 2) + 4 * n + (i & 3); }

struct Unit { int pm, pn, aux; const char* A; const char* B; };

struct TileOrder {
    int nM, nN, nAux, nwg, G, c;
    __device__ __forceinline__ void init(int nM_, int nN_, int nAux_, int G_, int c_) { nM = nM_; nN = nN_; nAux = nAux_; nwg = nM * nN * nAux; G = G_; c = c_; }
    __device__ __forceinline__ bool map(int i, int& aux, int& pm, int& pn) const {
        const long L = (long)i * G + c; if (L >= nwg) return false;
        int wgid = (int)L; { const int q = nwg / NXCD, r = nwg % NXCD, xcd = wgid % NXCD, off = wgid / NXCD; wgid = (xcd < r ? xcd * (q + 1) : r * (q + 1) + (xcd - r) * q) + off; }
        const int per = nM * nN; aux = wgid / per; wgid -= aux * per;
        const int nig = WGM * nN, gid = wgid / nig, fm = gid * WGM, gsz = (nM - fm) < WGM ? (nM - fm) : WGM;
        pm = fm + ((wgid % nig) % gsz); pn = (wgid % nig) / gsz; return true;
    }
};
struct PlainSched {
    static constexpr bool GATHER = false;
    TileOrder o; const char* A0; const char* B0; size_t sA, sB, tA, tB;
    __device__ __forceinline__ void init(const void* A, const void* B, int lda, int ldb, int nM, int nN, int nAux, size_t sA_, size_t sB_, int G, int c) {
        o.init(nM, nN, nAux, G, c); A0 = (const char*)A; B0 = (const char*)B; sA = sA_; sB = sB_; tA = (size_t)BM * lda * 2; tB = (size_t)BM * ldb * 2; }
    __device__ __forceinline__ bool next(int i, Unit& u) const {
        if (!o.map(i, u.aux, u.pm, u.pn)) return false;
        u.A = A0 + (size_t)u.aux * sA + (size_t)u.pm * tA; u.B = B0 + (size_t)u.aux * sB + (size_t)u.pn * tB; return true; }
    __device__ __forceinline__ unsigned arow(const Unit&, int) const { return 0u; }
};

template <class Epi, class Sched>
__device__ __forceinline__ void gemm_phase(LAS unsigned char* lds, const int lda, const int ldb, const int K, const Sched& S, const Epi& E) {
    const int tid = threadIdx.x, wid = __builtin_amdgcn_readfirstlane(tid >> 6), lane = tid & 63, wr = wid >> 2, wc = wid & 3, fr = lane & 15, fq = lane >> 4;
    int K_o = K; asm volatile("" : "+s"(K_o));
    const int nt = K_o / BK;
    unsigned voffA[2], voffB[2]; int RA[2], CA2[2];
#pragma unroll
    for (int i = 0; i < 2; ++i) { int R, C; stage_rc(tid * 16 + i * 8192, R, C); const int Rb = Epi::PERM ? ((R & ~31) + perm32(R & 31)) : R;
        RA[i] = R; CA2[i] = C * 2; voffA[i] = (unsigned)(R * lda + C) * 2u; voffB[i] = (unsigned)(Rb * ldb + C) * 2u; }
    const size_t kstep = (size_t)(BK * 2);
    const size_t hstepA = (size_t)HALF * lda * 2, hstepB = (size_t)HALF * ldb * 2;
    const unsigned ldsw = (unsigned)wid * 1024u;
    const int aoff = lds_byte(wr * 64 + fr, fq * 8), boff = lds_byte(wc * 32 + fr, fq * 8);
#define PG8_SA(b, h) (((b) * 2 + (h)) * HTB)
#define PG8_SB(b, h) ((4 + (b) * 2 + (h)) * HTB)
#define PG8_STAGE(bufoff, gbase, voff) do { _Pragma("unroll") for (int _i = 0; _i < 2; ++_i) \
        __builtin_amdgcn_global_load_lds((const unsigned*)((const char*)(gbase) + (voff)[_i]), (LAS unsigned*)(lds + (bufoff) + ldsw + _i * 8192), 16, 0, 0); } while (0)
#define PG8_LDA(dst, b, h) do { _Pragma("unroll") for (int m = 0; m < 4; ++m) _Pragma("unroll") for (int k = 0; k < 2; ++k) dst[m][k] = *(const LAS bf16x8*)(lds + PG8_SA(b, h) + aoff + m * 2048 + k * 1024); } while (0)
#define PG8_LDB(dst, b, h) do { _Pragma("unroll") for (int n = 0; n < 2; ++n) _Pragma("unroll") for (int k = 0; k < 2; ++k) dst[n][k] = *(const LAS bf16x8*)(lds + PG8_SB(b, h) + boff + n * 2048 + k * 1024); } while (0)
#define PG8_MMA(ai, bj, At, Bt) do { __builtin_amdgcn_s_setprio(1); _Pragma("unroll") for (int m = 0; m < 4; ++m) _Pragma("unroll") for (int n = 0; n < 2; ++n) _Pragma("unroll") for (int k = 0; k < 2; ++k) \
        acc[ai][bj][m][n] = __builtin_amdgcn_mfma_f32_16x16x32_bf16(Bt[n][k], At[m][k], acc[ai][bj][m][n], 0, 0, 0); __builtin_amdgcn_s_setprio(0); } while (0)
#define PG8_WAIT_V(n) asm volatile("s_waitcnt vmcnt(" #n ")" ::: "memory")
#define PG8_WAIT_L(n) asm volatile("s_waitcnt lgkmcnt(" #n ")" ::: "memory")
#define PG8_BAR __builtin_amdgcn_s_barrier()
#define PG8_SCHED __builtin_amdgcn_sched_barrier(0)
    Unit cur, nxt; int ui = 0;
    if (!S.next(0, cur)) return;
    f32x4 acc[2][2][4][2];
#pragma unroll
    for (int a = 0; a < 2; ++a)
#pragma unroll
        for (int b = 0; b < 2; ++b)
#pragma unroll
            for (int m = 0; m < 4; ++m)
#pragma unroll
                for (int n = 0; n < 2; ++n) acc[a][b][m][n] = (f32x4){0.f, 0.f, 0.f, 0.f};
    bf16x8 At[4][2], B0[2][2], B1[2][2];
    const char* cA = cur.A; const char* cB = cur.B;
    unsigned voA0[2], voA1[2], vnA0[2], vnA1[2];
    if constexpr (Sched::GATHER) {
#pragma unroll
        for (int i = 0; i < 2; ++i) { voA0[i] = S.arow(cur, RA[i]) * (unsigned)(lda * 2) + (unsigned)CA2[i]; voA1[i] = S.arow(cur, HALF + RA[i]) * (unsigned)(lda * 2) + (unsigned)CA2[i]; vnA0[i] = voA0[i]; vnA1[i] = voA1[i]; }
    }
    if constexpr (Sched::GATHER) {
        PG8_STAGE(PG8_SB(0, 0), cB, voffB); PG8_STAGE(PG8_SB(0, 1), cB + hstepB, voffB); PG8_STAGE(PG8_SA(0, 0), cA, voA0); PG8_STAGE(PG8_SA(0, 1), cA, voA1);
        if (wr == 1) PG8_BAR;
        PG8_WAIT_V(2); PG8_BAR;
        PG8_STAGE(PG8_SB(1, 0), cB + kstep, voffB); PG8_STAGE(PG8_SA(1, 0), cA + kstep, voA0); PG8_STAGE(PG8_SB(1, 1), cB + hstepB + kstep, voffB);
        PG8_WAIT_V(6); PG8_BAR;
    } else {
        PG8_STAGE(PG8_SB(0, 0), cB, voffB); PG8_STAGE(PG8_SB(0, 1), cB + hstepB, voffB); PG8_STAGE(PG8_SA(0, 0), cA, voffA); PG8_STAGE(PG8_SA(0, 1), cA + hstepA, voffA);
        if (wr == 1) PG8_BAR;
        PG8_WAIT_V(2); PG8_BAR;
        PG8_STAGE(PG8_SB(1, 0), cB + kstep, voffB); PG8_STAGE(PG8_SA(1, 0), cA + kstep, voffA); PG8_STAGE(PG8_SB(1, 1), cB + hstepB + kstep, voffB);
        PG8_WAIT_V(6); PG8_BAR;
    }
    for (;;) {
        const bool has_next = S.next(ui + 1, nxt);
        const char* nA = has_next ? nxt.A : cA; const char* nB = has_next ? nxt.B : cB;
        if constexpr (Sched::GATHER) {
            if (has_next) {
#pragma unroll
                for (int i = 0; i < 2; ++i) { vnA0[i] = S.arow(nxt, RA[i]) * (unsigned)(lda * 2) + (unsigned)CA2[i]; vnA1[i] = S.arow(nxt, HALF + RA[i]) * (unsigned)(lda * 2) + (unsigned)CA2[i]; }
            } else {
#pragma unroll
                for (int i = 0; i < 2; ++i) { vnA0[i] = voA0[i]; vnA1[i] = voA1[i]; }
            }
        }
        for (int t = 0; t < nt; t += 2) {
            const bool last = (t == nt - 2);
            const char* a1 = cA + (size_t)(t + 1) * kstep;
            const char* a2 = last ? nA : cA + (size_t)(t + 2) * kstep; const char* b2 = last ? nB : cB + (size_t)(t + 2) * kstep;
            const char* a3 = a2 + kstep; const char* b3 = b2 + kstep;
            unsigned o20[2], o21[2];
            if constexpr (Sched::GATHER) {
#pragma unroll
                for (int i = 0; i < 2; ++i) { o20[i] = last ? vnA0[i] : voA0[i]; o21[i] = last ? vnA1[i] : voA1[i]; }
            }
            PG8_LDB(B0, 0, 0); PG8_LDB(B1, 0, 1); PG8_SCHED; PG8_LDA(At, 0, 0);
            if constexpr (Sched::GATHER) { PG8_STAGE(PG8_SA(1, 1), a1, voA1); } else { PG8_STAGE(PG8_SA(1, 1), a1 + hstepA, voffA); }
            PG8_WAIT_V(8); PG8_WAIT_L(0); PG8_BAR; PG8_MMA(0, 0, At, B0); PG8_MMA(0, 1, At, B1); PG8_BAR; PG8_SCHED;
            PG8_LDA(At, 0, 1); PG8_STAGE(PG8_SB(0, 0), b2, voffB); PG8_STAGE(PG8_SB(0, 1), b2 + hstepB, voffB);
            if constexpr (Sched::GATHER) { PG8_STAGE(PG8_SA(0, 0), a2, o20); } else { PG8_STAGE(PG8_SA(0, 0), a2, voffA); }
            PG8_WAIT_V(8); PG8_WAIT_L(0); PG8_BAR; PG8_MMA(1, 0, At, B0); PG8_MMA(1, 1, At, B1); PG8_BAR; PG8_SCHED;
            PG8_LDB(B0, 1, 0); PG8_LDB(B1, 1, 1); PG8_SCHED; PG8_LDA(At, 1, 0);
            if constexpr (Sched::GATHER) { PG8_STAGE(PG8_SA(0, 1), a2, o21); } else { PG8_STAGE(PG8_SA(0, 1), a2 + hstepA, voffA); }
            PG8_WAIT_V(8); PG8_WAIT_L(0); PG8_BAR; PG8_MMA(0, 0, At, B0); PG8_MMA(0, 1, At, B1); PG8_BAR; PG8_SCHED;
            PG8_LDA(At, 1, 1); PG8_STAGE(PG8_SB(1, 0), b3, voffB); PG8_STAGE(PG8_SB(1, 1), b3 + hstepB, voffB);
            if constexpr (Sched::GATHER) { PG8_STAGE(PG8_SA(1, 0), a3, o20); } else { PG8_STAGE(PG8_SA(1, 0), a3, voffA); }
            PG8_WAIT_V(8); PG8_WAIT_L(0); PG8_BAR; PG8_MMA(1, 0, At, B0); PG8_MMA(1, 1, At, B1); PG8_BAR; PG8_SCHED;
        }
        if (wr == 0) PG8_BAR;
        E(acc, cur, wr, wc, fr, fq);
        if (!has_next) break;
#pragma unroll
        for (int a = 0; a < 2; ++a)
#pragma unroll
            for (int b = 0; b < 2; ++b)
#pragma unroll
                for (int m = 0; m < 4; ++m)
#pragma unroll
                    for (int n = 0; n < 2; ++n) acc[a][b][m][n] = (f32x4){0.f, 0.f, 0.f, 0.f};
        cur = nxt; cA = nA; cB = nB; ++ui;
        if constexpr (Sched::GATHER) {
#pragma unroll
            for (int i = 0; i < 2; ++i) { voA0[i] = vnA0[i]; voA1[i] = vnA1[i]; }
        }
        if (wr == 1) PG8_BAR;
    }
    PG8_WAIT_V(0);
    PG8_BAR;
#undef PG8_SA
#undef PG8_SB
#undef PG8_STAGE
#undef PG8_LDA
#undef PG8_LDB
#undef PG8_MMA
#undef PG8_WAIT_V
#undef PG8_WAIT_L
#undef PG8_BAR
#undef PG8_SCHED
}

struct EpiBf16 {
    static constexpr bool PERM = true;
    bf16_t* O; int ldc; float scale; size_t aux_stride;
    __device__ __forceinline__ void operator()(const f32x4 (&acc)[2][2][4][2], const Unit& u, int wr, int wc, int fr, int fq) const {
        const int row0 = u.pm * BM + wr * 64 + fr, col0 = u.pn * BM + wc * 32 + 8 * fq; bf16_t* base = O + (size_t)u.aux * aux_stride;
#pragma unroll
        for (int ai = 0; ai < 2; ++ai)
#pragma unroll
            for (int m = 0; m < 4; ++m) { bf16_t* rowp = base + (size_t)(row0 + ai * HALF + m * 16) * ldc + col0;
#pragma unroll
                for (int bj = 0; bj < 2; ++bj) { const f32x4 v0 = acc[ai][bj][m][0] * scale, v1 = acc[ai][bj][m][1] * scale;
                    u32x4 w; w.x = cvt_pk_bf16(v0[0], v0[1]); w.y = cvt_pk_bf16(v0[2], v0[3]); w.z = cvt_pk_bf16(v1[0], v1[1]); w.w = cvt_pk_bf16(v1[2], v1[3]);
                    *(u32x4*)(rowp + bj * HALF) = w; } }
    }
};
struct EpiSwiGLU {
    static constexpr bool PERM = true;
    bf16_t* O; int ldc;
    __device__ __forceinline__ void operator()(const f32x4 (&acc)[2][2][4][2], const Unit& u, int wr, int wc, int fr, int fq) const {
        const int row0 = u.pm * BM + wr * 64 + fr, col0 = u.pn * HALF + wc * 32 + 8 * fq;
#pragma unroll
        for (int ai = 0; ai < 2; ++ai)
#pragma unroll
            for (int m = 0; m < 4; ++m) { bf16_t* rowp = O + (size_t)(row0 + ai * HALF + m * 16) * ldc + col0;
                f32x4 h0, h1;
#pragma unroll
                for (int j = 0; j < 4; ++j) { const float g0 = acc[ai][0][m][0][j], g1 = acc[ai][0][m][1][j];
                    h0[j] = g0 * __builtin_amdgcn_rcpf(1.0f + __expf(-g0)) * acc[ai][1][m][0][j]; h1[j] = g1 * __builtin_amdgcn_rcpf(1.0f + __expf(-g1)) * acc[ai][1][m][1][j]; }
                u32x4 w; w.x = cvt_pk_bf16(h0[0], h0[1]); w.y = cvt_pk_bf16(h0[2], h0[3]); w.z = cvt_pk_bf16(h1[0], h1[1]); w.w = cvt_pk_bf16(h1[2], h1[3]);
                *(u32x4*)rowp = w; }
    }
};
struct EpiResGate {
    static constexpr bool PERM = false;
    const float* xin; float* out; const float* gate; int gstride; const float* bias;
    __device__ __forceinline__ void operator()(const f32x4 (&acc)[2][2][4][2], const Unit& u, int wr, int wc, int fr, int fq) const {
        const int row0 = u.pm * BM + wr * 64 + fr, col0 = u.pn * BM + wc * 32 + 4 * fq;
        const float* gp = gate + (size_t)((u.pm * BM) / SEQ) * gstride + col0;
        f32x4 gv[2][2], bv[2][2];
#pragma unroll
        for (int bj = 0; bj < 2; ++bj)
#pragma unroll
            for (int n = 0; n < 2; ++n) { gv[bj][n] = *(const f32x4*)(gp + bj * HALF + n * 16); bv[bj][n] = bias ? *(const f32x4*)(bias + col0 + bj * HALF + n * 16) : (f32x4){0.f, 0.f, 0.f, 0.f}; }
#pragma unroll
        for (int ai = 0; ai < 2; ++ai)
#pragma unroll
            for (int m = 0; m < 4; ++m) { const size_t off = (size_t)(row0 + ai * HALF + m * 16) * DM + col0;
#pragma unroll
                for (int bj = 0; bj < 2; ++bj)
#pragma unroll
                    for (int n = 0; n < 2; ++n) { const f32x4 xv = *(const f32x4*)(xin + off + bj * HALF + n * 16);
                        *(f32x4*)(out + off + bj * HALF + n * 16) = xv + gv[bj][n] * (acc[ai][bj][m][n] + bv[bj][n]); } }
    }
};
struct EpiChanDFT {
    static constexpr bool PERM = true;
    bf16_t* ZT;
    __device__ __forceinline__ void operator()(const f32x4 (&acc)[2][2][4][2], const Unit& u, int wr, int wc, int fr, int fq) const {
        const int tok0 = u.pn * BM, b = tok0 / SEQ, s0 = tok0 % SEQ + wc * 32 + 8 * fq;
        const unsigned base = (unsigned)((b * DM + u.aux * 256 + wr * 64 + fr) * 8192 + u.pm * 4096 + s0);
#pragma unroll
        for (int ai = 0; ai < 2; ++ai)
#pragma unroll
            for (int m = 0; m < 4; ++m)
#pragma unroll
                for (int bj = 0; bj < 2; ++bj) { const f32x4 v0 = acc[ai][bj][m][0], v1 = acc[ai][bj][m][1];
                    u32x4 w; w.x = cvt_pk_bf16(v0[0], v0[1]); w.y = cvt_pk_bf16(v0[2], v0[3]); w.z = cvt_pk_bf16(v1[0], v1[1]); w.w = cvt_pk_bf16(v1[2], v1[3]);
                    *(u32x4*)(ZT + (base + (unsigned)((ai * HALF + m * 16) * 8192 + bj * HALF))) = w; }
    }
};
}
namespace att {
constexpr int NW = 8, QBLK = 32, KVBLK = 64, DV = 128;
constexpr float THR = 8.f;
#define SBAR() __builtin_amdgcn_sched_barrier(0)
__device__ __forceinline__ int crow(int r, int hi) { return (r & 3) + 8 * (r >> 2) + 4 * hi; }
__device__ __forceinline__ int v_st(int k, int c) { const int kk = (k & ~0xC) | ((k & 4) << 1) | ((k & 8) >> 1); return ((kk >> 3) * 4 + (c >> 5)) * 512 + ((kk & 7) * 32 + (c & 31)) * 2; }
__device__ __forceinline__ int v_rd_base(int lane) { return ((lane & 3) << 3) | (((lane >> 2) & 3) << 6) | (((lane >> 4) & 1) << 5) | (((lane >> 5) & 1) << 8); }
constexpr int v_rd_off(int d0, int ks, int half) { return d0 * 512 + ks * 4096 + half * 2048; }
template <int OFF> __device__ __forceinline__ s16x4 tr_read(int vb) {
  s16x4 r; asm volatile("ds_read_b64_tr_b16 %0, %1 offset:%2" : "=&v"(r) : "v"(vb), "i"(OFF) : "memory"); return r;
}
template <int D0> __device__ __forceinline__ void pv_one(f32x16& od, int vb, bf16x8 pa0, bf16x8 pa1, bf16x8 pa2, bf16x8 pa3) {
  const s16x4 l0 = tr_read<v_rd_off(D0, 0, 0)>(vb), h0 = tr_read<v_rd_off(D0, 0, 1)>(vb), l1 = tr_read<v_rd_off(D0, 1, 0)>(vb), h1 = tr_read<v_rd_off(D0, 1, 1)>(vb);
  const s16x4 l2 = tr_read<v_rd_off(D0, 2, 0)>(vb), h2 = tr_read<v_rd_off(D0, 2, 1)>(vb), l3 = tr_read<v_rd_off(D0, 3, 0)>(vb), h3 = tr_read<v_rd_off(D0, 3, 1)>(vb);
  asm volatile("s_waitcnt lgkmcnt(0)" ::: "memory"); SBAR();
#define PK(L, H) (bf16x8){L[0], L[1], L[2], L[3], H[0], H[1], H[2], H[3]}
  od = __builtin_amdgcn_mfma_f32_32x32x16_bf16(pa0, PK(l0, h0), od, 0, 0, 0);
  od = __builtin_amdgcn_mfma_f32_32x32x16_bf16(pa1, PK(l1, h1), od, 0, 0, 0);
  od = __builtin_amdgcn_mfma_f32_32x32x16_bf16(pa2, PK(l2, h2), od, 0, 0, 0);
  od = __builtin_amdgcn_mfma_f32_32x32x16_bf16(pa3, PK(l3, h3), od, 0, 0, 0);
#undef PK
}
__device__ __forceinline__ void pv_d0(f32x16* o, int vb, bf16x8 pa0, bf16x8 pa1, bf16x8 pa2, bf16x8 pa3) {
  pv_one<0>(o[0], vb, pa0, pa1, pa2, pa3); pv_one<1>(o[1], vb, pa0, pa1, pa2, pa3); pv_one<2>(o[2], vb, pa0, pa1, pa2, pa3); pv_one<3>(o[3], vb, pa0, pa1, pa2, pa3);
}
template <int DK>
__device__ __forceinline__ void partialSM(f32x16& p0, f32x16& p1, float& m_reg, float& mn, float& alpha, bool masked, int dq, int hi) {
  constexpr float SCALE = (DK == 128) ? 0.088388347648318440f : 0.072168783648703220f;
  constexpr float C = SCALE * 1.4426950408889634f;
  if (masked) {
#pragma unroll
    for (int r = 0; r < 16; ++r) { const int d0 = dq - crow(r, hi), d1 = d0 - 32;
      p0[r] = (d0 <= 128 && d0 >= -128) ? p0[r] : -1e30f; p1[r] = (d1 <= 128 && d1 >= -128) ? p1[r] : -1e30f; }
  }
  float pmax = p0[0];
#pragma unroll
  for (int r = 1; r < 16; ++r) pmax = fmaxf(pmax, p0[r]);
#pragma unroll
  for (int r = 0; r < 16; ++r) pmax = fmaxf(pmax, p1[r]);
  { auto rr = __builtin_amdgcn_permlane32_swap(__float_as_uint(pmax), __float_as_uint(pmax), false, false);
    pmax = fmaxf(__uint_as_float(rr[0]), __uint_as_float(rr[1])); }
  if (__builtin_expect(__all(pmax - m_reg <= THR / SCALE), 1)) { mn = m_reg; alpha = 1.f; }
  else { mn = fmaxf(m_reg, pmax); alpha = __builtin_amdgcn_exp2f((m_reg - mn) * C); m_reg = mn; }
  const float mnC = -mn * C;
#pragma unroll
  for (int r = 0; r < 16; ++r) p0[r] = fmaf(p0[r], C, mnC);
#pragma unroll
  for (int r = 0; r < 16; ++r) p1[r] = fmaf(p1[r], C, mnC);
#pragma unroll
  for (int r = 0; r < 16; ++r) p0[r] = __builtin_amdgcn_exp2f(p0[r]);
}
__device__ __forceinline__ void finishSM(f32x16& p0, f32x16& p1, float alpha, float& l_reg, bf16x8& pa0, bf16x8& pa1, bf16x8& pa2, bf16x8& pa3) {
#pragma unroll
  for (int r = 0; r < 16; ++r) p1[r] = __builtin_amdgcn_exp2f(p1[r]);
  float ps = 0;
#pragma unroll
  for (int r = 0; r < 16; ++r) ps += p0[r];
#pragma unroll
  for (int r = 0; r < 16; ++r) ps += p1[r];
  { auto rr = __builtin_amdgcn_permlane32_swap(__float_as_uint(ps), __float_as_uint(ps), false, false);
    ps = __uint_as_float(rr[0]) + __uint_as_float(rr[1]); }
  l_reg = l_reg * alpha + ps;
#define PK4(P, BASE, OUT) do { unsigned a0 = cvt_pk_bf16(P[BASE + 0], P[BASE + 1]), a1 = cvt_pk_bf16(P[BASE + 2], P[BASE + 3]);   \
    unsigned b0 = cvt_pk_bf16(P[BASE + 4], P[BASE + 5]), b1 = cvt_pk_bf16(P[BASE + 6], P[BASE + 7]);                              \
    auto r0 = __builtin_amdgcn_permlane32_swap(a0, b0, false, false); auto r1 = __builtin_amdgcn_permlane32_swap(a1, b1, false, false); \
    u32x4 w = {r0[0], r1[0], r0[1], r1[1]}; OUT = *reinterpret_cast<bf16x8*>(&w); } while (0)
  PK4(p0, 0, pa0); PK4(p0, 8, pa1); PK4(p1, 0, pa2); PK4(p1, 8, pa3);
#undef PK4
}
template <int DK> __device__ __forceinline__ int kswz(int row, int colB) { return row * (DK * 2) + (colB ^ ((row & 7) << 4)); }
template <int DK>
__device__ __forceinline__ void qkt(f32x16& p0, f32x16& p1, const char* Ks, const bf16x8* qr, int r32, int hi) {
  p0 = f32x16{}; p1 = f32x16{};
#pragma unroll
  for (int d0 = 0; d0 < DK / 16; ++d0) { const int cb = (d0 * 16 + hi * 8) * 2;
    const bf16x8 b0 = *reinterpret_cast<const bf16x8*>(Ks + kswz<DK>(r32, cb));
    const bf16x8 b1 = *reinterpret_cast<const bf16x8*>(Ks + kswz<DK>(32 + r32, cb));
    p0 = __builtin_amdgcn_mfma_f32_32x32x16_bf16(b0, qr[d0], p0, 0, 0, 0);
    p1 = __builtin_amdgcn_mfma_f32_32x32x16_bf16(b1, qr[d0], p1, 0, 0, 0);
    if ((d0 & 3) == 3) SBAR(); }
}

template <int DK, bool WINDOW>
__device__ __forceinline__ void attn_unit(const bf16_t* __restrict__ Qb, int ldq, const bf16_t* __restrict__ Kh, const bf16_t* __restrict__ Vh, bf16_t* __restrict__ Ob, int ldo,
                                          int NT, int ks, int q0, float sink, char* lds) {
  constexpr float SCALE = (DK == 128) ? 0.088388347648318440f : 0.072168783648703220f;
  constexpr int SHM_K = KVBLK * DK * 2, SHM_V = KVBLK * DV * 2, NKC = DK / 64, KCH = DK / 8;
  int tid_o = threadIdx.x; asm volatile("" : "+v"(tid_o));
  const int tid = tid_o, wid = tid >> 6, lane = tid & 63, r32 = lane & 31, hi = lane >> 5;
  char* V_lds = lds; char* K_lds = lds + 2 * SHM_V;
  float* ws = (float*)(lds + 2 * SHM_V + 2 * SHM_K) + wid * 64; float* li_l = ws; float* al_l = ws + 32;
  float m_reg = WINDOW ? sink / SCALE : -1e30f, l_reg = WINDOW ? 1.f : 0.f;
  f32x16 o[4] = {}; bf16x8 qr[DK / 16];
  const bf16_t* Qw = Qb + (long)(wid * QBLK + r32) * ldq + hi * 8;
#pragma unroll
  for (int d0 = 0; d0 < DK / 16; ++d0) qr[d0] = *reinterpret_cast<const bf16x8*>(Qw + d0 * 16);
  const int sr = tid >> 4, sc = (tid & 15) * 8, vst0 = v_st(sr, sc), vst1 = v_st(32 + sr, sc);
  int krow[NKC], kcc[NKC];
#pragma unroll
  for (int i = 0; i < NKC; ++i) { const int c = tid + 512 * i; krow[i] = c / KCH; kcc[i] = c % KCH; }
  const int vb0 = (int)(uintptr_t)V_lds + v_rd_base(lane);
  const int qpos = q0 + wid * QBLK + r32;
  bf16x8 vs0, vs1, ksr[NKC];
#define TROW(j) (64 * (j) + ((WINDOW && (j) >= 4) ? ks : 0))
#define SLOAD(j) do { const long _k0 = TROW(j); vs0 = *reinterpret_cast<const bf16x8*>(&Vh[(_k0 + sr) * DV + sc]); vs1 = *reinterpret_cast<const bf16x8*>(&Vh[(_k0 + 32 + sr) * DV + sc]); \
    _Pragma("unroll") for (int _i = 0; _i < NKC; ++_i) ksr[_i] = *reinterpret_cast<const bf16x8*>(&Kh[(_k0 + krow[_i]) * DK + kcc[_i] * 8]); } while (0)
#define SWRITE(b) do { *(bf16x8*)(V_lds + (b) * SHM_V + vst0) = vs0; *(bf16x8*)(V_lds + (b) * SHM_V + vst1) = vs1; \
    _Pragma("unroll") for (int _i = 0; _i < NKC; ++_i) *(bf16x8*)(K_lds + (b) * SHM_K + kswz<DK>(krow[_i], kcc[_i] * 16)) = ksr[_i]; } while (0)
#define SWAIT() asm volatile("s_waitcnt vmcnt(0)" ::: "memory")
#define RESC(a) do { if (__any((a) < 1.f)) { if (hi == 0) al_l[r32] = (a); asm volatile("s_waitcnt lgkmcnt(0)" ::: "memory"); \
    _Pragma("unroll") for (int d = 0; d < 4; ++d) _Pragma("unroll") for (int r = 0; r < 16; ++r) o[d][r] *= al_l[crow(r, hi)]; } } while (0)
#define MASKED(j) (WINDOW && (j) >= 4)
#define DQ(j) (qpos - (ks + 64 * ((j) - 4)))
  f32x16 p0, p1; float mn, al; bf16x8 pa0, pa1, pa2, pa3;
  SLOAD(0); SWAIT(); SWRITE(0); __syncthreads();
  for (int j = 0; j < NT; ++j) {
    const int bsel = j & 1;
    if (j + 1 < NT) SLOAD(j + 1);
    SBAR(); qkt<DK>(p0, p1, K_lds + bsel * SHM_K, qr, r32, hi);
    partialSM<DK>(p0, p1, m_reg, mn, al, MASKED(j), DQ(j), hi);
    RESC(al);
    finishSM(p0, p1, al, l_reg, pa0, pa1, pa2, pa3); SBAR();
    pv_d0(o, vb0 + bsel * SHM_V, pa0, pa1, pa2, pa3);
    if (j + 1 < NT) { SWAIT(); SWRITE(bsel ^ 1); }
    __syncthreads();
  }
  if (hi == 0) li_l[r32] = l_reg; asm volatile("s_waitcnt lgkmcnt(0)" ::: "memory");
  float rli[16];
#pragma unroll
  for (int r = 0; r < 16; ++r) rli[r] = __builtin_amdgcn_rcpf(li_l[crow(r, hi)]);
  bf16_t* Ow = Ob + (long)(wid * QBLK) * ldo;
#pragma unroll
  for (int r = 0; r < 16; ++r) { const int orow = crow(r, hi);
#pragma unroll
    for (int d0 = 0; d0 < 4; ++d0) Ow[(long)orow * ldo + d0 * 32 + r32] = (bf16_t)f2bf(o[d0][r] * rli[r]); }
  __syncthreads();
#undef TROW
#undef SLOAD
#undef SWRITE
#undef SWAIT
#undef RESC
#undef MASKED
#undef DQ
}
}
struct Frame {
    LAS unsigned char* lds; volatile LAS unsigned* MISC; unsigned* ctl;
    int tid, lane, wave, vcu, G;
    const float *x, *c, *ctx, *c_ctx, *w_ada, *b_ada, *g_norm, *w_in, *g_aqn, *g_akn, *g_bq_lat, *w_bq_up, *g_bkv_lat, *w_bkv_up, *g_bqn, *g_bkn, *sink, *w_o, *w_fo, *b_fo, *w_router, *b_router, *w_gate, *w_up, *w_down;
    float* out; unsigned char* ws;
};
#define WSP(T_, off) ((T_*)(F.ws + (off)))

__device__ __forceinline__ void transpose_item(const float* W, int N, bf16_t* WT, int ldk, int k0, int n0, int drow0, LAS float* scr, int lane) {
#pragma unroll 8
    for (int i = 0; i < 32; ++i) { const int kk = 2 * i + (lane >> 5); scr[kk * 33 + (lane & 31)] = W[(size_t)(k0 + kk) * N + n0 + (lane & 31)]; }
    LDS_WAIT(); asm volatile("" ::: "memory");
    const int c = lane & 7;
#pragma unroll
    for (int j = 0; j < 4; ++j) { const int n = (lane >> 3) + 8 * j; const LAS float* s = scr + (8 * c) * 33 + n;
        u32x4 o; o.x = pk2(s[0 * 33], s[1 * 33]); o.y = pk2(s[2 * 33], s[3 * 33]); o.z = pk2(s[4 * 33], s[5 * 33]); o.w = pk2(s[6 * 33], s[7 * 33]);
        *(GAS u32x4*)(WT + (size_t)(drow0 + n) * ldk + k0 + 8 * c) = o; }
    LDS_WAIT(); asm volatile("" ::: "memory");
}
__device__ __forceinline__ void conv_plain(const float* W, int K, int N, bf16_t* WT, int item, LAS float* scr, int lane) {
    const int nblk = N / 32, kb = item / nblk, nb = item % nblk; transpose_item(W, N, WT, K, 64 * kb, 32 * nb, 32 * nb, scr, lane);
}

__device__ __forceinline__ void ada_task(Frame& F, int task, const LAS float* sl  ) {
    const int l = task / 768, n0 = (task % 768) * 16, kq = F.lane >> 2, c4 = F.lane & 3;
    const float* wp = F.w_ada + ((size_t)l * DM + kq) * 12288 + n0 + 4 * c4;
    f32x4 a0 = {0, 0, 0, 0}, a1 = a0, a2 = a0, a3 = a0, a4 = a0;
#pragma unroll 8
    for (int i = 0; i < 128; ++i) { const f32x4 w = *(const f32x4*)(wp + (size_t)i * 16 * 12288); const int k = kq + 16 * i;
        const f32x4 s = *(const LAS f32x4*)(sl + k * 8); const float s4 = sl[k * 8 + 4];
        a0 += w * s[0]; a1 += w * s[1]; a2 += w * s[2]; a3 += w * s[3]; a4 += w * s4; }
#pragma unroll
    for (int o = 4; o < 64; o <<= 1) {
#pragma unroll
        for (int j = 0; j < 4; ++j) { a0[j] += __shfl_xor(a0[j], o); a1[j] += __shfl_xor(a1[j], o); a2[j] += __shfl_xor(a2[j], o); a3[j] += __shfl_xor(a3[j], o); a4[j] += __shfl_xor(a4[j], o); } }
    if (kq == 0) { const f32x4 bv = *(const f32x4*)(F.b_ada + (size_t)l * 12288 + n0 + 4 * c4); float* mp = WSP(float, WS_MOD) + (size_t)l * 5 * 12288 + n0 + 4 * c4;
        *(f32x4*)(mp) = a0 + bv; *(f32x4*)(mp + 12288) = a1 + bv; *(f32x4*)(mp + 2 * 12288) = a2 + bv; *(f32x4*)(mp + 3 * 12288) = a3 + bv; *(f32x4*)(mp + 4 * 12288) = a4 + bv; }
}

__device__ __forceinline__ void p0_prologue(Frame& F) {
    const int gw = F.vcu * NWAVES + F.wave, NGW = F.G * NWAVES;
    LAS float* sl = (LAS float*)(F.lds);
    for (int i = F.tid; i < DM * 5; i += NTHR) { const int r = i / DM, k = i % DM; const float v = r < 4 ? F.c[r * DM + k] : F.c_ctx[k]; sl[k * 8 + r] = silu_f(v); }
    __syncthreads();
    for (int task = gw; task < 2 * 768; task += NGW) ada_task(F, task, sl);
    __syncthreads();
    LAS float* scr = (LAS float*)(F.lds + F.wave * 16384);
    constexpr int I_IN = (DM / 64) * (INW / 32), I_BQ = (512 / 64) * (1536 / 32), I_BKV = (256 / 64) * (2048 / 32), I_SQ = (DM / 64) * (DM / 32), I_E = (DM / 64) * (DE / 32)  ;
    constexpr int NITEMS = I_IN + I_BQ + I_BKV + 2 * I_SQ + 3 * 32 * I_E;
    for (int it = gw; it < NITEMS; it += NGW) {
        int r = it;
        if (r < I_IN) { conv_plain(F.w_in, DM, INW, WSP(bf16_t, WS_WIN_T), r, scr, F.lane); continue; } r -= I_IN;
        if (r < I_BQ) { conv_plain(F.w_bq_up, 512, 1536, WSP(bf16_t, WS_WBQ_T), r, scr, F.lane); continue; } r -= I_BQ;
        if (r < I_BKV) { conv_plain(F.w_bkv_up, 256, 2048, WSP(bf16_t, WS_WBKV_T), r, scr, F.lane); continue; } r -= I_BKV;
        if (r < I_SQ) { conv_plain(F.w_o, DM, DM, WSP(bf16_t, WS_WO_T), r, scr, F.lane); continue; } r -= I_SQ;
        if (r < I_SQ) { conv_plain(F.w_fo, DM, DM, WSP(bf16_t, WS_WFO_T), r, scr, F.lane); continue; } r -= I_SQ;
        if (r < 32 * I_E) { const int le = r / I_E, item = r % I_E, nblk = DE / 32, kb = item / nblk, nb = item % nblk, n0 = 32 * nb;
            transpose_item(F.w_gate + (size_t)le * DM * DE, DE, WSP(bf16_t, WS_WGU_T) + (size_t)le * DM * DM, DM, 64 * kb, n0, (n0 >> 7) * 256 + (n0 & 127), scr, F.lane); continue; } r -= 32 * I_E;
        if (r < 32 * I_E) { const int le = r / I_E, item = r % I_E, nblk = DE / 32, kb = item / nblk, nb = item % nblk, n0 = 32 * nb;
            transpose_item(F.w_up + (size_t)le * DM * DE, DE, WSP(bf16_t, WS_WGU_T) + (size_t)le * DM * DM, DM, 64 * kb, n0, (n0 >> 7) * 256 + 128 + (n0 & 127), scr, F.lane); continue; } r -= 32 * I_E;
        { const int le = r / I_E; conv_plain(F.w_down + (size_t)le * DE * DM, DE, DM, WSP(bf16_t, WS_WD_T) + (size_t)le * DM * DE, r % I_E, scr, F.lane); }
    }
    { u32x4* z = (u32x4*)(WSP(bf16_t, WS_WIN_T) + (size_t)INW * DM); const int n16 = (INWP - INW) * DM * 2 / 16;
      for (int i = blockIdx.x * NTHR + F.tid; i < n16; i += F.G * NTHR) z[i] = (u32x4){0u, 0u, 0u, 0u}; }
    for (int i = blockIdx.x * NTHR + F.tid; i < 512 * 256 / 2; i += F.G * NTHR) { const int e = 2 * i, row = e >> 8, c0 = e & 255, j = row & 255; const bool isn = row >= 256;
        const float f0 = (float)((j * c0) & 255) * (1.0f / 256.0f), f1 = (float)((j * (c0 + 1)) & 255) * (1.0f / 256.0f);
        const float v0 = isn ? -__builtin_amdgcn_sinf(f0) : __builtin_amdgcn_cosf(f0), v1 = isn ? -__builtin_amdgcn_sinf(f1) : __builtin_amdgcn_cosf(f1);
        WSP(unsigned, WS_WC)[i] = pk2(v0, v1); }
    for (int i = blockIdx.x * NTHR + F.tid; i < 4096 * 8192 / 8; i += F.G * NTHR) { const int k = i >> 10, c8 = (i & 1023) * 8, isn = c8 >= 4096, s0 = c8 & 4095; float v[8];
#pragma unroll
        for (int q = 0; q < 8; ++q) { const float f = (float)((k * (s0 + q)) & 4095) * (1.0f / 4096.0f); v[q] = isn ? __builtin_amdgcn_sinf(f) : __builtin_amdgcn_cosf(f); }
        u32x4 w; w.x = pk2(v[0], v[1]); w.y = pk2(v[2], v[3]); w.z = pk2(v[4], v[5]); w.w = pk2(v[6], v[7]);
        WSP(u32x4, WS_WS)[i] = w; }
}

__device__ __forceinline__ void norm_mod_row(const float* xrow, const float* g, const float* sh, const float* sc, bf16_t* orow, int lane, f32x4 (&v)[8]) {
    const GAS f32x4* xr = (const GAS f32x4*)xrow + lane; float ss = 0.f;
#pragma unroll
    for (int j = 0; j < 8; ++j) { v[j] = xr[64 * j]; ss += (v[j].x * v[j].x + v[j].y * v[j].y) + (v[j].z * v[j].z + v[j].w * v[j].w); }
    const float rstd = 1.0f / sqrtf(wave_sum(ss) * (1.0f / DM) + EPS);
    GAS u32x2* o8 = (GAS u32x2*)orow + lane;
#pragma unroll
    for (int j = 0; j < 8; ++j) { const f32x4 gg = ((const GAS f32x4*)g)[lane + 64 * j], s1 = ((const GAS f32x4*)sc)[lane + 64 * j], s0 = ((const GAS f32x4*)sh)[lane + 64 * j];
        v[j] = (v[j] * rstd * gg) * (1.0f + s1) + s0; u32x2 w; w.x = pk2(v[j].x, v[j].y); w.y = pk2(v[j].z, v[j].w); o8[64 * j] = w; }
}
__device__ __forceinline__ const float* modp(Frame& F, int l, int r, int chunk) { return WSP(float, WS_MOD) + ((size_t)l * 5 + r) * 12288 + chunk * DM; }

__device__ __forceinline__ void p1_norm(Frame& F) {
    const int gw = F.vcu * NWAVES + F.wave, NGW = F.G * NWAVES; f32x4 v[8];
    for (int row = gw; row < TT; row += NGW) { const bool lat = row < T; const int r = lat ? row / SEQ : 4;
        const float* xr = lat ? F.x + (size_t)row * DM : F.ctx + (size_t)(row - T) * DM;
        norm_mod_row(xr, F.g_norm, modp(F, 0, r, 0), modp(F, 0, r, 1), WSP(bf16_t, WS_H) + (size_t)row * DM, F.lane, v); }
}


__device__ __forceinline__ void p3_post(Frame& F) {
    const int gw = F.vcu * NWAVES + F.wave, NGW = F.G * NWAVES, lane = F.lane, li = lane & 31, hh = lane >> 5;
    const bf16_t* P = WSP(bf16_t, WS_P);
    const float fr = __powf(10000.0f, -(float)li * (1.0f / 32.0f));
    float gq[4], gk[4];
#pragma unroll
    for (int q = 0; q < 4; ++q) { gq[q] = F.g_aqn[li + 32 * q]; gk[q] = F.g_akn[li + 32 * q]; }
    for (int row = gw; row < TT; row += NGW) {
        const bool lat = row < T; const int b = lat ? row / SEQ : (row - T) / CTX, s = lat ? row % SEQ : (row - T) % CTX, kpos = lat ? CTX + s : s;
        const bf16_t* pr = P + (size_t)row * INWP;
        float cr, sr_, cc, sc_; { const float ar = (float)(s / 64) * fr, ac = (float)(s % 64) * fr; sincosf(ar, &sr_, &cr); sincosf(ac, &sc_, &cc); }
        if (lat) {
#pragma unroll
            for (int ps = 0; ps < 4; ++ps) { const int head = 2 * ps + hh; float y[4]; float ss = 0.f;
#pragma unroll
                for (int q = 0; q < 4; ++q) { y[q] = bf2f(pr[head * 128 + li + 32 * q]); ss += y[q] * y[q]; }
                const float rstd = 1.0f / sqrtf(half_sum(ss) * (1.0f / 128.0f) + EPS);
#pragma unroll
                for (int q = 0; q < 4; ++q) y[q] = y[q] * rstd * gq[q];
                bf16_t* o = WSP(bf16_t, WS_QA) + (size_t)row * 1024 + head * 128 + li;
                o[0] = (bf16_t)f2bf(y[0] * cr - y[1] * sr_); o[32] = (bf16_t)f2bf(y[0] * sr_ + y[1] * cr); o[64] = (bf16_t)f2bf(y[2] * cc - y[3] * sc_); o[96] = (bf16_t)f2bf(y[2] * sc_ + y[3] * cc); }
            { const u32x4 w = *(const u32x4*)(pr + 1536 + 8 * lane); float y[8] = {bflo(w.x), bfhi(w.x), bflo(w.y), bfhi(w.y), bflo(w.z), bfhi(w.z), bflo(w.w), bfhi(w.w)}; float ss = 0.f;
#pragma unroll
              for (int q = 0; q < 8; ++q) ss += y[q] * y[q];
              const float rstd = 1.0f / sqrtf(wave_sum(ss) * (1.0f / 512.0f) + EPS);
              const f32x4 g0 = *(const f32x4*)(F.g_bq_lat + 8 * lane), g1 = *(const f32x4*)(F.g_bq_lat + 8 * lane + 4);
              u32x4 o; o.x = pk2(y[0] * rstd * g0.x, y[1] * rstd * g0.y); o.y = pk2(y[2] * rstd * g0.z, y[3] * rstd * g0.w); o.z = pk2(y[4] * rstd * g1.x, y[5] * rstd * g1.y); o.w = pk2(y[6] * rstd * g1.z, y[7] * rstd * g1.w);
              *(u32x4*)(WSP(bf16_t, WS_BQL) + (size_t)row * 512 + 8 * lane) = o; }
        }
        { float y[4]; float ss = 0.f;
#pragma unroll
          for (int q = 0; q < 4; ++q) { y[q] = bf2f(pr[1024 + hh * 128 + li + 32 * q]); ss += y[q] * y[q]; }
          const float rstd = 1.0f / sqrtf(half_sum(ss) * (1.0f / 128.0f) + EPS);
#pragma unroll
          for (int q = 0; q < 4; ++q) y[q] = y[q] * rstd * gk[q];
          bf16_t* o = WSP(bf16_t, WS_KA) + ((size_t)(b * 2 + hh) * KVLEN + kpos) * 128 + li;
          if (lat) { o[0] = (bf16_t)f2bf(y[0] * cr - y[1] * sr_); o[32] = (bf16_t)f2bf(y[0] * sr_ + y[1] * cr); o[64] = (bf16_t)f2bf(y[2] * cc - y[3] * sc_); o[96] = (bf16_t)f2bf(y[2] * sc_ + y[3] * cc); }
          else { o[0] = (bf16_t)f2bf(y[0]); o[32] = (bf16_t)f2bf(y[1]); o[64] = (bf16_t)f2bf(y[2]); o[96] = (bf16_t)f2bf(y[3]); } }
        { const u32x2 w = *(const u32x2*)(pr + 1280 + 4 * lane); const int d = 4 * lane, h2 = d >> 7;
          *(u32x2*)(WSP(bf16_t, WS_VA) + ((size_t)(b * 2 + h2) * KVLEN + kpos) * 128 + (d & 127)) = w; }
        { const u32x2 w = *(const u32x2*)(pr + 2048 + 4 * lane); float y[4] = {bflo(w.x), bfhi(w.x), bflo(w.y), bfhi(w.y)};
          const float ss = (y[0] * y[0] + y[1] * y[1]) + (y[2] * y[2] + y[3] * y[3]);
          const float rstd = 1.0f / sqrtf(wave_sum(ss) * (1.0f / 256.0f) + EPS); const f32x4 g0 = *(const f32x4*)(F.g_bkv_lat + 4 * lane);
          u32x2 o; o.x = pk2(y[0] * rstd * g0.x, y[1] * rstd * g0.y); o.y = pk2(y[2] * rstd * g0.z, y[3] * rstd * g0.w);
          *(u32x2*)(WSP(bf16_t, WS_KVL) + (size_t)row * 256 + 4 * lane) = o; }
        WSP(bf16_t, WS_KR)[(size_t)row * 64 + lane] = pr[2304 + lane];
    }
}

__device__ __forceinline__ void p5_post(Frame& F) {
    const int gw = F.vcu * NWAVES + F.wave, NGW = F.G * NWAVES, lane = F.lane, i16 = lane & 15, sel = (lane >> 4) & 1; const bool tl = lane < 32;
    const bf16_t* BQ = WSP(bf16_t, WS_BQ); const bf16_t* KV = WSP(bf16_t, WS_KV); const bf16_t* KR = WSP(bf16_t, WS_KR);
    const float fr = __powf(10000.0f, -(float)i16 * (1.0f / 16.0f));
    const int t1 = 128 + 32 * sel + i16, t2 = t1 + 16;
    const float gq0 = F.g_bqn[lane], gq1 = F.g_bqn[lane + 64], gq2 = F.g_bqn[t1], gq3 = F.g_bqn[t2];
    const float gk0 = F.g_bkn[lane], gk1 = F.g_bkn[lane + 64], gk2 = F.g_bkn[t1], gk3 = F.g_bkn[t2];
    for (int row = gw; row < TT; row += NGW) {
        const bool lat = row < T; const int b = lat ? row / SEQ : (row - T) / CTX, s = lat ? row % SEQ : (row - T) % CTX, kpos = lat ? CTX + s : s;
        float cs, sn; { const float pos = sel ? (float)(s % 64) : (float)(s / 64); sincosf(pos * fr, &sn, &cs); }
        const float kr1 = tl ? bf2f(KR[(size_t)row * 64 + 32 * sel + i16]) : 0.f, kr2 = tl ? bf2f(KR[(size_t)row * 64 + 32 * sel + 16 + i16]) : 0.f;
#pragma unroll 2
        for (int h = 0; h < 8; ++h) {
            if (lat) { const bf16_t* q = BQ + (size_t)row * 1536 + h * 192;
                float y0 = bf2f(q[lane]), y1 = bf2f(q[lane + 64]), x1 = tl ? bf2f(q[t1]) : 0.f, x2 = tl ? bf2f(q[t2]) : 0.f;
                const float rstd = 1.0f / sqrtf(wave_sum((y0 * y0 + y1 * y1) + (x1 * x1 + x2 * x2)) * (1.0f / 192.0f) + EPS);
                y0 *= rstd * gq0; y1 *= rstd * gq1; x1 *= rstd * gq2; x2 *= rstd * gq3;
                bf16_t* o = WSP(bf16_t, WS_QB) + (size_t)row * 1536 + h * 192;
                o[lane] = (bf16_t)f2bf(y0); o[lane + 64] = (bf16_t)f2bf(y1);
                if (tl) { o[t1] = (bf16_t)f2bf(x1 * cs - x2 * sn); o[t2] = (bf16_t)f2bf(x1 * sn + x2 * cs); } }
            { const bf16_t* k = KV + (size_t)row * DM + h * 256;
              float y0 = bf2f(k[lane]), y1 = bf2f(k[lane + 64]), x1 = kr1, x2 = kr2;
              const float rstd = 1.0f / sqrtf(wave_sum((y0 * y0 + y1 * y1) + (x1 * x1 + x2 * x2)) * (1.0f / 192.0f) + EPS);
              y0 *= rstd * gk0; y1 *= rstd * gk1; x1 *= rstd * gk2; x2 *= rstd * gk3;
              bf16_t* o = WSP(bf16_t, WS_KB) + ((size_t)(b * 8 + h) * KVLEN + kpos) * 192;
              o[lane] = (bf16_t)f2bf(y0); o[lane + 64] = (bf16_t)f2bf(y1);
              if (tl) { if (lat) { o[t1] = (bf16_t)f2bf(x1 * cs - x2 * sn); o[t2] = (bf16_t)f2bf(x1 * sn + x2 * cs); } else { o[t1] = (bf16_t)f2bf(x1); o[t2] = (bf16_t)f2bf(x2); } }
              *(unsigned*)(WSP(bf16_t, WS_VB) + ((size_t)(b * 8 + h) * KVLEN + kpos) * 128 + 2 * lane) = *(const unsigned*)(k + 128 + 2 * lane); }
        }
    }
}

__device__ __forceinline__ void p6_attn(Frame& F) {
    char* lds = (char*)F.lds;
    for (int uid = F.vcu; uid < 1024; uid += F.G) {
        const int u = uid & 511, qb = u & 15, h = (u >> 4) & 7, b = u >> 7; const size_t tok0 = (size_t)b * SEQ + qb * 256;
#ifndef ATT_NO_DENSE
        if (uid < 512) {
            att::attn_unit<192, false>(WSP(bf16_t, WS_QB) + tok0 * 1536 + h * 192, 1536, WSP(bf16_t, WS_KB) + (size_t)(b * 8 + h) * KVLEN * 192, WSP(bf16_t, WS_VB) + (size_t)(b * 8 + h) * KVLEN * 128,
                                       WSP(bf16_t, WS_Y) + tok0 * DM + 1024 + h * 128, DM, KVLEN / 64, 0, 0, 0.f, lds);
        }
#endif
#ifndef ATT_NO_WIN
        if (uid >= 512) {
            const int q0 = qb * 256, ks = q0 >= 128 ? q0 - 128 : 0, ke = (q0 + 384 < SEQ) ? q0 + 384 : SEQ, kvh = h >> 2;
            att::attn_unit<128, true>(WSP(bf16_t, WS_QA) + tok0 * 1024 + h * 128, 1024, WSP(bf16_t, WS_KA) + (size_t)(b * 2 + kvh) * KVLEN * 128, WSP(bf16_t, WS_VA) + (size_t)(b * 2 + kvh) * KVLEN * 128,
                                      WSP(bf16_t, WS_Y) + tok0 * DM + h * 128, DM, 4 + (ke - ks) / 64, ks, q0, F.sink[h], lds);
        }
#endif
    }
}
#define R_E(F) WSP(int, WS_ROUTE)
#define R_P(F) (WSP(int, WS_ROUTE) + 2 * T)
#define R_W(F) (WSP(float, WS_ROUTE) + 4 * T)
#define R_STOK(F) (WSP(int, WS_ROUTE) + 6 * T)

__device__ __forceinline__ void p8_route(Frame& F, int l) {
    LAS float* wrt = (LAS float*)F.lds;
    LAS int* hist = (LAS int*)(F.lds + RING_BYTES);
    LAS int* hbase = hist + 16;
    LAS int* tinfo = (LAS int*)(F.lds + RING_BYTES + 1024);
    for (int i = F.tid; i < DM * NE; i += NTHR) { const int k = i >> 4, e = i & 15; wrt[e * DM + k] = F.w_router[i]; }
    if (F.tid < 16) hist[F.tid] = 0;
    __syncthreads();
    float br[16];
#pragma unroll
    for (int e = 0; e < 16; ++e) br[e] = F.b_router[e];
    const float* g = F.g_norm + (size_t)(l * 2 + 1) * DM;
    unsigned* cnt = F.ctl + CW_CNT + l * 16 * 64;
    for (int grp = F.vcu; grp < T / 64; grp += F.G) {
        for (int q = 0; q < 8; ++q) { const int tl = F.wave * 8 + q, tok = grp * 64 + tl, b = tok / SEQ; f32x4 v[8];
            norm_mod_row(F.out + (size_t)tok * DM, g, modp(F, l, b, 3), modp(F, l, b, 4), WSP(bf16_t, WS_H) + (size_t)tok * DM, F.lane, v);
            float lg[16];
#pragma unroll
            for (int e = 0; e < 16; ++e) { float a = 0.f;
#pragma unroll
                for (int j = 0; j < 8; ++j) { const f32x4 w = *(const LAS f32x4*)(wrt + e * DM + 256 * j + 4 * F.lane); a += (v[j].x * w.x + v[j].y * w.y) + (v[j].z * w.z + v[j].w * w.w); }
                lg[e] = wave_sum(a); }
            float aff[16], sel[16];
#pragma unroll
            for (int e = 0; e < 16; ++e) { aff[e] = 1.0f / (1.0f + expf(-lg[e])); sel[e] = aff[e] + br[e]; }
            float gs[4], ga0[4], ga1[4]; int gi0[4], gi1[4];
#pragma unroll
            for (int gq = 0; gq < 4; ++gq) { int i0 = 0; float m0 = sel[4 * gq], a0 = aff[4 * gq];
#pragma unroll
                for (int i = 1; i < 4; ++i) if (sel[4 * gq + i] > m0) { m0 = sel[4 * gq + i]; a0 = aff[4 * gq + i]; i0 = i; }
                int i1 = -1; float m1 = -3.0e38f, a1 = 0.f;
#pragma unroll
                for (int i = 0; i < 4; ++i) if (i != i0 && sel[4 * gq + i] > m1) { m1 = sel[4 * gq + i]; a1 = aff[4 * gq + i]; i1 = i; }
                gs[gq] = m0 + m1; gi0[gq] = 4 * gq + i0; gi1[gq] = 4 * gq + i1; ga0[gq] = a0; ga1[gq] = a1; }
            int e0 = gi0[0], e1 = gi1[0]; float a0 = ga0[0], a1 = ga1[0], best = gs[0];
#pragma unroll
            for (int gq = 1; gq < 4; ++gq) if (gs[gq] > best) { best = gs[gq]; e0 = gi0[gq]; e1 = gi1[gq]; a0 = ga0[gq]; a1 = ga1[gq]; }
            const float inv = 1.0f / (a0 + a1);
            if (F.lane == 0) { const int r0 = __hip_atomic_fetch_add(hist + e0, 1, __ATOMIC_RELAXED, __HIP_MEMORY_SCOPE_WORKGROUP), r1 = __hip_atomic_fetch_add(hist + e1, 1, __ATOMIC_RELAXED, __HIP_MEMORY_SCOPE_WORKGROUP);
                LAS int* ti = tinfo + tl * 6; ti[0] = e0; ti[1] = e1; ti[2] = r0; ti[3] = r1; ti[4] = __float_as_int(a0 * inv); ti[5] = __float_as_int(a1 * inv); }
        }
        __syncthreads();
        if (F.tid < 16) hbase[F.tid] = (int)__hip_atomic_fetch_add(cnt + F.tid * 64, (unsigned)hist[F.tid], __ATOMIC_RELAXED, __HIP_MEMORY_SCOPE_AGENT);
        __syncthreads();
        if (F.tid < 64) { const int tok = grp * 64 + F.tid; const LAS int* ti = tinfo + F.tid * 6;
            R_E(F)[2 * tok] = ti[0]; R_E(F)[2 * tok + 1] = ti[1]; R_P(F)[2 * tok] = hbase[ti[0]] + ti[2]; R_P(F)[2 * tok + 1] = hbase[ti[1]] + ti[3];
            R_W(F)[2 * tok] = __int_as_float(ti[4]); R_W(F)[2 * tok + 1] = __int_as_float(ti[5]); }
        if (F.tid < 16) hist[F.tid] = 0;
        __syncthreads();
    }
}
struct MoeTiles { int tend[16]; };
__device__ __forceinline__ MoeTiles moe_tiles(Frame& F, int l) {
    MoeTiles m; int acc = 0;
#pragma unroll
    for (int e = 0; e < 16; ++e) { const unsigned c = __builtin_amdgcn_readfirstlane(__hip_atomic_load(F.ctl + CW_CNT + (l * 16 + e) * 64, RLX_AGENT)); acc += (int)((c + 255u) >> 8); m.tend[e] = acc; }
    return m;
}
__device__ __forceinline__ void p9_scatter(Frame& F, int l) {
    const MoeTiles mt = moe_tiles(F, l);
    for (int i = blockIdx.x * NTHR + F.tid; i < 2 * T; i += F.G * NTHR) { const int e = R_E(F)[i]; int off = 0;
#pragma unroll
        for (int k = 0; k < 15; ++k) off = (e > k) ? mt.tend[k] : off;
        const int ap = off * 256 + R_P(F)[i]; R_P(F)[i] = ap; R_STOK(F)[ap] = i >> 1; }
    for (int e = 0; e < 16; ++e) { const int c = (int)__builtin_amdgcn_readfirstlane(__hip_atomic_load(F.ctl + CW_CNT + (l * 16 + e) * 64, RLX_AGENT)); const int off = e ? mt.tend[e - 1] : 0;
        for (int i = off * 256 + c + blockIdx.x * NTHR + F.tid; i < mt.tend[e] * 256; i += F.G * NTHR) R_STOK(F)[i] = 0; }
}
namespace pg8 {
struct MoeSched {
    TileOrder o; MoeTiles mt; const char* A0; const char* B0; const int* stok; size_t eB, tA, tB;
    __device__ __forceinline__ void init(const MoeTiles& m, const void* A, const void* B, int lda, int ldb, size_t eB_, const int* stok_, int G, int c) {
        mt = m; o.init(m.tend[15], DM / BM, 1, G, c); A0 = (const char*)A; B0 = (const char*)B; eB = eB_; stok = stok_; tA = (size_t)BM * lda * 2; tB = (size_t)BM * ldb * 2; }
    __device__ __forceinline__ int expert(int pm) const { int e = 0;
#pragma unroll
        for (int k = 0; k < 15; ++k) e += (pm >= mt.tend[k]) ? 1 : 0;
        return e; }
};
struct MoeSched1 : MoeSched { static constexpr bool GATHER = true;
    __device__ __forceinline__ bool next(int i, Unit& u) const { if (!o.map(i, u.aux, u.pm, u.pn)) return false; u.aux = expert(u.pm); u.A = A0; u.B = B0 + (size_t)u.aux * eB + (size_t)u.pn * tB; return true; }
    __device__ __forceinline__ unsigned arow(const Unit& u, int r) const { return (unsigned)stok[u.pm * BM + r]; } };
struct MoeSched2 : MoeSched { static constexpr bool GATHER = false;
    __device__ __forceinline__ bool next(int i, Unit& u) const { if (!o.map(i, u.aux, u.pm, u.pn)) return false; u.aux = expert(u.pm); u.A = A0 + (size_t)u.pm * tA; u.B = B0 + (size_t)u.aux * eB + (size_t)u.pn * tB; return true; }
    __device__ __forceinline__ unsigned arow(const Unit&, int) const { return 0u; } };
}
__device__ __forceinline__ void p12_combine(Frame& F, int l) {
    const int gw = F.vcu * NWAVES + F.wave, NGW = F.G * NWAVES, lane = F.lane; const bf16_t* YS = WSP(bf16_t, WS_YS);
    for (int tok = gw; tok < T; tok += NGW) { const int b = tok / SEQ; const int p0 = R_P(F)[2 * tok], p1 = R_P(F)[2 * tok + 1]; const float w0 = R_W(F)[2 * tok], w1 = R_W(F)[2 * tok + 1];
        const float* gt = modp(F, l, b, 5); float* xr = F.out + (size_t)tok * DM; f32x4 v[8]; float ss = 0.f;
#pragma unroll
        for (int j = 0; j < 8; ++j) { const int c = 4 * lane + 256 * j; const u32x2 y0 = *(const u32x2*)(YS + (size_t)p0 * DM + c), y1 = *(const u32x2*)(YS + (size_t)p1 * DM + c);
            const f32x4 gv = *(const f32x4*)(gt + c), xv = *(const f32x4*)(xr + c);
            f32x4 m; m.x = w0 * bflo(y0.x) + w1 * bflo(y1.x); m.y = w0 * bfhi(y0.x) + w1 * bfhi(y1.x); m.z = w0 * bflo(y0.y) + w1 * bflo(y1.y); m.w = w0 * bfhi(y0.y) + w1 * bfhi(y1.y);
            v[j] = xv + gv * m; *(f32x4*)(xr + c) = v[j]; ss += (v[j].x * v[j].x + v[j].y * v[j].y) + (v[j].z * v[j].z + v[j].w * v[j].w); }
        if (l == 0) { const float rstd = 1.0f / sqrtf(wave_sum(ss) * (1.0f / DM) + EPS); const float* g = F.g_norm + (size_t)2 * DM; const float* sh = modp(F, 1, b, 0); const float* sc = modp(F, 1, b, 1);
            bf16_t* orow = WSP(bf16_t, WS_H) + (size_t)tok * DM;
#pragma unroll
            for (int j = 0; j < 8; ++j) { const int c = 4 * lane + 256 * j; const f32x4 gg = *(const f32x4*)(g + c), s1 = *(const f32x4*)(sc + c), s0 = *(const f32x4*)(sh + c);
                const f32x4 hv = (v[j] * rstd * gg) * (1.0f + s1) + s0; u32x2 w; w.x = pk2(hv.x, hv.y); w.y = pk2(hv.z, hv.w); *(u32x2*)(orow + c) = w; } }
    }
}
#ifndef MK_SINGLE
#define MK_SINGLE 0
#endif
#ifndef MK_LAST
#define MK_LAST 21
#endif
constexpr int N_PHASES = 21;
struct Args { const float* in[25]; float* out; unsigned char* ws; int ph_lo, ph_hi; };
static_assert(sizeof(Args) == 27 * 8 + 8, "Args has no padding");

__global__ void __launch_bounds__(NTHR, 2) fwd_kernel(Args args) {
    extern __shared__ __attribute__((aligned(16))) unsigned char lds_raw[];
    Frame F;
    F.lds = (LAS unsigned char*)lds_raw;
    F.MISC = (volatile LAS unsigned*)(F.lds + MISC_OFF);
    F.tid = threadIdx.x; F.lane = F.tid & 63; F.wave = __builtin_amdgcn_readfirstlane(F.tid >> 6);
    F.G = gridDim.x; { const int bx = blockIdx.x; F.vcu = (F.G % 8 == 0) ? (bx % 8) * (F.G / 8) + bx / 8 : bx; }
    F.ws = args.ws; F.ctl = (unsigned*)(args.ws + WS_CTL); F.out = args.out;
    F.x = args.in[0]; F.c = args.in[1]; F.ctx = args.in[2]; F.c_ctx = args.in[3]; F.w_ada = args.in[4]; F.b_ada = args.in[5]; F.g_norm = args.in[6]; F.w_in = args.in[7];
    F.g_aqn = args.in[8]; F.g_akn = args.in[9]; F.g_bq_lat = args.in[10]; F.w_bq_up = args.in[11]; F.g_bkv_lat = args.in[12]; F.w_bkv_up = args.in[13]; F.g_bqn = args.in[14]; F.g_bkn = args.in[15];
    F.sink = args.in[16]; F.w_o = args.in[17]; F.w_fo = args.in[18]; F.b_fo = args.in[19]; F.w_router = args.in[20]; F.b_router = args.in[21]; F.w_gate = args.in[22]; F.w_up = args.in[23]; F.w_down = args.in[24];
    for (int u = F.tid; u < (LDS_BYTES - RING_BYTES) / 4; u += NTHR) ((LAS unsigned*)(F.lds + RING_BYTES))[u] = 0u;
    __syncthreads();
    const int lo = args.ph_lo, hi = args.ph_hi;
    XcdBarrier bar; bar.bar = F.ctl + CW_BAR; bar.x = 0; bar.st = nullptr;
    if (MK_SINGLE) bar = xcd_barrier_post(F.ctl + CW_BAR, F.MISC + 8);
#ifdef MK_ONLY
#define IN(k) ((k) == MK_ONLY && lo <= (k) && (k) < hi)
#else
#define IN(k) (lo <= (k) && (k) < hi)
#endif
#define SEAM(k) do { if (MK_SINGLE && IN((k) + 1)) xcd_barrier(bar); else __syncthreads(); } while (0)
    const int c = (int)blockIdx.x;

    if (IN(0)) { p0_prologue(F); SEAM(0); }
    if (IN(1)) { p1_norm(F); SEAM(1); }
    if (IN(2)) {
        pg8::PlainSched S; S.init(WSP(bf16_t, WS_H), WSP(bf16_t, WS_WIN_T), DM, DM, TT / 256, INWP / 256, 1, 0, 0, F.G, c);
        pg8::EpiBf16 E{WSP(bf16_t, WS_P), INWP, 1.0f, 0};
        pg8::gemm_phase(F.lds, DM, DM, DM, S, E); SEAM(2); }
    if (IN(3)) { p3_post(F); SEAM(3); }
    if (IN(4)) {
        { pg8::PlainSched S; S.init(WSP(bf16_t, WS_BQL), WSP(bf16_t, WS_WBQ_T), 512, 512, T / 256, 1536 / 256, 1, 0, 0, F.G, c);
          pg8::EpiBf16 E{WSP(bf16_t, WS_BQ), 1536, 1.0f, 0}; pg8::gemm_phase(F.lds, 512, 512, 512, S, E); }
        { pg8::PlainSched S; S.init(WSP(bf16_t, WS_KVL), WSP(bf16_t, WS_WBKV_T), 256, 256, TT / 256, DM / 256, 1, 0, 0, F.G, c);
          pg8::EpiBf16 E{WSP(bf16_t, WS_KV), DM, 1.0f, 0}; pg8::gemm_phase(F.lds, 256, 256, 256, S, E); }
        SEAM(4); }
    if (IN(5)) { p5_post(F); SEAM(5); }
    if (IN(6)) { p6_attn(F); SEAM(6); }
    if (IN(7)) {
        pg8::PlainSched S; S.init(WSP(bf16_t, WS_Y), WSP(bf16_t, WS_WO_T), DM, DM, T / 256, DM / 256, 1, 0, 0, F.G, c);
        pg8::EpiResGate E{F.x, F.out, modp(F, 0, 0, 2), 12288, nullptr};
        pg8::gemm_phase(F.lds, DM, DM, DM, S, E); SEAM(7); }
#define MOE_LAYER(l, P8, P9, P10, P11, P12)                                                                                                                    \
    if (IN(P8)) { p8_route(F, l); SEAM(P8); }                                                                                                                  \
    if (IN(P9)) { p9_scatter(F, l); SEAM(P9); }                                                                                                                \
    if (IN(P10)) { const MoeTiles mt = moe_tiles(F, l); pg8::MoeSched1 S; S.init(mt, WSP(bf16_t, WS_H), WSP(bf16_t, WS_WGU_T) + (size_t)l * 16 * DM * DM, DM, DM, (size_t)DM * DM * 2, R_STOK(F), F.G, c); \
        pg8::EpiSwiGLU E{WSP(bf16_t, WS_HS), DE}; pg8::gemm_phase(F.lds, DM, DM, DM, S, E); SEAM(P10); }                                                         \
    if (IN(P11)) { const MoeTiles mt = moe_tiles(F, l); pg8::MoeSched2 S; S.init(mt, WSP(bf16_t, WS_HS), WSP(bf16_t, WS_WD_T) + (size_t)l * 16 * DM * DE, DE, DE, (size_t)DM * DE * 2, R_STOK(F), F.G, c); \
        pg8::EpiBf16 E{WSP(bf16_t, WS_YS), DM, 1.0f, 0}; pg8::gemm_phase(F.lds, DE, DE, DE, S, E); SEAM(P11); }                                                  \
    if (IN(P12)) { p12_combine(F, l); SEAM(P12); }
    MOE_LAYER(0, 8, 9, 10, 11, 12)
    if (IN(13)) {
        pg8::PlainSched S; S.init(WSP(bf16_t, WS_WC), WSP(bf16_t, WS_H), 256, DM, 2, T / 256, 8, 0, (size_t)256 * 2, F.G, c);
        pg8::EpiChanDFT E{WSP(bf16_t, WS_ZT)}; pg8::gemm_phase(F.lds, 256, DM, 256, S, E); SEAM(13); }
    if (IN(14)) {
        pg8::PlainSched S; S.init(WSP(bf16_t, WS_WS), WSP(bf16_t, WS_ZT), 8192, 8192, SEQ / 256, DM / 256, NB, 0, (size_t)DM * 8192 * 2, F.G, c);
        pg8::EpiBf16 E{WSP(bf16_t, WS_F), DM, 1.0f / 1024.0f, (size_t)SEQ * DM}; pg8::gemm_phase(F.lds, 8192, 8192, 8192, S, E); SEAM(14); }
    if (IN(15)) {
        pg8::PlainSched S; S.init(WSP(bf16_t, WS_F), WSP(bf16_t, WS_WFO_T), DM, DM, T / 256, DM / 256, 1, 0, 0, F.G, c);
        pg8::EpiResGate E{F.out, F.out, modp(F, 1, 0, 2), 12288, F.b_fo};
        pg8::gemm_phase(F.lds, DM, DM, DM, S, E); SEAM(15); }
    MOE_LAYER(1, 16, 17, 18, 19, 20)
#undef IN
#undef SEAM
}

extern "C" void kernel_launch(void* const* d_in, const int* in_sizes, int n_in, void* d_out, int out_size, void* d_ws, size_t ws_size, hipStream_t stream) {
    static int grid = 0;
    if (grid == 0) {
        if (n_in != 25 || out_size != T * DM || ws_size < WS_END) { fprintf(stderr, "kernel_launch: shape mismatch n_in %d out %d ws %zu (need %zu)\n", n_in, out_size, ws_size, (size_t)WS_END); grid = -1; return; }
        int dev = 0, cus = 0, per_cu = 0;
        if (hipGetDevice(&dev) != hipSuccess || hipDeviceGetAttribute(&cus, hipDeviceAttributeMultiprocessorCount, dev) != hipSuccess) { grid = -1; return; }
        if (hipFuncSetAttribute((const void*)fwd_kernel, hipFuncAttributeMaxDynamicSharedMemorySize, LDS_BYTES) != hipSuccess) { fprintf(stderr, "kernel_launch: hipFuncSetAttribute failed\n"); grid = -1; return; }
        if (hipOccupancyMaxActiveBlocksPerMultiprocessor(&per_cu, (const void*)fwd_kernel, NTHR, LDS_BYTES) != hipSuccess || per_cu < 1) fprintf(stderr, "kernel_launch: occupancy query says %d\n", per_cu);
        (void)hipGetLastError();
        grid = cus;
    }
    if (grid < 0) return;
    (void)hipMemsetAsync((char*)d_ws + WS_CTL, 0, CTL_ZERO_BYTES, stream);
    Args a{};
    for (int i = 0; i < 25; ++i) a.in[i] = (const float*)d_in[i];
    a.out = (float*)d_out; a.ws = (unsigned char*)d_ws;
    if (MK_LAST <= 7) (void)hipMemcpyAsync(d_out, d_in[0], (size_t)T * DM * 4, hipMemcpyDeviceToDevice, stream);
#if MK_SINGLE
    a.ph_lo = 0; a.ph_hi = MK_LAST;
    hipLaunchKernelGGL(fwd_kernel, dim3(grid), dim3(NTHR), LDS_BYTES, stream, a);
#else
    for (int ph = 0; ph < MK_LAST; ++ph) { a.ph_lo = ph; a.ph_hi = ph + 1; hipLaunchKernelGGL(fwd_kernel, dim3(grid), dim3(NTHR), LDS_BYTES, stream, a); }
#endif
    const hipError_t le = hipPeekAtLastError();
    if (le != hipSuccess) fprintf(stderr, "kernel_launch: launch failed: %s\n", hipGetErrorName(le));
}
```

```cpp
#define MK_SINGLE 1
#define MK_LAST 21
#include <hip/hip_runtime.h>
#include <cstdio>
#include <cstdint>

#define LAS __attribute__((address_space(3)))
#define GAS __attribute__((address_space(1)))
typedef unsigned short bf16_t;
typedef short bf16x8 __attribute__((ext_vector_type(8)));
typedef short s16x4 __attribute__((ext_vector_type(4)));
typedef float f32x4 __attribute__((ext_vector_type(4)));
typedef float f32x2 __attribute__((ext_vector_type(2)));
typedef float f32x16 __attribute__((ext_vector_type(16)));
typedef unsigned u32x4 __attribute__((ext_vector_type(4)));
typedef unsigned u32x2 __attribute__((ext_vector_type(2)));

constexpr int DM = 2048, NB = 4, SEQ = 4096, T = NB * SEQ, CTX = 256, TC = NB * CTX, TT = T + TC, KVLEN = CTX + SEQ;
constexpr int INW = 2368, INWP = 2560, NE = 16, DE = 1024, APAD = 2 * T + NE * 256;
constexpr float EPS = 1e-6f;
constexpr int NWAVES = 8, NTHR = 512;

constexpr size_t MiB = 1u << 20;
constexpr size_t WS_CTL = 0, CTL_ZERO_BYTES = 1 * MiB;
constexpr size_t WS_MOD = 1 * MiB;
constexpr size_t WS_ROUTE = 2 * MiB;
constexpr size_t WS_WIN_T = 4 * MiB, WS_WBQ_T = 14 * MiB, WS_WBKV_T = 16 * MiB, WS_WO_T = 18 * MiB, WS_WFO_T = 26 * MiB, WS_WC = 34 * MiB, WS_KR = 35 * MiB;
constexpr size_t WS_WS = 38 * MiB, WS_WGU_T = 102 * MiB, WS_WD_T = 358 * MiB;
constexpr size_t WS_H = 486 * MiB, WS_RA = 554 * MiB, WS_RC = 714 * MiB, WS_RD = 790 * MiB, WS_END = 924 * MiB;
constexpr size_t WS_P = WS_RA, WS_BQ = WS_RA, WS_KV = WS_RA + 48 * MiB, WS_Y = WS_RA, WS_YS = WS_RA, WS_ZT = WS_RA;
constexpr size_t WS_QA = WS_RC, WS_KA = WS_RC + 32 * MiB, WS_VA = WS_RC + 41 * MiB, WS_BQL = WS_RC + 50 * MiB, WS_KVL = WS_RC + 66 * MiB, WS_F = WS_RC;
constexpr size_t WS_QB = WS_RD, WS_KB = WS_RD + 48 * MiB, WS_VB = WS_RD + 99 * MiB, WS_HS = WS_RD;
static_assert((size_t)TT * INWP * 2 <= 160 * MiB && (size_t)APAD * DM * 2 <= 160 * MiB && (size_t)NB * DM * 8192 * 2 <= 160 * MiB, "region A");
static_assert((size_t)T * 1536 * 2 <= 48 * MiB && WS_KV + (size_t)TT * DM * 2 <= WS_RC, "BQ/KV");
static_assert((size_t)T * 1024 * 2 <= 32 * MiB && (size_t)NB * 2 * KVLEN * 128 * 2 <= 9 * MiB && (size_t)T * 512 * 2 <= 16 * MiB && WS_KVL + (size_t)TT * 256 * 2 <= WS_RD, "region C");
static_assert((size_t)T * 1536 * 2 <= 48 * MiB && (size_t)NB * 8 * KVLEN * 192 * 2 <= 51 * MiB && WS_VB + (size_t)NB * 8 * KVLEN * 128 * 2 <= WS_END && (size_t)APAD * DE * 2 <= 134 * MiB, "region D");
static_assert((size_t)TT * DM * 2 <= 68 * MiB && (size_t)TT * 64 * 2 <= 3 * MiB, "H/KR");
constexpr int CW_BAR = 4096;
constexpr int CW_CNT = 8192;

constexpr int RING_BYTES = 131072;
constexpr int MISC_OFF = RING_BYTES + 320;
constexpr int LDS_BYTES = 147456;

#define RLX_AGENT __ATOMIC_RELAXED, __HIP_MEMORY_SCOPE_AGENT
#define LDS_WAIT() asm volatile("s_waitcnt lgkmcnt(0)" ::: "memory")
#define VM_WAIT() asm volatile("s_waitcnt vmcnt(0)" ::: "memory")
__device__ __forceinline__ unsigned f2bf(float f) { unsigned u = __builtin_bit_cast(unsigned, f); return (u + 0x7fffu + ((u >> 16) & 1u)) >> 16; }
__device__ __forceinline__ unsigned pk2(float lo, float hi) { return f2bf(lo) | (f2bf(hi) << 16); }
__device__ __forceinline__ float bf2f(unsigned b) { return __builtin_bit_cast(float, b << 16); }
__device__ __forceinline__ float bflo(unsigned w) { return __builtin_bit_cast(float, w << 16); }
__device__ __forceinline__ float bfhi(unsigned w) { return __builtin_bit_cast(float, w & 0xffff0000u); }
__device__ __forceinline__ unsigned cvt_pk_bf16(float lo, float hi) { unsigned r; asm volatile("v_cvt_pk_bf16_f32 %0, %1, %2" : "=v"(r) : "v"(lo), "v"(hi)); return r; }
__device__ __forceinline__ float wave_sum(float v) {
#pragma unroll
    for (int o = 1; o < 64; o <<= 1) v += __shfl_xor(v, o);
    return v;
}
__device__ __forceinline__ float half_sum(float v) {
#pragma unroll
    for (int o = 1; o < 32; o <<= 1) v += __shfl_xor(v, o);
    return v;
}
__device__ __forceinline__ float silu_f(float v) { return v / (1.0f + __expf(-v)); }

#define XB_TMO      128
#define XB_XCNT(j)  (256  + 64 * (j))
#define XB_XSUB(j)  (1280 + 64 * (j))
#define XB_XGEN(j)  (2304 + 64 * (j))
#define XB_TOP      3328
#define XB_TOPGEN   3392
#define XCD_BAR_WORDS 3456
#define XB_SPIN_CAP (1u << 18)
__device__ __forceinline__ unsigned xb_ld(unsigned* p)              { return __hip_atomic_load(p, __ATOMIC_RELAXED, __HIP_MEMORY_SCOPE_AGENT); }
__device__ __forceinline__ unsigned xb_add(unsigned* p, unsigned v) { return __hip_atomic_fetch_add(p, v, __ATOMIC_RELAXED, __HIP_MEMORY_SCOPE_AGENT); }
__device__ __forceinline__ unsigned xb_xcc_id() { return (unsigned)__builtin_amdgcn_s_getreg((3 << 11) | 20) & 0xFu; }
#define XB_SPIN(cond, bar) do { unsigned _sp = 0; while (cond) { __builtin_amdgcn_s_sleep(1); \
    if ((++_sp & 255u) == 0u) { if (xb_ld(&(bar)[XB_TMO])) break; if (_sp > XB_SPIN_CAP) { atomicAdd(&(bar)[XB_TMO], 1u); break; } } } } while (0)
struct XcdBarrier { unsigned* bar; unsigned x; volatile LAS unsigned* st; };
__device__ __forceinline__ XcdBarrier xcd_barrier_post(unsigned* bar, volatile LAS unsigned* st) {
    XcdBarrier b; b.bar = bar; b.x = xb_xcc_id(); b.st = st;
    if (threadIdx.x == 0) (void)xb_add(&bar[XB_XCNT(b.x)], 1u);
    return b;
}
__device__ __forceinline__ void xcd_barrier_complete(unsigned* bar, unsigned x, unsigned& nloc, unsigned& nx) {
    const unsigned G = gridDim.x * gridDim.y * gridDim.z;
    unsigned sum, cnt, mine, sp = 0u;
    for (;;) {
        sum = 0u; cnt = 0u; mine = 0u;
#pragma unroll
        for (unsigned j = 0; j < 16; ++j) { const unsigned c = xb_ld(&bar[XB_XCNT(j)]); sum += c; cnt += (c > 0u) ? 1u : 0u; mine = (j == x) ? c : mine; }
        if (sum == G) break;
        __builtin_amdgcn_s_sleep(1);
        if ((++sp & 255u) == 0u) { if (xb_ld(&bar[XB_TMO])) break; if (sp > XB_SPIN_CAP) { atomicAdd(&bar[XB_TMO], 1u); break; } }
    }
    nloc = mine > 0u ? mine : 1u; nx = cnt > 0u ? cnt : 1u;
}
__device__ __forceinline__ void xcd_barrier(const XcdBarrier& b) {
    asm volatile("s_waitcnt vmcnt(0)" ::: "memory");
    __syncthreads();
    if (threadIdx.x == 0) {
        unsigned* bar = b.bar;
        __builtin_amdgcn_s_waitcnt(0);
        unsigned nloc = b.st[0], nx = b.st[1];
        if (nloc == 0u) { xcd_barrier_complete(bar, b.x, nloc, nx); b.st[0] = nloc; b.st[1] = nx; }
        const unsigned old = xb_add(&bar[XB_XSUB(b.x)], 1u);
        const unsigned gen = old / nloc;
        if (old + 1u == (gen + 1u) * nloc) {
            __builtin_amdgcn_fence(__ATOMIC_RELEASE, "agent");
            asm volatile("s_waitcnt vmcnt(0)" ::: "memory");
            const unsigned og = xb_add(&bar[XB_TOP], 1u);
            const unsigned tg = og / nx;
            if (og + 1u == (tg + 1u) * nx) xb_add(&bar[XB_TOPGEN], 1u);
            else XB_SPIN(xb_ld(&bar[XB_TOPGEN]) == tg, bar);
            __builtin_amdgcn_fence(__ATOMIC_ACQUIRE, "agent");
            xb_add(&bar[XB_XGEN(b.x)], 1u);
            asm volatile("s_waitcnt vmcnt(0)" ::: "memory");
        } else {
            XB_SPIN(xb_ld(&bar[XB_XGEN(b.x)]) == gen, bar);
            __builtin_amdgcn_fence(__ATOMIC_ACQUIRE, "agent");
            asm volatile("s_waitcnt vmcnt(0)" ::: "memory");
        }
    }
    __syncthreads();
}
namespace pg8 {
constexpr int BM = 256, BK = 64, HALF = 128, HTB = HALF * BK * 2, STAGE_BYTES = 8 * HTB, NXCD = 8, WGM = 8;
__host__ __device__ __forceinline__ int lds_byte(int r, int c) { const int st = (r >> 4) * 2 + (c >> 5), rr = r & 15, cc = c & 31, ob = rr * 64 + cc * 2; return st * 1024 + (ob ^ (((ob >> 9) & 1) << 5)); }
__host__ __device__ __forceinline__ void stage_rc(int b, int& R, int& C) { const int st = b / 1024, sb = b % 1024, swz = sb ^ (((sb >> 9) & 1) << 5); R = (st >> 1) * 16 + swz / 64; C = (st & 1) * 32 + (swz % 64) / 2; }
__host__ __device__ __forceinline__ int perm32(int rho) { const int n = rho >> 4, i = rho & 15; return 8 * (i >> 2) + 4 * n + (i & 3); }

struct Unit { int pm, pn, aux; const char* A; const char* B; };

struct TileOrder {
    int nM, nN, nAux, nwg, G, c;
    __device__ __forceinline__ void init(int nM_, int nN_, int nAux_, int G_, int c_) { nM = nM_; nN = nN_; nAux = nAux_; nwg = nM * nN * nAux; G = G_; c = c_; }
    __device__ __forceinline__ bool map(int i, int& aux, int& pm, int& pn) const {
        const long L = (long)i * G + c; if (L >= nwg) return false;
        int wgid = (int)L; { const int q = nwg / NXCD, r = nwg % NXCD, xcd = wgid % NXCD, off = wgid / NXCD; wgid = (xcd < r ? xcd * (q + 1) : r * (q + 1) + (xcd - r) * q) + off; }
        const int per = nM * nN; aux = wgid / per; wgid -= aux * per;
        const int nig = WGM * nN, gid = wgid / nig, fm = gid * WGM, gsz = (nM - fm) < WGM ? (nM - fm) : WGM;
        pm = fm + ((wgid % nig) % gsz); pn = (wgid % nig) / gsz; return true;
    }
};
struct PlainSched {
    static constexpr bool GATHER = false;
    TileOrder o; const char* A0; const char* B0; size_t sA, sB, tA, tB;
    __device__ __forceinline__ void init(const void* A, const void* B, int lda, int ldb, int nM, int nN, int nAux, size_t sA_, size_t sB_, int G, int c) {
        o.init(nM, nN, nAux, G, c); A0 = (const char*)A; B0 = (const char*)B; sA = sA_; sB = sB_; tA = (size_t)BM * lda * 2; tB = (size_t)BM * ldb * 2; }
    __device__ __forceinline__ bool next(int i, Unit& u) const {
        if (!o.map(i, u.aux, u.pm, u.pn)) return false;
        u.A = A0 + (size_t)u.aux * sA + (size_t)u.pm * tA; u.B = B0 + (size_t)u.aux * sB + (size_t)u.pn * tB; return true; }
    __device__ __forceinline__ unsigned arow(const Unit&, int) const { return 0u; }
};

template <class Epi, class Sched>
__device__ __forceinline__ void gemm_phase(LAS unsigned char* lds, const int lda, const int ldb, const int K, const Sched& S, const Epi& E) {
    const int tid = threadIdx.x, wid = __builtin_amdgcn_readfirstlane(tid >> 6), lane = tid & 63, wr = wid >> 2, wc = wid & 3, fr = lane & 15, fq = lane >> 4;
    int K_o = K; asm volatile("" : "+s"(K_o));
    const int nt = K_o / BK;
    unsigned voffA[2], voffB[2]; int RA[2], CA2[2];
#pragma unroll
    for (int i = 0; i < 2; ++i) { int R, C; stage_rc(tid * 16 + i * 8192, R, C); const int Rb = Epi::PERM ? ((R & ~31) + perm32(R & 31)) : R;
        RA[i] = R; CA2[i] = C * 2; voffA[i] = (unsigned)(R * lda + C) * 2u; voffB[i] = (unsigned)(Rb * ldb + C) * 2u; }
    const size_t kstep = (size_t)(BK * 2);
    const size_t hstepA = (size_t)HALF * lda * 2, hstepB = (size_t)HALF * ldb * 2;
    const unsigned ldsw = (unsigned)wid * 1024u;
    const int aoff = lds_byte(wr * 64 + fr, fq * 8), boff = lds_byte(wc * 32 + fr, fq * 8);
#define PG8_SA(b, h) (((b) * 2 + (h)) * HTB)
#define PG8_SB(b, h) ((4 + (b) * 2 + (h)) * HTB)
#define PG8_STAGE(bufoff, gbase, voff) do { _Pragma("unroll") for (int _i = 0; _i < 2; ++_i) \
        __builtin_amdgcn_global_load_lds((const unsigned*)((const char*)(gbase) + (voff)[_i]), (LAS unsigned*)(lds + (bufoff) + ldsw + _i * 8192), 16, 0, 0); } while (0)
#define PG8_LDA(dst, b, h) do { _Pragma("unroll") for (int m = 0; m < 4; ++m) _Pragma("unroll") for (int k = 0; k < 2; ++k) dst[m][k] = *(const LAS bf16x8*)(lds + PG8_SA(b, h) + aoff + m * 2048 + k * 1024); } while (0)
#define PG8_LDB(dst, b, h) do { _Pragma("unroll") for (int n = 0; n < 2; ++n) _Pragma("unroll") for (int k = 0; k < 2; ++k) dst[n][k] = *(const LAS bf16x8*)(lds + PG8_SB(b, h) + boff + n * 2048 + k * 1024); } while (0)
#define PG8_MMA(ai, bj, At, Bt) do { __builtin_amdgcn_s_setprio(1); _Pragma("unroll") for (int m = 0; m < 4; ++m) _Pragma("unroll") for (int n = 0; n < 2; ++n) _Pragma("unroll") for (int k = 0; k < 2; ++k) \
        acc[ai][bj][m][n] = __builtin_amdgcn_mfma_f32_16x16x32_bf16(Bt[n][k], At[m][k], acc[ai][bj][m][n], 0, 0, 0); __builtin_amdgcn_s_setprio(0); } while (0)
#define PG8_WAIT_V(n) asm volatile("s_waitcnt vmcnt(" #n ")" ::: "memory")
#define PG8_WAIT_L(n) asm volatile("s_waitcnt lgkmcnt(" #n ")" ::: "memory")
#define PG8_BAR __builtin_amdgcn_s_barrier()
#define PG8_SCHED __builtin_amdgcn_sched_barrier(0)
    Unit cur, nxt; int ui = 0;
    if (!S.next(0, cur)) return;
    f32x4 acc[2][2][4][2];
#pragma unroll
    for (int a = 0; a < 2; ++a)
#pragma unroll
        for (int b = 0; b < 2; ++b)
#pragma unroll
            for (int m = 0; m < 4; ++m)
#pragma unroll
                for (int n = 0; n < 2; ++n) acc[a][b][m][n] = (f32x4){0.f, 0.f, 0.f, 0.f};
    bf16x8 At[4][2], B0[2][2], B1[2][2];
    const char* cA = cur.A; const char* cB = cur.B;
    unsigned voA0[2], voA1[2], vnA0[2], vnA1[2];
    if constexpr (Sched::GATHER) {
#pragma unroll
        for (int i = 0; i < 2; ++i) { voA0[i] = S.arow(cur, RA[i]) * (unsigned)(lda * 2) + (unsigned)CA2[i]; voA1[i] = S.arow(cur, HALF + RA[i]) * (unsigned)(lda * 2) + (unsigned)CA2[i]; vnA0[i] = voA0[i]; vnA1[i] = voA1[i]; }
    }
    if constexpr (Sched::GATHER) {
        PG8_STAGE(PG8_SB(0, 0), cB, voffB); PG8_STAGE(PG8_SB(0, 1), cB + hstepB, voffB); PG8_STAGE(PG8_SA(0, 0), cA, voA0); PG8_STAGE(PG8_SA(0, 1), cA, voA1);
        if (wr == 1) PG8_BAR;
        PG8_WAIT_V(2); PG8_BAR;
        PG8_STAGE(PG8_SB(1, 0), cB + kstep, voffB); PG8_STAGE(PG8_SA(1, 0), cA + kstep, voA0); PG8_STAGE(PG8_SB(1, 1), cB + hstepB + kstep, voffB);
        PG8_WAIT_V(6); PG8_BAR;
    } else {
        PG8_STAGE(PG8_SB(0, 0), cB, voffB); PG8_STAGE(PG8_SB(0, 1), cB + hstepB, voffB); PG8_STAGE(PG8_SA(0, 0), cA, voffA); PG8_STAGE(PG8_SA(0, 1), cA + hstepA, voffA);
        if (wr == 1) PG8_BAR;
        PG8_WAIT_V(2); PG8_BAR;
        PG8_STAGE(PG8_SB(1, 0), cB + kstep, voffB); PG8_STAGE(PG8_SA(1, 0), cA + kstep, voffA); PG8_STAGE(PG8_SB(1, 1), cB + hstepB + kstep, voffB);
        PG8_WAIT_V(6); PG8_BAR;
    }
    for (;;) {
        const bool has_next = S.next(ui + 1, nxt);
        const char* nA = has_next ? nxt.A : cA; const char* nB = has_next ? nxt.B : cB;
        if constexpr (Sched::GATHER) {
            if (has_next) {
#pragma unroll
                for (int i = 0; i < 2; ++i) { vnA0[i] = S.arow(nxt, RA[i]) * (unsigned)(lda * 2) + (unsigned)CA2[i]; vnA1[i] = S.arow(nxt, HALF + RA[i]) * (unsigned)(lda * 2) + (unsigned)CA2[i]; }
            } else {
#pragma unroll
                for (int i = 0; i < 2; ++i) { vnA0[i] = voA0[i]; vnA1[i] = voA1[i]; }
            }
        }
        for (int t = 0; t < nt; t += 2) {
            const bool last = (t == nt - 2);
            const char* a1 = cA + (size_t)(t + 1) * kstep;
            const char* a2 = last ? nA : cA + (size_t)(t + 2) * kstep; const char* b2 = last ? nB : cB + (size_t)(t + 2) * kstep;
            const char* a3 = a2 + kstep; const char* b3 = b2 + kstep;
            unsigned o20[2], o21[2];
            if constexpr (Sched::GATHER) {
#pragma unroll
                for (int i = 0; i < 2; ++i) { o20[i] = last ? vnA0[i] : voA0[i]; o21[i] = last ? vnA1[i] : voA1[i]; }
            }
            PG8_LDB(B0, 0, 0); PG8_LDB(B1, 0, 1); PG8_SCHED; PG8_LDA(At, 0, 0);
            if constexpr (Sched::GATHER) { PG8_STAGE(PG8_SA(1, 1), a1, voA1); } else { PG8_STAGE(PG8_SA(1, 1), a1 + hstepA, voffA); }
            PG8_WAIT_V(8); PG8_WAIT_L(0); PG8_BAR; PG8_MMA(0, 0, At, B0); PG8_MMA(0, 1, At, B1); PG8_BAR; PG8_SCHED;
            PG8_LDA(At, 0, 1); PG8_STAGE(PG8_SB(0, 0), b2, voffB); PG8_STAGE(PG8_SB(0, 1), b2 + hstepB, voffB);
            if constexpr (Sched::GATHER) { PG8_STAGE(PG8_SA(0, 0), a2, o20); } else { PG8_STAGE(PG8_SA(0, 0), a2, voffA); }
            PG8_WAIT_V(8); PG8_WAIT_L(0); PG8_BAR; PG8_MMA(1, 0, At, B0); PG8_MMA(1, 1, At, B1); PG8_BAR; PG8_SCHED;
            PG8_LDB(B0, 1, 0); PG8_LDB(B1, 1, 1); PG8_SCHED; PG8_LDA(At, 1, 0);
            if constexpr (Sched::GATHER) { PG8_STAGE(PG8_SA(0, 1), a2, o21); } else { PG8_STAGE(PG8_SA(0, 1), a2 + hstepA, voffA); }
            PG8_WAIT_V(8); PG8_WAIT_L(0); PG8_BAR; PG8_MMA(0, 0, At, B0); PG8_MMA(0, 1, At, B1); PG8_BAR; PG8_SCHED;
            PG8_LDA(At, 1, 1); PG8_STAGE(PG8_SB(1, 0), b3, voffB); PG8_STAGE(PG8_SB(1, 1), b3 + hstepB, voffB);
            if constexpr (Sched::GATHER) { PG8_STAGE(PG8_SA(1, 0), a3, o20); } else { PG8_STAGE(PG8_SA(1, 0), a3, voffA); }
            PG8_WAIT_V(8); PG8_WAIT_L(0); PG8_BAR; PG8_MMA(1, 0, At, B0); PG8_MMA(1, 1, At, B1); PG8_BAR; PG8_SCHED;
        }
        if (wr == 0) PG8_BAR;
        E(acc, cur, wr, wc, fr, fq);
        if (!has_next) break;
#pragma unroll
        for (int a = 0; a < 2; ++a)
#pragma unroll
            for (int b = 0; b < 2; ++b)
#pragma unroll
                for (int m = 0; m < 4; ++m)
#pragma unroll
                    for (int n = 0; n < 2; ++n) acc[a][b][m][n] = (f32x4){0.f, 0.f, 0.f, 0.f};
        cur = nxt; cA = nA; cB = nB; ++ui;
        if constexpr (Sched::GATHER) {
#pragma unroll
            for (int i = 0; i < 2; ++i) { voA0[i] = vnA0[i]; voA1[i] = vnA1[i]; }
        }
        if (wr == 1) PG8_BAR;
    }
    PG8_WAIT_V(0);
    PG8_BAR;
#undef PG8_SA
#undef PG8_SB
#undef PG8_STAGE
#undef PG8_LDA
#undef PG8_LDB
#undef PG8_MMA
#undef PG8_WAIT_V
#undef PG8_WAIT_L
#undef PG8_BAR
#undef PG8_SCHED
}

struct EpiBf16 {
    static constexpr bool PERM = true;
    bf16_t* O; int ldc; float scale; size_t aux_stride;
    __device__ __forceinline__ void operator()(const f32x4 (&acc)[2][2][4][2], const Unit& u, int wr, int wc, int fr, int fq) const {
        const int row0 = u.pm * BM + wr * 64 + fr, col0 = u.pn * BM + wc * 32 + 8 * fq; bf16_t* base = O + (size_t)u.aux * aux_stride;
#pragma unroll
        for (int ai = 0; ai < 2; ++ai)
#pragma unroll
            for (int m = 0; m < 4; ++m) { bf16_t* rowp = base + (size_t)(row0 + ai * HALF + m * 16) * ldc + col0;
#pragma unroll
                for (int bj = 0; bj < 2; ++bj) { const f32x4 v0 = acc[ai][bj][m][0] * scale, v1 = acc[ai][bj][m][1] * scale;
                    u32x4 w; w.x = cvt_pk_bf16(v0[0], v0[1]); w.y = cvt_pk_bf16(v0[2], v0[3]); w.z = cvt_pk_bf16(v1[0], v1[1]); w.w = cvt_pk_bf16(v1[2], v1[3]);
                    *(u32x4*)(rowp + bj * HALF) = w; } }
    }
};
struct EpiSwiGLU {
    static constexpr bool PERM = true;
    bf16_t* O; int ldc;
    __device__ __forceinline__ void operator()(const f32x4 (&acc)[2][2][4][2], const Unit& u, int wr, int wc, int fr, int fq) const {
        const int row0 = u.pm * BM + wr * 64 + fr, col0 = u.pn * HALF + wc * 32 + 8 * fq;
#pragma unroll
        for (int ai = 0; ai < 2; ++ai)
#pragma unroll
            for (int m = 0; m < 4; ++m) { bf16_t* rowp = O + (size_t)(row0 + ai * HALF + m * 16) * ldc + col0;
                f32x4 h0, h1;
#pragma unroll
                for (int j = 0; j < 4; ++j) { const float g0 = acc[ai][0][m][0][j], g1 = acc[ai][0][m][1][j];
                    h0[j] = g0 * __builtin_amdgcn_rcpf(1.0f + __expf(-g0)) * acc[ai][1][m][0][j]; h1[j] = g1 * __builtin_amdgcn_rcpf(1.0f + __expf(-g1)) * acc[ai][1][m][1][j]; }
                u32x4 w; w.x = cvt_pk_bf16(h0[0], h0[1]); w.y = cvt_pk_bf16(h0[2], h0[3]); w.z = cvt_pk_bf16(h1[0], h1[1]); w.w = cvt_pk_bf16(h1[2], h1[3]);
                *(u32x4*)rowp = w; }
    }
};
struct EpiResGate {
    static constexpr bool PERM = false;
    const float* xin; float* out; const float* gate; int gstride; const float* bias;
    __device__ __forceinline__ void operator()(const f32x4 (&acc)[2][2][4][2], const Unit& u, int wr, int wc, int fr, int fq) const {
        const int row0 = u.pm * BM + wr * 64 + fr, col0 = u.pn * BM + wc * 32 + 4 * fq;
        const float* gp = gate + (size_t)((u.pm * BM) / SEQ) * gstride + col0;
        f32x4 gv[2][2], bv[2][2];
#pragma unroll
        for (int bj = 0; bj < 2; ++bj)
#pragma unroll
            for (int n = 0; n < 2; ++n) { gv[bj][n] = *(const f32x4*)(gp + bj * HALF + n * 16); bv[bj][n] = bias ? *(const f32x4*)(bias + col0 + bj * HALF + n * 16) : (f32x4){0.f, 0.f, 0.f, 0.f}; }
#pragma unroll
        for (int ai = 0; ai < 2; ++ai)
#pragma unroll
            for (int m = 0; m < 4; ++m) { const size_t off = (size_t)(row0 + ai * HALF + m * 16) * DM + col0;
#pragma unroll
                for (int bj = 0; bj < 2; ++bj)
#pragma unroll
                    for (int n = 0; n < 2; ++n) { const f32x4 xv = *(const f32x4*)(xin + off + bj * HALF + n * 16);
                        *(f32x4*)(out + off + bj * HALF + n * 16) = xv + gv[bj][n] * (acc[ai][bj][m][n] + bv[bj][n]); } }
    }
};
struct EpiChanDFT {
    static constexpr bool PERM = true;
    bf16_t* ZT;
    __device__ __forceinline__ void operator()(const f32x4 (&acc)[2][2][4][2], const Unit& u, int wr, int wc, int fr, int fq) const {
        const int tok0 = u.pn * BM, b = tok0 / SEQ, s0 = tok0 % SEQ + wc * 32 + 8 * fq;
        const unsigned base = (unsigned)((b * DM + u.aux * 256 + wr * 64 + fr) * 8192 + u.pm * 4096 + s0);
#pragma unroll
        for (int ai = 0; ai < 2; ++ai)
#pragma unroll
            for (int m = 0; m < 4; ++m)
#pragma unroll
                for (int bj = 0; bj < 2; ++bj) { const f32x4 v0 = acc[ai][bj][m][0], v1 = acc[ai][bj][m][1];
                    u32x4 w; w.x = cvt_pk_bf16(v0[0], v0[1]); w.y = cvt_pk_bf16(v0[2], v0[3]); w.z = cvt_pk_bf16(v1[0], v1[1]); w.w = cvt_pk_bf16(v1[2], v1[3]);
                    *(u32x4*)(ZT + (base + (unsigned)((ai * HALF + m * 16) * 8192 + bj * HALF))) = w; }
    }
};
}
namespace att {
constexpr int NW = 8, QBLK = 32, KVBLK = 64, DV = 128;
constexpr float THR = 8.f;
#define SBAR() __builtin_amdgcn_sched_barrier(0)
__device__ __forceinline__ int crow(int r, int hi) { return (r & 3) + 8 * (r >> 2) + 4 * hi; }
__device__ __forceinline__ int v_st(int k, int c) { const int kk = (k & ~0xC) | ((k & 4) << 1) | ((k & 8) >> 1); return ((kk >> 3) * 4 + (c >> 5)) * 512 + ((kk & 7) * 32 + (c & 31)) * 2; }
__device__ __forceinline__ int v_rd_base(int lane) { return ((lane & 3) << 3) | (((lane >> 2) & 3) << 6) | (((lane >> 4) & 1) << 5) | (((lane >> 5) & 1) << 8); }
constexpr int v_rd_off(int d0, int ks, int half) { return d0 * 512 + ks * 4096 + half * 2048; }
template <int OFF> __device__ __forceinline__ s16x4 tr_read(int vb) {
  s16x4 r; asm volatile("ds_read_b64_tr_b16 %0, %1 offset:%2" : "=&v"(r) : "v"(vb), "i"(OFF) : "memory"); return r;
}
template <int D0> __device__ __forceinline__ void pv_one(f32x16& od, int vb, bf16x8 pa0, bf16x8 pa1, bf16x8 pa2, bf16x8 pa3) {
  const s16x4 l0 = tr_read<v_rd_off(D0, 0, 0)>(vb), h0 = tr_read<v_rd_off(D0, 0, 1)>(vb), l1 = tr_read<v_rd_off(D0, 1, 0)>(vb), h1 = tr_read<v_rd_off(D0, 1, 1)>(vb);
  const s16x4 l2 = tr_read<v_rd_off(D0, 2, 0)>(vb), h2 = tr_read<v_rd_off(D0, 2, 1)>(vb), l3 = tr_read<v_rd_off(D0, 3, 0)>(vb), h3 = tr_read<v_rd_off(D0, 3, 1)>(vb);
  asm volatile("s_waitcnt lgkmcnt(0)" ::: "memory"); SBAR();
#define PK(L, H) (bf16x8){L[0], L[1], L[2], L[3], H[0], H[1], H[2], H[3]}
  od = __builtin_amdgcn_mfma_f32_32x32x16_bf16(pa0, PK(l0, h0), od, 0, 0, 0);
  od = __builtin_amdgcn_mfma_f32_32x32x16_bf16(pa1, PK(l1, h1), od, 0, 0, 0);
  od = __builtin_amdgcn_mfma_f32_32x32x16_bf16(pa2, PK(l2, h2), od, 0, 0, 0);
  od = __builtin_amdgcn_mfma_f32_32x32x16_bf16(pa3, PK(l3, h3), od, 0, 0, 0);
#undef PK
}
__device__ __forceinline__ void pv_d0(f32x16* o, int vb, bf16x8 pa0, bf16x8 pa1, bf16x8 pa2, bf16x8 pa3) {
  pv_one<0>(o[0], vb, pa0, pa1, pa2, pa3); pv_one<1>(o[1], vb, pa0, pa1, pa2, pa3); pv_one<2>(o[2], vb, pa0, pa1, pa2, pa3); pv_one<3>(o[3], vb, pa0, pa1, pa2, pa3);
}
template <int DK>
__device__ __forceinline__ void partialSM(f32x16& p0, f32x16& p1, float& m_reg, float& mn, float& alpha, bool masked, int dq, int hi) {
  constexpr float SCALE = (DK == 128) ? 0.088388347648318440f : 0.072168783648703220f;
  constexpr float C = SCALE * 1.4426950408889634f;
  if (masked) {
#pragma unroll
    for (int r = 0; r < 16; ++r) { const int d0 = dq - crow(r, hi), d1 = d0 - 32;
      p0[r] = (d0 <= 128 && d0 >= -128) ? p0[r] : -1e30f; p1[r] = (d1 <= 128 && d1 >= -128) ? p1[r] : -1e30f; }
  }
  float pmax = p0[0];
#pragma unroll
  for (int r = 1; r < 16; ++r) pmax = fmaxf(pmax, p0[r]);
#pragma unroll
  for (int r = 0; r < 16; ++r) pmax = fmaxf(pmax, p1[r]);
  { auto rr = __builtin_amdgcn_permlane32_swap(__float_as_uint(pmax), __float_as_uint(pmax), false, false);
    pmax = fmaxf(__uint_as_float(rr[0]), __uint_as_float(rr[1])); }
  if (__builtin_expect(__all(pmax - m_reg <= THR / SCALE), 1)) { mn = m_reg; alpha = 1.f; }
  else { mn = fmaxf(m_reg, pmax); alpha = __builtin_amdgcn_exp2f((m_reg - mn) * C); m_reg = mn; }
  const float mnC = -mn * C;
#pragma unroll
  for (int r = 0; r < 16; ++r) p0[r] = fmaf(p0[r], C, mnC);
#pragma unroll
  for (int r = 0; r < 16; ++r) p1[r] = fmaf(p1[r], C, mnC);
#pragma unroll
  for (int r = 0; r < 16; ++r) p0[r] = __builtin_amdgcn_exp2f(p0[r]);
}
__device__ __forceinline__ void finishSM(f32x16& p0, f32x16& p1, float alpha, float& l_reg, bf16x8& pa0, bf16x8& pa1, bf16x8& pa2, bf16x8& pa3) {
#pragma unroll
  for (int r = 0; r < 16; ++r) p1[r] = __builtin_amdgcn_exp2f(p1[r]);
  float ps = 0;
#pragma unroll
  for (int r = 0; r < 16; ++r) ps += p0[r];
#pragma unroll
  for (int r = 0; r < 16; ++r) ps += p1[r];
  { auto rr = __builtin_amdgcn_permlane32_swap(__float_as_uint(ps), __float_as_uint(ps), false, false);
    ps = __uint_as_float(rr[0]) + __uint_as_float(rr[1]); }
  l_reg = l_reg * alpha + ps;
#define PK4(P, BASE, OUT) do { unsigned a0 = cvt_pk_bf16(P[BASE + 0], P[BASE + 1]), a1 = cvt_pk_bf16(P[BASE + 2], P[BASE + 3]);   \
    unsigned b0 = cvt_pk_bf16(P[BASE + 4], P[BASE + 5]), b1 = cvt_pk_bf16(P[BASE + 6], P[BASE + 7]);                              \
    auto r0 = __builtin_amdgcn_permlane32_swap(a0, b0, false, false); auto r1 = __builtin_amdgcn_permlane32_swap(a1, b1, false, false); \
    u32x4 w = {r0[0], r1[0], r0[1], r1[1]}; OUT = *reinterpret_cast<bf16x8*>(&w); } while (0)
  PK4(p0, 0, pa0); PK4(p0, 8, pa1); PK4(p1, 0, pa2); PK4(p1, 8, pa3);
#undef PK4
}
template <int DK> __device__ __forceinline__ int kswz(int row, int colB) { return row * (DK * 2) + (colB ^ ((row & 7) << 4)); }
template <int DK>
__device__ __forceinline__ void qkt(f32x16& p0, f32x16& p1, const char* Ks, const bf16x8* qr, int r32, int hi) {
  p0 = f32x16{}; p1 = f32x16{};
#pragma unroll
  for (int d0 = 0; d0 < DK / 16; ++d0) { const int cb = (d0 * 16 + hi * 8) * 2;
    const bf16x8 b0 = *reinterpret_cast<const bf16x8*>(Ks + kswz<DK>(r32, cb));
    const bf16x8 b1 = *reinterpret_cast<const bf16x8*>(Ks + kswz<DK>(32 + r32, cb));
    p0 = __builtin_amdgcn_mfma_f32_32x32x16_bf16(b0, qr[d0], p0, 0, 0, 0);
    p1 = __builtin_amdgcn_mfma_f32_32x32x16_bf16(b1, qr[d0], p1, 0, 0, 0);
    if ((d0 & 3) == 3) SBAR(); }
}

template <int DK, bool WINDOW>
__device__ __forceinline__ void attn_unit(const bf16_t* __restrict__ Qb, int ldq, const bf16_t* __restrict__ Kh, const bf16_t* __restrict__ Vh, bf16_t* __restrict__ Ob, int ldo,
                                          int NT, int ks, int q0, float sink, char* lds) {
  constexpr float SCALE = (DK == 128) ? 0.088388347648318440f : 0.072168783648703220f;
  constexpr int SHM_K = KVBLK * DK * 2, SHM_V = KVBLK * DV * 2, NKC = DK / 64, KCH = DK / 8;
  int tid_o = threadIdx.x; asm volatile("" : "+v"(tid_o));
  const int tid = tid_o, wid = tid >> 6, lane = tid & 63, r32 = lane & 31, hi = lane >> 5;
  char* V_lds = lds; char* K_lds = lds + 2 * SHM_V;
  float* ws = (float*)(lds + 2 * SHM_V + 2 * SHM_K) + wid * 64; float* li_l = ws; float* al_l = ws + 32;
  float m_reg = WINDOW ? sink / SCALE : -1e30f, l_reg = WINDOW ? 1.f : 0.f;
  f32x16 o[4] = {}; bf16x8 qr[DK / 16];
  const bf16_t* Qw = Qb + (long)(wid * QBLK + r32) * ldq + hi * 8;
#pragma unroll
  for (int d0 = 0; d0 < DK / 16; ++d0) qr[d0] = *reinterpret_cast<const bf16x8*>(Qw + d0 * 16);
  const int sr = tid >> 4, sc = (tid & 15) * 8, vst0 = v_st(sr, sc), vst1 = v_st(32 + sr, sc);
  int krow[NKC], kcc[NKC];
#pragma unroll
  for (int i = 0; i < NKC; ++i) { const int c = tid + 512 * i; krow[i] = c / KCH; kcc[i] = c % KCH; }
  const int vb0 = (int)(uintptr_t)V_lds + v_rd_base(lane);
  const int qpos = q0 + wid * QBLK + r32;
  bf16x8 vs0, vs1, ksr[NKC];
#define TROW(j) (64 * (j) + ((WINDOW && (j) >= 4) ? ks : 0))
#define SLOAD(j) do { const long _k0 = TROW(j); vs0 = *reinterpret_cast<const bf16x8*>(&Vh[(_k0 + sr) * DV + sc]); vs1 = *reinterpret_cast<const bf16x8*>(&Vh[(_k0 + 32 + sr) * DV + sc]); \
    _Pragma("unroll") for (int _i = 0; _i < NKC; ++_i) ksr[_i] = *reinterpret_cast<const bf16x8*>(&Kh[(_k0 + krow[_i]) * DK + kcc[_i] * 8]); } while (0)
#define SWRITE(b) do { *(bf16x8*)(V_lds + (b) * SHM_V + vst0) = vs0; *(bf16x8*)(V_lds + (b) * SHM_V + vst1) = vs1; \
    _Pragma("unroll") for (int _i = 0; _i < NKC; ++_i) *(bf16x8*)(K_lds + (b) * SHM_K + kswz<DK>(krow[_i], kcc[_i] * 16)) = ksr[_i]; } while (0)
#define SWAIT() asm volatile("s_waitcnt vmcnt(0)" ::: "memory")
#define RESC(a) do { if (__any((a) < 1.f)) { if (hi == 0) al_l[r32] = (a); asm volatile("s_waitcnt lgkmcnt(0)" ::: "memory"); \
    _Pragma("unroll") for (int d = 0; d < 4; ++d) _Pragma("unroll") for (int r = 0; r < 16; ++r) o[d][r] *= al_l[crow(r, hi)]; } } while (0)
#define MASKED(j) (WINDOW && (j) >= 4)
#define DQ(j) (qpos - (ks + 64 * ((j) - 4)))
  f32x16 p0, p1; float mn, al; bf16x8 pa0, pa1, pa2, pa3;
  SLOAD(0); SWAIT(); SWRITE(0); __syncthreads();
  for (int j = 0; j < NT; ++j) {
    const int bsel = j & 1;
    if (j + 1 < NT) SLOAD(j + 1);
    SBAR(); qkt<DK>(p0, p1, K_lds + bsel * SHM_K, qr, r32, hi);
    partialSM<DK>(p0, p1, m_reg, mn, al, MASKED(j), DQ(j), hi);
    RESC(al);
    finishSM(p0, p1, al, l_reg, pa0, pa1, pa2, pa3); SBAR();
    pv_d0(o, vb0 + bsel * SHM_V, pa0, pa1, pa2, pa3);
    if (j + 1 < NT) { SWAIT(); SWRITE(bsel ^ 1); }
    __syncthreads();
  }
  if (hi == 0) li_l[r32] = l_reg; asm volatile("s_waitcnt lgkmcnt(0)" ::: "memory");
  float rli[16];
#pragma unroll
  for (int r = 0; r < 16; ++r) rli[r] = __builtin_amdgcn_rcpf(li_l[crow(r, hi)]);
  bf16_t* Ow = Ob + (long)(wid * QBLK) * ldo;
#pragma unroll
  for (int r = 0; r < 16; ++r) { const int orow = crow(r, hi);
#pragma unroll
    for (int d0 = 0; d0 < 4; ++d0) Ow[(long)orow * ldo + d0 * 32 + r32] = (bf16_t)f2bf(o[d0][r] * rli[r]); }
  __syncthreads();
#undef TROW
#undef SLOAD
#undef SWRITE
#undef SWAIT
#undef RESC
#undef MASKED
#undef DQ
}
}
struct Frame {
    LAS unsigned char* lds; volatile LAS unsigned* MISC; unsigned* ctl;
    int tid, lane, wave, vcu, G;
    const float *x, *c, *ctx, *c_ctx, *w_ada, *b_ada, *g_norm, *w_in, *g_aqn, *g_akn, *g_bq_lat, *w_bq_up, *g_bkv_lat, *w_bkv_up, *g_bqn, *g_bkn, *sink, *w_o, *w_fo, *b_fo, *w_router, *b_router, *w_gate, *w_up, *w_down;
    float* out; unsigned char* ws;
};
#define WSP(T_, off) ((T_*)(F.ws + (off)))

__device__ __forceinline__ void transpose_item(const float* W, int N, bf16_t* WT, int ldk, int k0, int n0, int drow0, LAS float* scr, int lane) {
#pragma unroll 8
    for (int i = 0; i < 32; ++i) { const int kk = 2 * i + (lane >> 5); scr[kk * 33 + (lane & 31)] = W[(size_t)(k0 + kk) * N + n0 + (lane & 31)]; }
    LDS_WAIT(); asm volatile("" ::: "memory");
    const int c = lane & 7;
#pragma unroll
    for (int j = 0; j < 4; ++j) { const int n = (lane >> 3) + 8 * j; const LAS float* s = scr + (8 * c) * 33 + n;
        u32x4 o; o.x = pk2(s[0 * 33], s[1 * 33]); o.y = pk2(s[2 * 33], s[3 * 33]); o.z = pk2(s[4 * 33], s[5 * 33]); o.w = pk2(s[6 * 33], s[7 * 33]);
        *(GAS u32x4*)(WT + (size_t)(drow0 + n) * ldk + k0 + 8 * c) = o; }
    LDS_WAIT(); asm volatile("" ::: "memory");
}
__device__ __forceinline__ void conv_plain(const float* W, int K, int N, bf16_t* WT, int item, LAS float* scr, int lane) {
    const int nblk = N / 32, kb = item / nblk, nb = item % nblk; transpose_item(W, N, WT, K, 64 * kb, 32 * nb, 32 * nb, scr, lane);
}

__device__ __forceinline__ void ada_task(Frame& F, int task, const LAS float* sl  ) {
    const int l = task / 768, n0 = (task % 768) * 16, kq = F.lane >> 2, c4 = F.lane & 3;
    const float* wp = F.w_ada + ((size_t)l * DM + kq) * 12288 + n0 + 4 * c4;
    f32x4 a0 = {0, 0, 0, 0}, a1 = a0, a2 = a0, a3 = a0, a4 = a0;
#pragma unroll 8
    for (int i = 0; i < 128; ++i) { const f32x4 w = *(const f32x4*)(wp + (size_t)i * 16 * 12288); const int k = kq + 16 * i;
        const f32x4 s = *(const LAS f32x4*)(sl + k * 8); const float s4 = sl[k * 8 + 4];
        a0 += w * s[0]; a1 += w * s[1]; a2 += w * s[2]; a3 += w * s[3]; a4 += w * s4; }
#pragma unroll
    for (int o = 4; o < 64; o <<= 1) {
#pragma unroll
        for (int j = 0; j < 4; ++j) { a0[j] += __shfl_xor(a0[j], o); a1[j] += __shfl_xor(a1[j], o); a2[j] += __shfl_xor(a2[j], o); a3[j] += __shfl_xor(a3[j], o); a4[j] += __shfl_xor(a4[j], o); } }
    if (kq == 0) { const f32x4 bv = *(const f32x4*)(F.b_ada + (size_t)l * 12288 + n0 + 4 * c4); float* mp = WSP(float, WS_MOD) + (size_t)l * 5 * 12288 + n0 + 4 * c4;
        *(f32x4*)(mp) = a0 + bv; *(f32x4*)(mp + 12288) = a1 + bv; *(f32x4*)(mp + 2 * 12288) = a2 + bv; *(f32x4*)(mp + 3 * 12288) = a3 + bv; *(f32x4*)(mp + 4 * 12288) = a4 + bv; }
}

__device__ __forceinline__ void p0_prologue(Frame& F) {
    const int gw = F.vcu * NWAVES + F.wave, NGW = F.G * NWAVES;
    LAS float* sl = (LAS float*)(F.lds);
    for (int i = F.tid; i < DM * 5; i += NTHR) { const int r = i / DM, k = i % DM; const float v = r < 4 ? F.c[r * DM + k] : F.c_ctx[k]; sl[k * 8 + r] = silu_f(v); }
    __syncthreads();
    for (int task = gw; task < 2 * 768; task += NGW) ada_task(F, task, sl);
    __syncthreads();
    LAS float* scr = (LAS float*)(F.lds + F.wave * 16384);
    constexpr int I_IN = (DM / 64) * (INW / 32), I_BQ = (512 / 64) * (1536 / 32), I_BKV = (256 / 64) * (2048 / 32), I_SQ = (DM / 64) * (DM / 32), I_E = (DM / 64) * (DE / 32)  ;
    constexpr int NITEMS = I_IN + I_BQ + I_BKV + 2 * I_SQ + 3 * 32 * I_E;
    for (int it = gw; it < NITEMS; it += NGW) {
        int r = it;
        if (r < I_IN) { conv_plain(F.w_in, DM, INW, WSP(bf16_t, WS_WIN_T), r, scr, F.lane); continue; } r -= I_IN;
        if (r < I_BQ) { conv_plain(F.w_bq_up, 512, 1536, WSP(bf16_t, WS_WBQ_T), r, scr, F.lane); continue; } r -= I_BQ;
        if (r < I_BKV) { conv_plain(F.w_bkv_up, 256, 2048, WSP(bf16_t, WS_WBKV_T), r, scr, F.lane); continue; } r -= I_BKV;
        if (r < I_SQ) { conv_plain(F.w_o, DM, DM, WSP(bf16_t, WS_WO_T), r, scr, F.lane); continue; } r -= I_SQ;
        if (r < I_SQ) { conv_plain(F.w_fo, DM, DM, WSP(bf16_t, WS_WFO_T), r, scr, F.lane); continue; } r -= I_SQ;
        if (r < 32 * I_E) { const int le = r / I_E, item = r % I_E, nblk = DE / 32, kb = item / nblk, nb = item % nblk, n0 = 32 * nb;
            transpose_item(F.w_gate + (size_t)le * DM * DE, DE, WSP(bf16_t, WS_WGU_T) + (size_t)le * DM * DM, DM, 64 * kb, n0, (n0 >> 7) * 256 + (n0 & 127), scr, F.lane); continue; } r -= 32 * I_E;
        if (r < 32 * I_E) { const int le = r / I_E, item = r % I_E, nblk = DE / 32, kb = item / nblk, nb = item % nblk, n0 = 32 * nb;
            transpose_item(F.w_up + (size_t)le * DM * DE, DE, WSP(bf16_t, WS_WGU_T) + (size_t)le * DM * DM, DM, 64 * kb, n0, (n0 >> 7) * 256 + 128 + (n0 & 127), scr, F.lane); continue; } r -= 32 * I_E;
        { const int le = r / I_E; conv_plain(F.w_down + (size_t)le * DE * DM, DE, DM, WSP(bf16_t, WS_WD_T) + (size_t)le * DM * DE, r % I_E, scr, F.lane); }
    }
    { u32x4* z = (u32x4*)(WSP(bf16_t, WS_WIN_T) + (size_t)INW * DM); const int n16 = (INWP - INW) * DM * 2 / 16;
      for (int i = blockIdx.x * NTHR + F.tid; i < n16; i += F.G * NTHR) z[i] = (u32x4){0u, 0u, 0u, 0u}; }
    for (int i = blockIdx.x * NTHR + F.tid; i < 512 * 256 / 2; i += F.G * NTHR) { const int e = 2 * i, row = e >> 8, c0 = e & 255, j = row & 255; const bool isn = row >= 256;
        const float f0 = (float)((j * c0) & 255) * (1.0f / 256.0f), f1 = (float)((j * (c0 + 1)) & 255) * (1.0f / 256.0f);
        const float v0 = isn ? -__builtin_amdgcn_sinf(f0) : __builtin_amdgcn_cosf(f0), v1 = isn ? -__builtin_amdgcn_sinf(f1) : __builtin_amdgcn_cosf(f1);
        WSP(unsigned, WS_WC)[i] = pk2(v0, v1); }
    for (int i = blockIdx.x * NTHR + F.tid; i < 4096 * 8192 / 8; i += F.G * NTHR) { const int k = i >> 10, c8 = (i & 1023) * 8, isn = c8 >= 4096, s0 = c8 & 4095; float v[8];
#pragma unroll
        for (int q = 0; q < 8; ++q) { const float f = (float)((k * (s0 + q)) & 4095) * (1.0f / 4096.0f); v[q] = isn ? __builtin_amdgcn_sinf(f) : __builtin_amdgcn_cosf(f); }
        u32x4 w; w.x = pk2(v[0], v[1]); w.y = pk2(v[2], v[3]); w.z = pk2(v[4], v[5]); w.w = pk2(v[6], v[7]);
        WSP(u32x4, WS_WS)[i] = w; }
}

__device__ __forceinline__ void norm_mod_row(const float* xrow, const float* g, const float* sh, const float* sc, bf16_t* orow, int lane, f32x4 (&v)[8]) {
    const GAS f32x4* xr = (const GAS f32x4*)xrow + lane; float ss = 0.f;
#pragma unroll
    for (int j = 0; j < 8; ++j) { v[j] = xr[64 * j]; ss += (v[j].x * v[j].x + v[j].y * v[j].y) + (v[j].z * v[j].z + v[j].w * v[j].w); }
    const float rstd = 1.0f / sqrtf(wave_sum(ss) * (1.0f / DM) + EPS);
    GAS u32x2* o8 = (GAS u32x2*)orow + lane;
#pragma unroll
    for (int j = 0; j < 8; ++j) { const f32x4 gg = ((const GAS f32x4*)g)[lane + 64 * j], s1 = ((const GAS f32x4*)sc)[lane + 64 * j], s0 = ((const GAS f32x4*)sh)[lane + 64 * j];
        v[j] = (v[j] * rstd * gg) * (1.0f + s1) + s0; u32x2 w; w.x = pk2(v[j].x, v[j].y); w.y = pk2(v[j].z, v[j].w); o8[64 * j] = w; }
}
__device__ __forceinline__ const float* modp(Frame& F, int l, int r, int chunk) { return WSP(float, WS_MOD) + ((size_t)l * 5 + r) * 12288 + chunk * DM; }

__device__ __forceinline__ void p1_norm(Frame& F) {
    const int gw = F.vcu * NWAVES + F.wave, NGW = F.G * NWAVES; f32x4 v[8];
    for (int row = gw; row < TT; row += NGW) { const bool lat = row < T; const int r = lat ? row / SEQ : 4;
        const float* xr = lat ? F.x + (size_t)row * DM : F.ctx + (size_t)(row - T) * DM;
        norm_mod_row(xr, F.g_norm, modp(F, 0, r, 0), modp(F, 0, r, 1), WSP(bf16_t, WS_H) + (size_t)row * DM, F.lane, v); }
}


__device__ __forceinline__ void p3_post(Frame& F) {
    const int gw = F.vcu * NWAVES + F.wave, NGW = F.G * NWAVES, lane = F.lane, li = lane & 31, hh = lane >> 5;
    const bf16_t* P = WSP(bf16_t, WS_P);
    const float fr = __powf(10000.0f, -(float)li * (1.0f / 32.0f));
    float gq[4], gk[4];
#pragma unroll
    for (int q = 0; q < 4; ++q) { gq[q] = F.g_aqn[li + 32 * q]; gk[q] = F.g_akn[li + 32 * q]; }
    for (int row = gw; row < TT; row += NGW) {
        const bool lat = row < T; const int b = lat ? row / SEQ : (row - T) / CTX, s = lat ? row % SEQ : (row - T) % CTX, kpos = lat ? CTX + s : s;
        const bf16_t* pr = P + (size_t)row * INWP;
        float cr, sr_, cc, sc_; { const float ar = (float)(s / 64) * fr, ac = (float)(s % 64) * fr; sincosf(ar, &sr_, &cr); sincosf(ac, &sc_, &cc); }
        if (lat) {
#pragma unroll
            for (int ps = 0; ps < 4; ++ps) { const int head = 2 * ps + hh; float y[4]; float ss = 0.f;
#pragma unroll
                for (int q = 0; q < 4; ++q) { y[q] = bf2f(pr[head * 128 + li + 32 * q]); ss += y[q] * y[q]; }
                const float rstd = 1.0f / sqrtf(half_sum(ss) * (1.0f / 128.0f) + EPS);
#pragma unroll
                for (int q = 0; q < 4; ++q) y[q] = y[q] * rstd * gq[q];
                bf16_t* o = WSP(bf16_t, WS_QA) + (size_t)row * 1024 + head * 128 + li;
                o[0] = (bf16_t)f2bf(y[0] * cr - y[1] * sr_); o[32] = (bf16_t)f2bf(y[0] * sr_ + y[1] * cr); o[64] = (bf16_t)f2bf(y[2] * cc - y[3] * sc_); o[96] = (bf16_t)f2bf(y[2] * sc_ + y[3] * cc); }
            { const u32x4 w = *(const u32x4*)(pr + 1536 + 8 * lane); float y[8] = {bflo(w.x), bfhi(w.x), bflo(w.y), bfhi(w.y), bflo(w.z), bfhi(w.z), bflo(w.w), bfhi(w.w)}; float ss = 0.f;
#pragma unroll
              for (int q = 0; q < 8; ++q) ss += y[q] * y[q];
              const float rstd = 1.0f / sqrtf(wave_sum(ss) * (1.0f / 512.0f) + EPS);
              const f32x4 g0 = *(const f32x4*)(F.g_bq_lat + 8 * lane), g1 = *(const f32x4*)(F.g_bq_lat + 8 * lane + 4);
              u32x4 o; o.x = pk2(y[0] * rstd * g0.x, y[1] * rstd * g0.y); o.y = pk2(y[2] * rstd * g0.z, y[3] * rstd * g0.w); o.z = pk2(y[4] * rstd * g1.x, y[5] * rstd * g1.y); o.w = pk2(y[6] * rstd * g1.z, y[7] * rstd * g1.w);
              *(u32x4*)(WSP(bf16_t, WS_BQL) + (size_t)row * 512 + 8 * lane) = o; }
        }
        { float y[4]; float ss = 0.f;
#pragma unroll
          for (int q = 0; q < 4; ++q) { y[q] = bf2f(pr[1024 + hh * 128 + li + 32 * q]); ss += y[q] * y[q]; }
          const float rstd = 1.0f / sqrtf(half_sum(ss) * (1.0f / 128.0f) + EPS);
#pragma unroll
          for (int q = 0; q < 4; ++q) y[q] = y[q] * rstd * gk[q];
          bf16_t* o = WSP(bf16_t, WS_KA) + ((size_t)(b * 2 + hh) * KVLEN + kpos) * 128 + li;
          if (lat) { o[0] = (bf16_t)f2bf(y[0] * cr - y[1] * sr_); o[32] = (bf16_t)f2bf(y[0] * sr_ + y[1] * cr); o[64] = (bf16_t)f2bf(y[2] * cc - y[3] * sc_); o[96] = (bf16_t)f2bf(y[2] * sc_ + y[3] * cc); }
          else { o[0] = (bf16_t)f2bf(y[0]); o[32] = (bf16_t)f2bf(y[1]); o[64] = (bf16_t)f2bf(y[2]); o[96] = (bf16_t)f2bf(y[3]); } }
        { const u32x2 w = *(const u32x2*)(pr + 1280 + 4 * lane); const int d = 4 * lane, h2 = d >> 7;
          *(u32x2*)(WSP(bf16_t, WS_VA) + ((size_t)(b * 2 + h2) * KVLEN + kpos) * 128 + (d & 127)) = w; }
        { const u32x2 w = *(const u32x2*)(pr + 2048 + 4 * lane); float y[4] = {bflo(w.x), bfhi(w.x), bflo(w.y), bfhi(w.y)};
          const float ss = (y[0] * y[0] + y[1] * y[1]) + (y[2] * y[2] + y[3] * y[3]);
          const float rstd = 1.0f / sqrtf(wave_sum(ss) * (1.0f / 256.0f) + EPS); const f32x4 g0 = *(const f32x4*)(F.g_bkv_lat + 4 * lane);
          u32x2 o; o.x = pk2(y[0] * rstd * g0.x, y[1] * rstd * g0.y); o.y = pk2(y[2] * rstd * g0.z, y[3] * rstd * g0.w);
          *(u32x2*)(WSP(bf16_t, WS_KVL) + (size_t)row * 256 + 4 * lane) = o; }
        WSP(bf16_t, WS_KR)[(size_t)row * 64 + lane] = pr[2304 + lane];
    }
}

__device__ __forceinline__ void p5_post(Frame& F) {
    const int gw = F.vcu * NWAVES + F.wave, NGW = F.G * NWAVES, lane = F.lane, i16 = lane & 15, sel = (lane >> 4) & 1; const bool tl = lane < 32;
    const bf16_t* BQ = WSP(bf16_t, WS_BQ); const bf16_t* KV = WSP(bf16_t, WS_KV); const bf16_t* KR = WSP(bf16_t, WS_KR);
    const float fr = __powf(10000.0f, -(float)i16 * (1.0f / 16.0f));
    const int t1 = 128 + 32 * sel + i16, t2 = t1 + 16;
    const float gq0 = F.g_bqn[lane], gq1 = F.g_bqn[lane + 64], gq2 = F.g_bqn[t1], gq3 = F.g_bqn[t2];
    const float gk0 = F.g_bkn[lane], gk1 = F.g_bkn[lane + 64], gk2 = F.g_bkn[t1], gk3 = F.g_bkn[t2];
    for (int row = gw; row < TT; row += NGW) {
        const bool lat = row < T; const int b = lat ? row / SEQ : (row - T) / CTX, s = lat ? row % SEQ : (row - T) % CTX, kpos = lat ? CTX + s : s;
        float cs, sn; { const float pos = sel ? (float)(s % 64) : (float)(s / 64); sincosf(pos * fr, &sn, &cs); }
        const float kr1 = tl ? bf2f(KR[(size_t)row * 64 + 32 * sel + i16]) : 0.f, kr2 = tl ? bf2f(KR[(size_t)row * 64 + 32 * sel + 16 + i16]) : 0.f;
#pragma unroll 2
        for (int h = 0; h < 8; ++h) {
            if (lat) { const bf16_t* q = BQ + (size_t)row * 1536 + h * 192;
                float y0 = bf2f(q[lane]), y1 = bf2f(q[lane + 64]), x1 = tl ? bf2f(q[t1]) : 0.f, x2 = tl ? bf2f(q[t2]) : 0.f;
                const float rstd = 1.0f / sqrtf(wave_sum((y0 * y0 + y1 * y1) + (x1 * x1 + x2 * x2)) * (1.0f / 192.0f) + EPS);
                y0 *= rstd * gq0; y1 *= rstd * gq1; x1 *= rstd * gq2; x2 *= rstd * gq3;
                bf16_t* o = WSP(bf16_t, WS_QB) + (size_t)row * 1536 + h * 192;
                o[lane] = (bf16_t)f2bf(y0); o[lane + 64] = (bf16_t)f2bf(y1);
                if (tl) { o[t1] = (bf16_t)f2bf(x1 * cs - x2 * sn); o[t2] = (bf16_t)f2bf(x1 * sn + x2 * cs); } }
            { const bf16_t* k = KV + (size_t)row * DM + h * 256;
              float y0 = bf2f(k[lane]), y1 = bf2f(k[lane + 64]), x1 = kr1, x2 = kr2;
              const float rstd = 1.0f / sqrtf(wave_sum((y0 * y0 + y1 * y1) + (x1 * x1 + x2 * x2)) * (1.0f / 192.0f) + EPS);
              y0 *= rstd * gk0; y1 *= rstd * gk1; x1 *= rstd * gk2; x2 *= rstd * gk3;
              bf16_t* o = WSP(bf16_t, WS_KB) + ((size_t)(b * 8 + h) * KVLEN + kpos) * 192;
              o[lane] = (bf16_t)f2bf(y0); o[lane + 64] = (bf16_t)f2bf(y1);
              if (tl) { if (lat) { o[t1] = (bf16_t)f2bf(x1 * cs - x2 * sn); o[t2] = (bf16_t)f2bf(x1 * sn + x2 * cs); } else { o[t1] = (bf16_t)f2bf(x1); o[t2] = (bf16_t)f2bf(x2); } }
              *(unsigned*)(WSP(bf16_t, WS_VB) + ((size_t)(b * 8 + h) * KVLEN + kpos) * 128 + 2 * lane) = *(const unsigned*)(k + 128 + 2 * lane); }
        }
    }
}

__device__ __forceinline__ void p6_attn(Frame& F) {
    char* lds = (char*)F.lds;
    for (int uid = F.vcu; uid < 1024; uid += F.G) {
        const int u = uid & 511, qb = u & 15, h = (u >> 4) & 7, b = u >> 7; const size_t tok0 = (size_t)b * SEQ + qb * 256;
#ifndef ATT_NO_DENSE
        if (uid < 512) {
            att::attn_unit<192, false>(WSP(bf16_t, WS_QB) + tok0 * 1536 + h * 192, 1536, WSP(bf16_t, WS_KB) + (size_t)(b * 8 + h) * KVLEN * 192, WSP(bf16_t, WS_VB) + (size_t)(b * 8 + h) * KVLEN * 128,
                                       WSP(bf16_t, WS_Y) + tok0 * DM + 1024 + h * 128, DM, KVLEN / 64, 0, 0, 0.f, lds);
        }
#endif
#ifndef ATT_NO_WIN
        if (uid >= 512) {
            const int q0 = qb * 256, ks = q0 >= 128 ? q0 - 128 : 0, ke = (q0 + 384 < SEQ) ? q0 + 384 : SEQ, kvh = h >> 2;
            att::attn_unit<128, true>(WSP(bf16_t, WS_QA) + tok0 * 1024 + h * 128, 1024, WSP(bf16_t, WS_KA) + (size_t)(b * 2 + kvh) * KVLEN * 128, WSP(bf16_t, WS_VA) + (size_t)(b * 2 + kvh) * KVLEN * 128,
                                      WSP(bf16_t, WS_Y) + tok0 * DM + h * 128, DM, 4 + (ke - ks) / 64, ks, q0, F.sink[h], lds);
        }
#endif
    }
}
#define R_E(F) WSP(int, WS_ROUTE)
#define R_P(F) (WSP(int, WS_ROUTE) + 2 * T)
#define R_W(F) (WSP(float, WS_ROUTE) + 4 * T)
#define R_STOK(F) (WSP(int, WS_ROUTE) + 6 * T)

__device__ __forceinline__ void p8_route(Frame& F, int l) {
    LAS float* wrt = (LAS float*)F.lds;
    LAS int* hist = (LAS int*)(F.lds + RING_BYTES);
    LAS int* hbase = hist + 16;
    LAS int* tinfo = (LAS int*)(F.lds + RING_BYTES + 1024);
    for (int i = F.tid; i < DM * NE; i += NTHR) { const int k = i >> 4, e = i & 15; wrt[e * DM + k] = F.w_router[i]; }
    if (F.tid < 16) hist[F.tid] = 0;
    __syncthreads();
    float br[16];
#pragma unroll
    for (int e = 0; e < 16; ++e) br[e] = F.b_router[e];
    const float* g = F.g_norm + (size_t)(l * 2 + 1) * DM;
    unsigned* cnt = F.ctl + CW_CNT + l * 16 * 64;
    for (int grp = F.vcu; grp < T / 64; grp += F.G) {
        for (int q = 0; q < 8; ++q) { const int tl = F.wave * 8 + q, tok = grp * 64 + tl, b = tok / SEQ; f32x4 v[8];
            norm_mod_row(F.out + (size_t)tok * DM, g, modp(F, l, b, 3), modp(F, l, b, 4), WSP(bf16_t, WS_H) + (size_t)tok * DM, F.lane, v);
            float lg[16];
#pragma unroll
            for (int e = 0; e < 16; ++e) { float a = 0.f;
#pragma unroll
                for (int j = 0; j < 8; ++j) { const f32x4 w = *(const LAS f32x4*)(wrt + e * DM + 256 * j + 4 * F.lane); a += (v[j].x * w.x + v[j].y * w.y) + (v[j].z * w.z + v[j].w * w.w); }
                lg[e] = wave_sum(a); }
            float aff[16], sel[16];
#pragma unroll
            for (int e = 0; e < 16; ++e) { aff[e] = 1.0f / (1.0f + expf(-lg[e])); sel[e] = aff[e] + br[e]; }
            float gs[4], ga0[4], ga1[4]; int gi0[4], gi1[4];
#pragma unroll
            for (int gq = 0; gq < 4; ++gq) { int i0 = 0; float m0 = sel[4 * gq], a0 = aff[4 * gq];
#pragma unroll
                for (int i = 1; i < 4; ++i) if (sel[4 * gq + i] > m0) { m0 = sel[4 * gq + i]; a0 = aff[4 * gq + i]; i0 = i; }
                int i1 = -1; float m1 = -3.0e38f, a1 = 0.f;
#pragma unroll
                for (int i = 0; i < 4; ++i) if (i != i0 && sel[4 * gq + i] > m1) { m1 = sel[4 * gq + i]; a1 = aff[4 * gq + i]; i1 = i; }
                gs[gq] = m0 + m1; gi0[gq] = 4 * gq + i0; gi1[gq] = 4 * gq + i1; ga0[gq] = a0; ga1[gq] = a1; }
            int e0 = gi0[0], e1 = gi1[0]; float a0 = ga0[0], a1 = ga1[0], best = gs[0];
#pragma unroll
            for (int gq = 1; gq < 4; ++gq) if (gs[gq] > best) { best = gs[gq]; e0 = gi0[gq]; e1 = gi1[gq]; a0 = ga0[gq]; a1 = ga1[gq]; }
            const float inv = 1.0f / (a0 + a1);
            if (F.lane == 0) { const int r0 = __hip_atomic_fetch_add(hist + e0, 1, __ATOMIC_RELAXED, __HIP_MEMORY_SCOPE_WORKGROUP), r1 = __hip_atomic_fetch_add(hist + e1, 1, __ATOMIC_RELAXED, __HIP_MEMORY_SCOPE_WORKGROUP);
                LAS int* ti = tinfo + tl * 6; ti[0] = e0; ti[1] = e1; ti[2] = r0; ti[3] = r1; ti[4] = __float_as_int(a0 * inv); ti[5] = __float_as_int(a1 * inv); }
        }
        __syncthreads();
        if (F.tid < 16) hbase[F.tid] = (int)__hip_atomic_fetch_add(cnt + F.tid * 64, (unsigned)hist[F.tid], __ATOMIC_RELAXED, __HIP_MEMORY_SCOPE_AGENT);
        __syncthreads();
        if (F.tid < 64) { const int tok = grp * 64 + F.tid; const LAS int* ti = tinfo + F.tid * 6;
            R_E(F)[2 * tok] = ti[0]; R_E(F)[2 * tok + 1] = ti[1]; R_P(F)[2 * tok] = hbase[ti[0]] + ti[2]; R_P(F)[2 * tok + 1] = hbase[ti[1]] + ti[3];
            R_W(F)[2 * tok] = __int_as_float(ti[4]); R_W(F)[2 * tok + 1] = __int_as_float(ti[5]); }
        if (F.tid < 16) hist[F.tid] = 0;
        __syncthreads();
    }
}
struct MoeTiles { int tend[16]; };
__device__ __forceinline__ MoeTiles moe_tiles(Frame& F, int l) {
    MoeTiles m; int acc = 0;
#pragma unroll
    for (int e = 0; e < 16; ++e) { const unsigned c = __builtin_amdgcn_readfirstlane(__hip_atomic_load(F.ctl + CW_CNT + (l * 16 + e) * 64, RLX_AGENT)); acc += (int)((c + 255u) >> 8); m.tend[e] = acc; }
    return m;
}
__device__ __forceinline__ void p9_scatter(Frame& F, int l) {
    const MoeTiles mt = moe_tiles(F, l);
    for (int i = blockIdx.x * NTHR + F.tid; i < 2 * T; i += F.G * NTHR) { const int e = R_E(F)[i]; int off = 0;
#pragma unroll
        for (int k = 0; k < 15; ++k) off = (e > k) ? mt.tend[k] : off;
        const int ap = off * 256 + R_P(F)[i]; R_P(F)[i] = ap; R_STOK(F)[ap] = i >> 1; }
    for (int e = 0; e < 16; ++e) { const int c = (int)__builtin_amdgcn_readfirstlane(__hip_atomic_load(F.ctl + CW_CNT + (l * 16 + e) * 64, RLX_AGENT)); const int off = e ? mt.tend[e - 1] : 0;
        for (int i = off * 256 + c + blockIdx.x * NTHR + F.tid; i < mt.tend[e] * 256; i += F.G * NTHR) R_STOK(F)[i] = 0; }
}
namespace pg8 {
struct MoeSched {
    TileOrder o; MoeTiles mt; const char* A0; const char* B0; const int* stok; size_t eB, tA, tB;
    __device__ __forceinline__ void init(const MoeTiles& m, const void* A, const void* B, int lda, int ldb, size_t eB_, const int* stok_, int G, int c) {
        mt = m; o.init(m.tend[15], DM / BM, 1, G, c); A0 = (const char*)A; B0 = (const char*)B; eB = eB_; stok = stok_; tA = (size_t)BM * lda * 2; tB = (size_t)BM * ldb * 2; }
    __device__ __forceinline__ int expert(int pm) const { int e = 0;
#pragma unroll
        for (int k = 0; k < 15; ++k) e += (pm >= mt.tend[k]) ? 1 : 0;
        return e; }
};
struct MoeSched1 : MoeSched { static constexpr bool GATHER = true;
    __device__ __forceinline__ bool next(int i, Unit& u) const { if (!o.map(i, u.aux, u.pm, u.pn)) return false; u.aux = expert(u.pm); u.A = A0; u.B = B0 + (size_t)u.aux * eB + (size_t)u.pn * tB; return true; }
    __device__ __forceinline__ unsigned arow(const Unit& u, int r) const { return (unsigned)stok[u.pm * BM + r]; } };
struct MoeSched2 : MoeSched { static constexpr bool GATHER = false;
    __device__ __forceinline__ bool next(int i, Unit& u) const { if (!o.map(i, u.aux, u.pm, u.pn)) return false; u.aux = expert(u.pm); u.A = A0 + (size_t)u.pm * tA; u.B = B0 + (size_t)u.aux * eB + (size_t)u.pn * tB; return true; }
    __device__ __forceinline__ unsigned arow(const Unit&, int) const { return 0u; } };
}
__device__ __forceinline__ void p12_combine(Frame& F, int l) {
    const int gw = F.vcu * NWAVES + F.wave, NGW = F.G * NWAVES, lane = F.lane; const bf16_t* YS = WSP(bf16_t, WS_YS);
    for (int tok = gw; tok < T; tok += NGW) { const int b = tok / SEQ; const int p0 = R_P(F)[2 * tok], p1 = R_P(F)[2 * tok + 1]; const float w0 = R_W(F)[2 * tok], w1 = R_W(F)[2 * tok + 1];
        const float* gt = modp(F, l, b, 5); float* xr = F.out + (size_t)tok * DM; f32x4 v[8]; float ss = 0.f;
#pragma unroll
        for (int j = 0; j < 8; ++j) { const int c = 4 * lane + 256 * j; const u32x2 y0 = *(const u32x2*)(YS + (size_t)p0 * DM + c), y1 = *(const u32x2*)(YS + (size_t)p1 * DM + c);
            const f32x4 gv = *(const f32x4*)(gt + c), xv = *(const f32x4*)(xr + c);
            f32x4 m; m.x = w0 * bflo(y0.x) + w1 * bflo(y1.x); m.y = w0 * bfhi(y0.x) + w1 * bfhi(y1.x); m.z = w0 * bflo(y0.y) + w1 * bflo(y1.y); m.w = w0 * bfhi(y0.y) + w1 * bfhi(y1.y);
            v[j] = xv + gv * m; *(f32x4*)(xr + c) = v[j]; ss += (v[j].x * v[j].x + v[j].y * v[j].y) + (v[j].z * v[j].z + v[j].w * v[j].w); }
        if (l == 0) { const float rstd = 1.0f / sqrtf(wave_sum(ss) * (1.0f / DM) + EPS); const float* g = F.g_norm + (size_t)2 * DM; const float* sh = modp(F, 1, b, 0); const float* sc = modp(F, 1, b, 1);
            bf16_t* orow = WSP(bf16_t, WS_H) + (size_t)tok * DM;
#pragma unroll
            for (int j = 0; j < 8; ++j) { const int c = 4 * lane + 256 * j; const f32x4 gg = *(const f32x4*)(g + c), s1 = *(const f32x4*)(sc + c), s0 = *(const f32x4*)(sh + c);
                const f32x4 hv = (v[j] * rstd * gg) * (1.0f + s1) + s0; u32x2 w; w.x = pk2(hv.x, hv.y); w.y = pk2(hv.z, hv.w); *(u32x2*)(orow + c) = w; } }
    }
}
#ifndef MK_SINGLE
#define MK_SINGLE 0
#endif
#ifndef MK_LAST
#define MK_LAST 21
#endif
constexpr int N_PHASES = 21;
struct Args { const float* in[25]; float* out; unsigned char* ws; int ph_lo, ph_hi; };
static_assert(sizeof(Args) == 27 * 8 + 8, "Args has no padding");

__global__ void __launch_bounds__(NTHR, 2) fwd_kernel(Args args) {
    extern __shared__ __attribute__((aligned(16))) unsigned char lds_raw[];
    Frame F;
    F.lds = (LAS unsigned char*)lds_raw;
    F.MISC = (volatile LAS unsigned*)(F.lds + MISC_OFF);
    F.tid = threadIdx.x; F.lane = F.tid & 63; F.wave = __builtin_amdgcn_readfirstlane(F.tid >> 6);
    F.G = gridDim.x; { const int bx = blockIdx.x; F.vcu = (F.G % 8 == 0) ? (bx % 8) * (F.G / 8) + bx / 8 : bx; }
    F.ws = args.ws; F.ctl = (unsigned*)(args.ws + WS_CTL); F.out = args.out;
    F.x = args.in[0]; F.c = args.in[1]; F.ctx = args.in[2]; F.c_ctx = args.in[3]; F.w_ada = args.in[4]; F.b_ada = args.in[5]; F.g_norm = args.in[6]; F.w_in = args.in[7];
    F.g_aqn = args.in[8]; F.g_akn = args.in[9]; F.g_bq_lat = args.in[10]; F.w_bq_up = args.in[11]; F.g_bkv_lat = args.in[12]; F.w_bkv_up = args.in[13]; F.g_bqn = args.in[14]; F.g_bkn = args.in[15];
    F.sink = args.in[16]; F.w_o = args.in[17]; F.w_fo = args.in[18]; F.b_fo = args.in[19]; F.w_router = args.in[20]; F.b_router = args.in[21]; F.w_gate = args.in[22]; F.w_up = args.in[23]; F.w_down = args.in[24];
    for (int u = F.tid; u < (LDS_BYTES - RING_BYTES) / 4; u += NTHR) ((LAS unsigned*)(F.lds + RING_BYTES))[u] = 0u;
    __syncthreads();
    const int lo = args.ph_lo, hi = args.ph_hi;
    XcdBarrier bar; bar.bar = F.ctl + CW_BAR; bar.x = 0; bar.st = nullptr;
    if (MK_SINGLE) bar = xcd_barrier_post(F.ctl + CW_BAR, F.MISC + 8);
#ifdef MK_ONLY
#define IN(k) ((k) == MK_ONLY && lo <= (k) && (k) < hi)
#else
#define IN(k) (lo <= (k) && (k) < hi)
#endif
#define SEAM(k) do { if (MK_SINGLE && IN((k) + 1)) xcd_barrier(bar); else __syncthreads(); } while (0)
    const int c = (int)blockIdx.x;

    if (IN(0)) { p0_prologue(F); SEAM(0); }
    if (IN(1)) { p1_norm(F); SEAM(1); }
    if (IN(2)) {
        pg8::PlainSched S; S.init(WSP(bf16_t, WS_H), WSP(bf16_t, WS_WIN_T), DM, DM, TT / 256, INWP / 256, 1, 0, 0, F.G, c);
        pg8::EpiBf16 E{WSP(bf16_t, WS_P), INWP, 1.0f, 0};
        pg8::gemm_phase(F.lds, DM, DM, DM, S, E); SEAM(2); }
    if (IN(3)) { p3_post(F); SEAM(3); }
    if (IN(4)) {
        { pg8::PlainSched S; S.init(WSP(bf16_t, WS_BQL), WSP(bf16_t, WS_WBQ_T), 512, 512, T / 256, 1536 / 256, 1, 0, 0, F.G, c);
          pg8::EpiBf16 E{WSP(bf16_t, WS_BQ), 1536, 1.0f, 0}; pg8::gemm_phase(F.lds, 512, 512, 512, S, E); }
        { pg8::PlainSched S; S.init(WSP(bf16_t, WS_KVL), WSP(bf16_t, WS_WBKV_T), 256, 256, TT / 256, DM / 256, 1, 0, 0, F.G, c);
          pg8::EpiBf16 E{WSP(bf16_t, WS_KV), DM, 1.0f, 0}; pg8::gemm_phase(F.lds, 256, 256, 256, S, E); }
        SEAM(4); }
    if (IN(5)) { p5_post(F); SEAM(5); }
    if (IN(6)) { p6_attn(F); SEAM(6); }
    if (IN(7)) {
        pg8::PlainSched S; S.init(WSP(bf16_t, WS_Y), WSP(bf16_t, WS_WO_T), DM, DM, T / 256, DM / 256, 1, 0, 0, F.G, c);
        pg8::EpiResGate E{F.x, F.out, modp(F, 0, 0, 2), 12288, nullptr};
        pg8::gemm_phase(F.lds, DM, DM, DM, S, E); SEAM(7); }
#define MOE_LAYER(l, P8, P9, P10, P11, P12)                                                                                                                    \
    if (IN(P8)) { p8_route(F, l); SEAM(P8); }                                                                                                                  \
    if (IN(P9)) { p9_scatter(F, l); SEAM(P9); }                                                                                                                \
    if (IN(P10)) { const MoeTiles mt = moe_tiles(F, l); pg8::MoeSched1 S; S.init(mt, WSP(bf16_t, WS_H), WSP(bf16_t, WS_WGU_T) + (size_t)l * 16 * DM * DM, DM, DM, (size_t)DM * DM * 2, R_STOK(F), F.G, c); \
        pg8::EpiSwiGLU E{WSP(bf16_t, WS_HS), DE}; pg8::gemm_phase(F.lds, DM, DM, DM, S, E); SEAM(P10); }                                                         \
    if (IN(P11)) { const MoeTiles mt = moe_tiles(F, l); pg8::MoeSched2 S; S.init(mt, WSP(bf16_t, WS_HS), WSP(bf16_t, WS_WD_T) + (size_t)l * 16 * DM * DE, DE, DE, (size_t)DM * DE * 2, R_STOK(F), F.G, c); \
        pg8::EpiBf16 E{WSP(bf16_t, WS_YS), DM, 1.0f, 0}; pg8::gemm_phase(F.lds, DE, DE, DE, S, E); SEAM(P11); }                                                  \
    if (IN(P12)) { p12_combine(F, l); SEAM(P12); }
    MOE_LAYER(0, 8, 9, 10, 11, 12)
    if (IN(13)) {
        pg8::PlainSched S; S.init(WSP(bf16_t, WS_WC), WSP(bf16_t, WS_H), 256, DM, 2, T / 256, 8, 0, (size_t)256 * 2, F.G, c);
        pg8::EpiChanDFT E{WSP(bf16_t, WS_ZT)}; pg8::gemm_phase(F.lds, 256, DM, 256, S, E); SEAM(13); }
    if (IN(14)) {
        pg8::PlainSched S; S.init(WSP(bf16_t, WS_WS), WSP(bf16_t, WS_ZT), 8192, 8192, SEQ / 256, DM / 256, NB, 0, (size_t)DM * 8192 * 2, F.G, c);
        pg8::EpiBf16 E{WSP(bf16_t, WS_F), DM, 1.0f / 1024.0f, (size_t)SEQ * DM}; pg8::gemm_phase(F.lds, 8192, 8192, 8192, S, E); SEAM(14); }
    if (IN(15)) {
        pg8::PlainSched S; S.init(WSP(bf16_t, WS_F), WSP(bf16_t, WS_WFO_T), DM, DM, T / 256, DM / 256, 1, 0, 0, F.G, c);
        pg8::EpiResGate E{F.out, F.out, modp(F, 1, 0, 2), 12288, F.b_fo};
        pg8::gemm_phase(F.lds, DM, DM, DM, S, E); SEAM(15); }
    MOE_LAYER(1, 16, 17, 18, 19, 20)
#undef IN
#undef SEAM
}

extern "C" void kernel_launch(void* const* d_in, const int* in_sizes, int n_in, void* d_out, int out_size, void* d_ws, size_t ws_size, hipStream_t stream) {
    static int grid = 0;
    if (grid == 0) {
        if (n_in != 25 || out_size != T * DM || ws_size < WS_END) { fprintf(stderr, "kernel_launch: shape mismatch n_in %d out %d ws %zu (need %zu)\n", n_in, out_size, ws_size, (size_t)WS_END); grid = -1; return; }
        int dev = 0, cus = 0, per_cu = 0;
        if (hipGetDevice(&dev) != hipSuccess || hipDeviceGetAttribute(&cus, hipDeviceAttributeMultiprocessorCount, dev) != hipSuccess) { grid = -1; return; }
        if (hipFuncSetAttribute((const void*)fwd_kernel, hipFuncAttributeMaxDynamicSharedMemorySize, LDS_BYTES) != hipSuccess) { fprintf(stderr, "kernel_launch: hipFuncSetAttribute failed\n"); grid = -1; return; }
        if (hipOccupancyMaxActiveBlocksPerMultiprocessor(&per_cu, (const void*)fwd_kernel, NTHR, LDS_BYTES) != hipSuccess || per_cu < 1) fprintf(stderr, "kernel_launch: occupancy query says %d\n", per_cu);
        (void)hipGetLastError();
        grid = cus;
    }
    if (grid < 0) return;
    (void)hipMemsetAsync((char*)d_ws + WS_CTL, 0, CTL_ZERO_BYTES, stream);
    Args a{};
    for (int i = 0; i < 25; ++i) a.in[i] = (const float*)d_in[i];
    a.out = (float*)d_out; a.ws = (unsigned char*)d_ws;
    if (MK_LAST <= 7) (void)hipMemcpyAsync(d_out, d_in[0], (size_t)T * DM * 4, hipMemcpyDeviceToDevice, stream);
#if MK_SINGLE
    a.ph_lo = 0; a.ph_hi = MK_LAST;
    hipLaunchKernelGGL(fwd_kernel, dim3(grid), dim3(NTHR), LDS_BYTES, stream, a);
#else
    for (int ph = 0; ph < MK_LAST; ++ph) { a.ph_lo = ph; a.ph_hi = ph + 1; hipLaunchKernelGGL(fwd_kernel, dim3(grid), dim3(NTHR), LDS_BYTES, stream, a); }
#endif
    const hipError_t le = hipPeekAtLastError();
    if (le != hipSuccess) fprintf(stderr, "kernel_launch: launch failed: %s\n", hipGetErrorName(le));
}
```

```cpp
#define MK_SINGLE 1
#define MK_LAST 22
#include <hip/hip_runtime.h>
#include <cstdio>
#include <cstdint>

#define LAS __attribute__((address_space(3)))
#define GAS __attribute__((address_space(1)))
typedef unsigned short bf16_t;
typedef short bf16x8 __attribute__((ext_vector_type(8)));
typedef short s16x4 __attribute__((ext_vector_type(4)));
typedef float f32x4 __attribute__((ext_vector_type(4)));
typedef float f32x2 __attribute__((ext_vector_type(2)));
typedef float f32x16 __attribute__((ext_vector_type(16)));
typedef unsigned u32x4 __attribute__((ext_vector_type(4)));
typedef unsigned u32x2 __attribute__((ext_vector_type(2)));
typedef int i32x4 __attribute__((ext_vector_type(4)));
typedef int i32x8 __attribute__((ext_vector_type(8)));

constexpr int DM = 2048, NB = 4, SEQ = 4096, T = NB * SEQ, CTX = 256, TC = NB * CTX, TT = T + TC, KVLEN = CTX + SEQ;
constexpr int INW = 2368, INWP = 2560, NE = 16, DE = 1024, APAD = 2 * T + NE * 256;
constexpr float EPS = 1e-6f;
constexpr int NWAVES = 8, NTHR = 512;

constexpr size_t MiB = 1u << 20;
constexpr size_t WS_CTL = 0, CTL_ZERO_BYTES = 1 * MiB;
constexpr size_t WS_MOD = 1 * MiB;
constexpr size_t WS_ROUTE = 2 * MiB;
constexpr size_t WS_WIN_T = 4 * MiB, WS_WBQ_T = 14 * MiB, WS_WBKV_T = 16 * MiB, WS_WO_T = 18 * MiB, WS_WFO_T = 26 * MiB, WS_WC = 34 * MiB, WS_KR = 35 * MiB;
constexpr size_t WS_WS = 38 * MiB, WS_WGU_T = 102 * MiB, WS_WD_T = 358 * MiB;
constexpr size_t WS_H = 486 * MiB, WS_RA = 554 * MiB, WS_RC = 714 * MiB, WS_RD = 790 * MiB, WS_XB = 924 * MiB  , WS_END = 988 * MiB;
constexpr size_t WS_P = WS_RA, WS_BQ = WS_RA, WS_KV = WS_RA + 48 * MiB, WS_Y = WS_RA, WS_YS = WS_RA, WS_FY = WS_RC  , WS_F = WS_H  ;
constexpr size_t WS_STOKE = WS_WS;
constexpr size_t WS_WRT = WS_WC + 768 * 1024;
constexpr size_t WS_A1 = WS_WC, WS_W2 = WS_WC + 512 * 1024;
constexpr size_t WS_Z128 = WS_WS + 2 * MiB;
constexpr size_t WS_UT = WS_RA;
constexpr size_t WS_QA = WS_RC, WS_KA = WS_RC + 32 * MiB, WS_VA = WS_RC + 41 * MiB, WS_BQL = WS_RC + 50 * MiB, WS_KVL = WS_RC + 66 * MiB;
constexpr size_t WS_QB = WS_RD, WS_KB = WS_RD + 48 * MiB, WS_VB = WS_RD + 99 * MiB, WS_HS = WS_RD;
static_assert((size_t)TT * INWP * 2 <= 160 * MiB && (size_t)APAD * DM * 2 <= 160 * MiB && (size_t)T * 4096 * 2 <= 160 * MiB && WS_UT + (size_t)64 * DM * 512 * 2 <= WS_RC && WS_FY + (size_t)T * 4096 * 2 <= WS_XB && WS_F + (size_t)T * DM <= WS_RA, "region A / UT / FY / F");
static_assert((size_t)T * 1536 * 2 <= 48 * MiB && WS_KV + (size_t)TT * DM * 2 <= WS_RC, "BQ/KV");
static_assert((size_t)T * 1024 * 2 <= 32 * MiB && (size_t)NB * 2 * KVLEN * 128 * 2 <= 9 * MiB && (size_t)T * 512 * 2 <= 16 * MiB && WS_KVL + (size_t)TT * 256 * 2 <= WS_RD, "region C");
static_assert((size_t)T * 1536 * 2 <= 48 * MiB && (size_t)NB * 8 * KVLEN * 192 * 2 <= 51 * MiB && WS_VB + (size_t)NB * 8 * KVLEN * 128 * 2 <= WS_END && (size_t)APAD * DE * 2 <= 134 * MiB, "region D");
static_assert((size_t)TT * DM * 2 <= 68 * MiB && (size_t)TT * 64 * 2 <= 3 * MiB, "H/KR");
constexpr int CW_BAR = 4096;
constexpr int CW_CNT = 8192;

constexpr int RING_BYTES = 131072;
constexpr int LDS_BYTES = 163840;
constexpr int MISC_OFF = LDS_BYTES - 512;

#define RLX_AGENT __ATOMIC_RELAXED, __HIP_MEMORY_SCOPE_AGENT
#define LDS_WAIT() asm volatile("s_waitcnt lgkmcnt(0)" ::: "memory")
#define VM_WAIT() asm volatile("s_waitcnt vmcnt(0)" ::: "memory")
__device__ __forceinline__ unsigned f2bf(float f) { unsigned u = __builtin_bit_cast(unsigned, f); return (u + 0x7fffu + ((u >> 16) & 1u)) >> 16; }
__device__ __forceinline__ unsigned pk2(float lo, float hi) { return f2bf(lo) | (f2bf(hi) << 16); }
__device__ __forceinline__ float bf2f(unsigned b) { return __builtin_bit_cast(float, b << 16); }
__device__ __forceinline__ float bflo(unsigned w) { return __builtin_bit_cast(float, w << 16); }
__device__ __forceinline__ float bfhi(unsigned w) { return __builtin_bit_cast(float, w & 0xffff0000u); }
__device__ __forceinline__ unsigned cvt_pk_bf16(float lo, float hi) { unsigned r; asm volatile("v_cvt_pk_bf16_f32 %0, %1, %2" : "=v"(r) : "v"(lo), "v"(hi)); return r; }
__device__ __forceinline__ unsigned pk4_fp8(float a, float b, float c, float d) { int p = 0; p = __builtin_amdgcn_cvt_pk_fp8_f32(a, b, p, false); p = __builtin_amdgcn_cvt_pk_fp8_f32(c, d, p, true); return (unsigned)p; }
constexpr float W8_SCALE = 32.0f, W8_INV = 1.0f / 32.0f;
template <int CTRL> __device__ __forceinline__ float dpp_mov(float v) { return __int_as_float(__builtin_amdgcn_update_dpp(0, __float_as_int(v), CTRL, 0xF, 0xF, true)); }
__device__ __forceinline__ float row_sum16(float v) {
    v += dpp_mov<0xB1>(v);
    v += dpp_mov<0x4E>(v);
    v += dpp_mov<0x141>(v);
    v += dpp_mov<0x140>(v);
    return v;
}
__device__ __forceinline__ float half_sum(float v) {
    v = row_sum16(v);
    const auto r = __builtin_amdgcn_permlane16_swap(__float_as_uint(v), __float_as_uint(v), false, false);
    return __uint_as_float(r[0]) + __uint_as_float(r[1]);
}
__device__ __forceinline__ float wave_sum(float v) {
    v = half_sum(v);
    const auto r = __builtin_amdgcn_permlane32_swap(__float_as_uint(v), __float_as_uint(v), false, false);
    return __uint_as_float(r[0]) + __uint_as_float(r[1]);
}
__device__ __forceinline__ int lane_now() { int l; asm volatile("v_mbcnt_lo_u32_b32 %0, -1, 0\n\tv_mbcnt_hi_u32_b32 %0, -1, %0" : "=v"(l)); return l; }
__device__ __forceinline__ float silu_f(float v) { return v / (1.0f + __expf(-v)); }

#define XB_TMO      128
#define XB_XCNT(j)  (256  + 64 * (j))
#define XB_XSUB(j)  (1280 + 64 * (j))
#define XB_XGEN(j)  (2304 + 64 * (j))
#define XB_TOP      3328
#define XB_TOPGEN   3392
#define XCD_BAR_WORDS 3456
#define XB_SPIN_CAP (1u << 18)
__device__ __forceinline__ unsigned xb_ld(unsigned* p)              { return __hip_atomic_load(p, __ATOMIC_RELAXED, __HIP_MEMORY_SCOPE_AGENT); }
__device__ __forceinline__ unsigned xb_add(unsigned* p, unsigned v) { return __hip_atomic_fetch_add(p, v, __ATOMIC_RELAXED, __HIP_MEMORY_SCOPE_AGENT); }
__device__ __forceinline__ unsigned xb_xcc_id() { return (unsigned)__builtin_amdgcn_s_getreg((3 << 11) | 20) & 0xFu; }
#define XB_SPIN(cond, bar) do { unsigned _sp = 0; while (cond) { __builtin_amdgcn_s_sleep(1); \
    if ((++_sp & 255u) == 0u) { if (xb_ld(&(bar)[XB_TMO])) break; if (_sp > XB_SPIN_CAP) { atomicAdd(&(bar)[XB_TMO], 1u); break; } } } } while (0)
struct XcdBarrier { unsigned* bar; unsigned x; volatile LAS unsigned* st; };
__device__ __forceinline__ XcdBarrier xcd_barrier_post(unsigned* bar, volatile LAS unsigned* st) {
    XcdBarrier b; b.bar = bar; b.x = xb_xcc_id(); b.st = st;
    if (threadIdx.x == 0) (void)xb_add(&bar[XB_XCNT(b.x)], 1u);
    return b;
}
__device__ __forceinline__ void xcd_barrier_complete(unsigned* bar, unsigned x, unsigned& nloc, unsigned& nx) {
    const unsigned G = gridDim.x * gridDim.y * gridDim.z;
    unsigned sum, cnt, mine, sp = 0u;
    for (;;) {
        sum = 0u; cnt = 0u; mine = 0u;
#pragma unroll
        for (unsigned j = 0; j < 16; ++j) { const unsigned c = xb_ld(&bar[XB_XCNT(j)]); sum += c; cnt += (c > 0u) ? 1u : 0u; mine = (j == x) ? c : mine; }
        if (sum == G) break;
        __builtin_amdgcn_s_sleep(1);
        if ((++sp & 255u) == 0u) { if (xb_ld(&bar[XB_TMO])) break; if (sp > XB_SPIN_CAP) { atomicAdd(&bar[XB_TMO], 1u); break; } }
    }
    nloc = mine > 0u ? mine : 1u; nx = cnt > 0u ? cnt : 1u;
}
__device__ __forceinline__ void xcd_barrier_lane0(const XcdBarrier& b) {
    unsigned* bar = b.bar;
    __builtin_amdgcn_s_waitcnt(0);
    unsigned nloc = b.st[0], nx = b.st[1];
    if (nloc == 0u) { xcd_barrier_complete(bar, b.x, nloc, nx); b.st[0] = nloc; b.st[1] = nx; }
    const unsigned old = xb_add(&bar[XB_XSUB(b.x)], 1u);
    const unsigned gen = old / nloc;
    if (old + 1u == (gen + 1u) * nloc) {
        __builtin_amdgcn_fence(__ATOMIC_RELEASE, "agent");
        asm volatile("s_waitcnt vmcnt(0)" ::: "memory");
        const unsigned og = xb_add(&bar[XB_TOP], 1u);
        const unsigned tg = og / nx;
        if (og + 1u == (tg + 1u) * nx) xb_add(&bar[XB_TOPGEN], 1u);
        else XB_SPIN(xb_ld(&bar[XB_TOPGEN]) == tg, bar);
        __builtin_amdgcn_fence(__ATOMIC_ACQUIRE, "agent");
        xb_add(&bar[XB_XGEN(b.x)], 1u);
        asm volatile("s_waitcnt vmcnt(0)" ::: "memory");
    } else {
        XB_SPIN(xb_ld(&bar[XB_XGEN(b.x)]) == gen, bar);
        __builtin_amdgcn_fence(__ATOMIC_ACQUIRE, "agent");
        asm volatile("s_waitcnt vmcnt(0)" ::: "memory");
    }
}
__device__ __forceinline__ void xcd_barrier(const XcdBarrier& b) {
    asm volatile("s_waitcnt vmcnt(0)" ::: "memory");
    __syncthreads();
    if (threadIdx.x == 0) xcd_barrier_lane0(b);
    __syncthreads();
}
template <class W> __device__ __forceinline__ void xcd_barrier_shadow(const XcdBarrier& b, W&& work) {
    asm volatile("s_waitcnt vmcnt(0)" ::: "memory");
    __syncthreads();
    if (threadIdx.x < 64) { if (threadIdx.x == 0) xcd_barrier_lane0(b); }
    else { work(); asm volatile("s_waitcnt vmcnt(0) lgkmcnt(0)" ::: "memory"); }
    __syncthreads();
}
namespace pg8 {
constexpr int BM = 256, BK = 64, HALF = 128, HTB = HALF * BK * 2, STAGE_BYTES = 8 * HTB, NXCD = 8, WGM = 8;
__host__ __device__ __forceinline__ int lds_byte(int r, int c) { const int st = (r >> 4) * 2 + (c >> 5), rr = r & 15, cc = c & 31, ob = rr * 64 + cc * 2; return st * 1024 + (ob ^ (((ob >> 9) & 1) << 5)); }
__host__ __device__ __forceinline__ void stage_rc(int b, int& R, int& C) { const int st = b / 1024, sb = b % 1024, swz = sb ^ (((sb >> 9) & 1) << 5); R = (st >> 1) * 16 + swz / 64; C = (st & 1) * 32 + (swz % 64) / 2; }
__host__ __device__ __forceinline__ int perm32(int rho) { const int n = rho >> 4, i = rho & 15; return 8 * (i >> 2) + 4 * n + (i & 3); }

struct Unit { int pm, pn, aux, r0, cnt; const char* A; const char* B; };

struct TileOrder {
    int nM, nN, nAux, nwg, G, c;
    __device__ __forceinline__ void init(int nM_, int nN_, int nAux_, int G_, int c_) { nM = nM_; nN = nN_; nAux = nAux_; nwg = nM * nN * nAux; G = G_; c = c_; }
    __device__ __forceinline__ bool map(int i, int& aux, int& pm, int& pn) const {
        const long L = (long)i * G + c; if (L >= nwg) return false;
        int wgid = (int)L; { const int q = nwg / NXCD, r = nwg % NXCD, xcd = wgid % NXCD, off = wgid / NXCD; wgid = (xcd < r ? xcd * (q + 1) : r * (q + 1) + (xcd - r) * q) + off; }
        const int per = nM * nN; aux = wgid / per; wgid -= aux * per;
        const int nig = WGM * nN, gid = wgid / nig, fm = gid * WGM, gsz = (nM - fm) < WGM ? (nM - fm) : WGM;
        pm = fm + ((wgid % nig) % gsz); pn = (wgid % nig) / gsz; return true;
    }
};
struct PlainSched {
    static constexpr bool GATHER = false;
    TileOrder o; const char* A0; const char* B0; size_t sA, sB, tA, tB;
    __device__ __forceinline__ void init(const void* A, const void* B, int lda, int ldb, int nM, int nN, int nAux, size_t sA_, size_t sB_, int G, int c) {
        o.init(nM, nN, nAux, G, c); A0 = (const char*)A; B0 = (const char*)B; sA = sA_; sB = sB_; tA = (size_t)BM * lda * 2; tB = (size_t)BM * ldb * 2; }
    __device__ __forceinline__ bool next(int i, Unit& u) const {
        if (!o.map(i, u.aux, u.pm, u.pn)) return false;
        u.A = A0 + (size_t)u.aux * sA + (size_t)u.pm * tA; u.B = B0 + (size_t)u.aux * sB + (size_t)u.pn * tB; return true; }
    __device__ __forceinline__ unsigned arow(const Unit&, int) const { return 0u; }
};

template <class Epi, class Sched, bool F8 = false>
__device__ __forceinline__ void gemm_phase(LAS unsigned char* lds, const int lda, const int ldb, const int K, const Sched& S, const Epi& E, const int wid) {
    const int lane = lane_now(), tid = wid * 64 + lane, wr = wid >> 2, wc = wid & 3, fr = lane & 15, fq = lane >> 4;
    int K_o = K; asm volatile("" : "+s"(K_o));
    const int nt = K_o / BK;
    unsigned voffA[2], voffB[2]; int RA[2], CA2[2];
#pragma unroll
    for (int i = 0; i < 2; ++i) { int R, C; stage_rc(tid * 16 + i * 8192, R, C); const int Rb = Epi::PERM ? ((R & ~31) + perm32(R & 31)) : R;
        RA[i] = R; CA2[i] = C * 2; voffA[i] = (unsigned)(R * lda + C) * 2u; voffB[i] = (unsigned)(Rb * ldb + C) * 2u; }
    const size_t kstep = (size_t)(BK * 2);
    const size_t hstepA = (size_t)HALF * lda * 2, hstepB = (size_t)HALF * ldb * 2;
    const unsigned ldsw = (unsigned)wid * 1024u;
    const int aoff = lds_byte(wr * 64 + fr, fq * 8), boff = lds_byte(wc * 32 + fr, fq * 8);
#define PG8_SA(b, h) (((b) * 2 + (h)) * HTB)
#define PG8_SB(b, h) ((4 + (b) * 2 + (h)) * HTB)
#define PG8_STAGE(bufoff, gbase, voff) do { _Pragma("unroll") for (int _i = 0; _i < 2; ++_i) \
        __builtin_amdgcn_global_load_lds((const unsigned*)((const char*)(gbase) + (voff)[_i]), (LAS unsigned*)(lds + (bufoff) + ldsw + _i * 8192), 16, 0, 0); } while (0)
#define PG8_LDA(dst, b, h) do { _Pragma("unroll") for (int m = 0; m < 4; ++m) _Pragma("unroll") for (int k = 0; k < 2; ++k) dst[m][k] = *(const LAS bf16x8*)(lds + PG8_SA(b, h) + aoff + m * 2048 + k * 1024); } while (0)
#define PG8_LDB(dst, b, h) do { _Pragma("unroll") for (int n = 0; n < 2; ++n) _Pragma("unroll") for (int k = 0; k < 2; ++k) dst[n][k] = *(const LAS bf16x8*)(lds + PG8_SB(b, h) + boff + n * 2048 + k * 1024); } while (0)
#define PG8_MMA(ai, bj, At, Bt) do { __builtin_amdgcn_s_setprio(1); _Pragma("unroll") for (int m = 0; m < 4; ++m) _Pragma("unroll") for (int n = 0; n < 2; ++n) _Pragma("unroll") for (int k = 0; k < 2; ++k) \
        acc[ai][bj][m][n] = __builtin_amdgcn_mfma_f32_16x16x32_bf16(Bt[n][k], At[m][k], acc[ai][bj][m][n], 0, 0, 0); __builtin_amdgcn_s_setprio(0); } while (0)
#define PG8_LDA8(dst, b, h) do { _Pragma("unroll") for (int m = 0; m < 4; ++m) { const i32x4 lo_ = *(const LAS i32x4*)(lds + PG8_SA(b, h) + aoff + m * 2048), hi_ = *(const LAS i32x4*)(lds + PG8_SA(b, h) + aoff + m * 2048 + 1024); \
        dst[m] = (i32x8){lo_[0], lo_[1], lo_[2], lo_[3], hi_[0], hi_[1], hi_[2], hi_[3]}; } } while (0)
#define PG8_LDB8(dst, b, h) do { _Pragma("unroll") for (int n = 0; n < 2; ++n) { const i32x4 lo_ = *(const LAS i32x4*)(lds + PG8_SB(b, h) + boff + n * 2048), hi_ = *(const LAS i32x4*)(lds + PG8_SB(b, h) + boff + n * 2048 + 1024); \
        dst[n] = (i32x8){lo_[0], lo_[1], lo_[2], lo_[3], hi_[0], hi_[1], hi_[2], hi_[3]}; } } while (0)
#define PG8_MMA8(ai, bj, At, Bt) do { __builtin_amdgcn_s_setprio(1); _Pragma("unroll") for (int m = 0; m < 4; ++m) _Pragma("unroll") for (int n = 0; n < 2; ++n) \
        { f32x4 c_; _Pragma("unroll") for (int j_ = 0; j_ < 4; ++j_) c_[j_] = accv[ai][bj][4 * (2 * m + n) + j_]; \
          c_ = __builtin_amdgcn_mfma_scale_f32_16x16x128_f8f6f4(Bt[n], At[m], c_, 0, 0, 0, 0x7f7f7f7f, 0, 0x7f7f7f7f); \
          _Pragma("unroll") for (int j_ = 0; j_ < 4; ++j_) accv[ai][bj][4 * (2 * m + n) + j_] = c_[j_]; } __builtin_amdgcn_s_setprio(0); } while (0)
#define PG8_WAIT_V(n) asm volatile("s_waitcnt vmcnt(" #n ")" ::: "memory")
#define PG8_WAIT_L(n) asm volatile("s_waitcnt lgkmcnt(" #n ")" ::: "memory")
#define PG8_BAR __builtin_amdgcn_s_barrier()
#define PG8_SCHED __builtin_amdgcn_sched_barrier(0)
    Unit cur, nxt; int ui = 0;
    if (!S.next(0, cur)) return;
    f32x4 acc[2][2][4][2];
    typedef float f32x32 __attribute__((ext_vector_type(32)));
    f32x32 accv[2][2];
#pragma unroll
    for (int a = 0; a < 2; ++a)
#pragma unroll
        for (int b = 0; b < 2; ++b)
#pragma unroll
            for (int j = 0; j < 32; ++j) accv[a][b][j] = 0.f;
#pragma unroll
    for (int a = 0; a < 2; ++a)
#pragma unroll
        for (int b = 0; b < 2; ++b)
#pragma unroll
            for (int m = 0; m < 4; ++m)
#pragma unroll
                for (int n = 0; n < 2; ++n) acc[a][b][m][n] = (f32x4){0.f, 0.f, 0.f, 0.f};
    bf16x8 At[4][2], B0[2][2], B1[2][2];
    i32x8 At8[4], B08[2], B18[2];
    const char* cA = cur.A; const char* cB = cur.B;
    unsigned voA0[2], voA1[2], vnA0[2], vnA1[2];
    if constexpr (Sched::GATHER) {
#pragma unroll
        for (int i = 0; i < 2; ++i) { voA0[i] = S.arow(cur, RA[i]) * (unsigned)(lda * 2) + (unsigned)CA2[i]; voA1[i] = S.arow(cur, HALF + RA[i]) * (unsigned)(lda * 2) + (unsigned)CA2[i]; vnA0[i] = voA0[i]; vnA1[i] = voA1[i]; }
    }
    if constexpr (Sched::GATHER) {
        PG8_STAGE(PG8_SB(0, 0), cB, voffB); PG8_STAGE(PG8_SB(0, 1), cB + hstepB, voffB); PG8_STAGE(PG8_SA(0, 0), cA, voA0); PG8_STAGE(PG8_SA(0, 1), cA, voA1);
        if (wr == 1) PG8_BAR;
        PG8_WAIT_V(2); PG8_BAR;
        PG8_STAGE(PG8_SB(1, 0), cB + kstep, voffB); PG8_STAGE(PG8_SA(1, 0), cA + kstep, voA0); PG8_STAGE(PG8_SB(1, 1), cB + hstepB + kstep, voffB);
        PG8_WAIT_V(6); PG8_BAR;
    } else {
        PG8_STAGE(PG8_SB(0, 0), cB, voffB); PG8_STAGE(PG8_SB(0, 1), cB + hstepB, voffB); PG8_STAGE(PG8_SA(0, 0), cA, voffA); PG8_STAGE(PG8_SA(0, 1), cA + hstepA, voffA);
        if (wr == 1) PG8_BAR;
        PG8_WAIT_V(2); PG8_BAR;
        PG8_STAGE(PG8_SB(1, 0), cB + kstep, voffB); PG8_STAGE(PG8_SA(1, 0), cA + kstep, voffA); PG8_STAGE(PG8_SB(1, 1), cB + hstepB + kstep, voffB);
        PG8_WAIT_V(6); PG8_BAR;
    }
    for (;;) {
        const bool has_next = S.next(ui + 1, nxt);
        const char* nA = has_next ? nxt.A : cA; const char* nB = has_next ? nxt.B : cB;
        if constexpr (Sched::GATHER) {
            if (has_next) { const int t2_ = wid * 64 + lane_now();
#pragma unroll
                for (int i = 0; i < 2; ++i) { int R_, C_; stage_rc(t2_ * 16 + i * 8192, R_, C_);
                  vnA0[i] = S.arow(nxt, R_) * (unsigned)(lda * 2) + (unsigned)(C_ * 2); vnA1[i] = S.arow(nxt, HALF + R_) * (unsigned)(lda * 2) + (unsigned)(C_ * 2); }
            } else {
#pragma unroll
                for (int i = 0; i < 2; ++i) { vnA0[i] = voA0[i]; vnA1[i] = voA1[i]; }
            }
        }
        for (int t = 0; t < nt; t += 2) {
            const bool last = (t == nt - 2);
            const char* a1 = cA + (size_t)(t + 1) * kstep;
            const char* a2 = last ? nA : cA + (size_t)(t + 2) * kstep; const char* b2 = last ? nB : cB + (size_t)(t + 2) * kstep;
            const char* a3 = a2 + kstep; const char* b3 = b2 + kstep;
            unsigned o20[2], o21[2];
            if constexpr (Sched::GATHER) {
#pragma unroll
                for (int i = 0; i < 2; ++i) { o20[i] = last ? vnA0[i] : voA0[i]; o21[i] = last ? vnA1[i] : voA1[i]; }
            }
            if constexpr (F8) { PG8_LDB8(B08, 0, 0); PG8_LDB8(B18, 0, 1); PG8_SCHED; PG8_LDA8(At8, 0, 0); } else { PG8_LDB(B0, 0, 0); PG8_LDB(B1, 0, 1); PG8_SCHED; PG8_LDA(At, 0, 0); }
            if constexpr (Sched::GATHER) { PG8_STAGE(PG8_SA(1, 1), a1, voA1); } else { PG8_STAGE(PG8_SA(1, 1), a1 + hstepA, voffA); }
            PG8_WAIT_V(8); PG8_WAIT_L(0); PG8_BAR; if constexpr (F8) { PG8_MMA8(0, 0, At8, B08); PG8_MMA8(0, 1, At8, B18); } else { PG8_MMA(0, 0, At, B0); PG8_MMA(0, 1, At, B1); } PG8_BAR; PG8_SCHED;
            if constexpr (F8) { PG8_LDA8(At8, 0, 1); } else { PG8_LDA(At, 0, 1); } PG8_STAGE(PG8_SB(0, 0), b2, voffB); PG8_STAGE(PG8_SB(0, 1), b2 + hstepB, voffB);
            if constexpr (Sched::GATHER) { PG8_STAGE(PG8_SA(0, 0), a2, o20); } else { PG8_STAGE(PG8_SA(0, 0), a2, voffA); }
            PG8_WAIT_V(8); PG8_WAIT_L(0); PG8_BAR; if constexpr (F8) { PG8_MMA8(1, 0, At8, B08); PG8_MMA8(1, 1, At8, B18); } else { PG8_MMA(1, 0, At, B0); PG8_MMA(1, 1, At, B1); } PG8_BAR; PG8_SCHED;
            if constexpr (F8) { PG8_LDB8(B08, 1, 0); PG8_LDB8(B18, 1, 1); PG8_SCHED; PG8_LDA8(At8, 1, 0); } else { PG8_LDB(B0, 1, 0); PG8_LDB(B1, 1, 1); PG8_SCHED; PG8_LDA(At, 1, 0); }
            if constexpr (Sched::GATHER) { PG8_STAGE(PG8_SA(0, 1), a2, o21); } else { PG8_STAGE(PG8_SA(0, 1), a2 + hstepA, voffA); }
            PG8_WAIT_V(8); PG8_WAIT_L(0); PG8_BAR; if constexpr (F8) { PG8_MMA8(0, 0, At8, B08); PG8_MMA8(0, 1, At8, B18); } else { PG8_MMA(0, 0, At, B0); PG8_MMA(0, 1, At, B1); } PG8_BAR; PG8_SCHED;
            if constexpr (F8) { PG8_LDA8(At8, 1, 1); } else { PG8_LDA(At, 1, 1); } PG8_STAGE(PG8_SB(1, 0), b3, voffB); PG8_STAGE(PG8_SB(1, 1), b3 + hstepB, voffB);
            if constexpr (Sched::GATHER) { PG8_STAGE(PG8_SA(1, 0), a3, o20); } else { PG8_STAGE(PG8_SA(1, 0), a3, voffA); }
            PG8_WAIT_V(8); PG8_WAIT_L(0); PG8_BAR; if constexpr (F8) { PG8_MMA8(1, 0, At8, B08); PG8_MMA8(1, 1, At8, B18); } else { PG8_MMA(1, 0, At, B0); PG8_MMA(1, 1, At, B1); } PG8_BAR; PG8_SCHED;
        }
        if (wr == 0) PG8_BAR;
        if constexpr (F8) {
#pragma unroll
            for (int a = 0; a < 2; ++a)
#pragma unroll
                for (int b = 0; b < 2; ++b)
#pragma unroll
                    for (int m = 0; m < 4; ++m)
#pragma unroll
                        for (int n = 0; n < 2; ++n)
#pragma unroll
                            for (int j = 0; j < 4; ++j) acc[a][b][m][n][j] = accv[a][b][4 * (2 * m + n) + j];
        }
        { const int l2_ = lane_now(); E(acc, cur, wr, wc, l2_ & 15, l2_ >> 4); }
        if (!has_next) break;
#pragma unroll
        for (int a = 0; a < 2; ++a)
#pragma unroll
            for (int b = 0; b < 2; ++b)
#pragma unroll
                for (int m = 0; m < 4; ++m)
#pragma unroll
                    for (int n = 0; n < 2; ++n) acc[a][b][m][n] = (f32x4){0.f, 0.f, 0.f, 0.f};
        if constexpr (F8) {
#pragma unroll
            for (int a = 0; a < 2; ++a)
#pragma unroll
                for (int b = 0; b < 2; ++b)
#pragma unroll
                    for (int j = 0; j < 32; ++j) accv[a][b][j] = 0.f;
        }
        cur = nxt; cA = nA; cB = nB; ++ui;
        if constexpr (Sched::GATHER) {
#pragma unroll
            for (int i = 0; i < 2; ++i) { voA0[i] = vnA0[i]; voA1[i] = vnA1[i]; }
        }
        if (wr == 1) PG8_BAR;
    }
    PG8_WAIT_V(0);
    PG8_BAR;
#undef PG8_SA
#undef PG8_SB
#undef PG8_STAGE
#undef PG8_LDA
#undef PG8_LDB
#undef PG8_MMA
#undef PG8_LDA8
#undef PG8_LDB8
#undef PG8_MMA8
#undef PG8_WAIT_V
#undef PG8_WAIT_L
#undef PG8_BAR
#undef PG8_SCHED
}

struct EpiBf16 {
    static constexpr bool PERM = true;
    bf16_t* O; int ldc; float scale; size_t aux_stride;
    __device__ __forceinline__ void operator()(const f32x4 (&acc)[2][2][4][2], const Unit& u, int wr, int wc, int fr, int fq) const {
        const int row0 = u.pm * BM + wr * 64 + fr, col0 = u.pn * BM + wc * 32 + 8 * fq; bf16_t* base = O + (size_t)u.aux * aux_stride;
#pragma unroll
        for (int ai = 0; ai < 2; ++ai)
#pragma unroll
            for (int m = 0; m < 4; ++m) { bf16_t* rowp = base + (size_t)(row0 + ai * HALF + m * 16) * ldc + col0;
#pragma unroll
                for (int bj = 0; bj < 2; ++bj) { const f32x4 v0 = acc[ai][bj][m][0] * scale, v1 = acc[ai][bj][m][1] * scale;
                    u32x4 w; w.x = cvt_pk_bf16(v0[0], v0[1]); w.y = cvt_pk_bf16(v0[2], v0[3]); w.z = cvt_pk_bf16(v1[0], v1[1]); w.w = cvt_pk_bf16(v1[2], v1[3]);
                    *(u32x4*)(rowp + bj * HALF) = w; } }
    }
};
struct EpiSwiGLU {
    static constexpr bool PERM = true;
    bf16_t* O; int ldc;
    __device__ __forceinline__ void operator()(const f32x4 (&acc)[2][2][4][2], const Unit& u, int wr, int wc, int fr, int fq) const {
        const int row0 = u.pm * BM + wr * 64 + fr, col0 = u.pn * HALF + wc * 32 + 8 * fq;
#pragma unroll
        for (int ai = 0; ai < 2; ++ai)
#pragma unroll
            for (int m = 0; m < 4; ++m) { bf16_t* rowp = O + (size_t)(row0 + ai * HALF + m * 16) * ldc + col0;
                f32x4 h0, h1;
#pragma unroll
                for (int j = 0; j < 4; ++j) { const float g0 = acc[ai][0][m][0][j], g1 = acc[ai][0][m][1][j];
                    h0[j] = g0 * __builtin_amdgcn_rcpf(1.0f + __expf(-g0)) * acc[ai][1][m][0][j]; h1[j] = g1 * __builtin_amdgcn_rcpf(1.0f + __expf(-g1)) * acc[ai][1][m][1][j]; }
                u32x4 w; w.x = cvt_pk_bf16(h0[0], h0[1]); w.y = cvt_pk_bf16(h0[2], h0[3]); w.z = cvt_pk_bf16(h1[0], h1[1]); w.w = cvt_pk_bf16(h1[2], h1[3]);
                *(u32x4*)rowp = w; }
    }
};
struct EpiSwiGLU8 {
    static constexpr bool PERM = true;
    unsigned char* O; int ldc;
    __device__ __forceinline__ void operator()(const f32x4 (&acc)[2][2][4][2], const Unit& u, int wr, int wc, int fr, int fq) const {
        const int row0 = u.pm * BM + wr * 64 + fr, col0 = u.pn * HALF + wc * 32 + 8 * fq;
#pragma unroll
        for (int ai = 0; ai < 2; ++ai)
#pragma unroll
            for (int m = 0; m < 4; ++m) { unsigned char* rowp = O + (size_t)(row0 + ai * HALF + m * 16) * ldc + col0;
                f32x4 h0, h1;
#pragma unroll
                for (int j = 0; j < 4; ++j) { const float g0 = acc[ai][0][m][0][j] * W8_INV, g1 = acc[ai][0][m][1][j] * W8_INV;
                    h0[j] = g0 * __builtin_amdgcn_rcpf(1.0f + __expf(-g0)) * (acc[ai][1][m][0][j] * W8_INV); h1[j] = g1 * __builtin_amdgcn_rcpf(1.0f + __expf(-g1)) * (acc[ai][1][m][1][j] * W8_INV); }
                u32x2 w; w.x = pk4_fp8(h0[0], h0[1], h0[2], h0[3]); w.y = pk4_fp8(h1[0], h1[1], h1[2], h1[3]);
                *(u32x2*)rowp = w; }
    }
};
template <bool XIN_BF, bool XOUT_BF> struct EpiResGate {
    static constexpr bool PERM = false;
    const void* xin; void* out; const float* gate; int gstride; const float* bias; float scale;
    __device__ __forceinline__ void operator()(const f32x4 (&acc)[2][2][4][2], const Unit& u, int wr, int wc, int fr, int fq) const {
        const int row0 = u.pm * BM + wr * 64 + fr, col0 = u.pn * BM + wc * 32 + 4 * fq;
        const float* gp = gate + (size_t)((u.pm * BM) / SEQ) * gstride + col0;
        f32x4 gv[2][2], bv[2][2];
#pragma unroll
        for (int bj = 0; bj < 2; ++bj)
#pragma unroll
            for (int n = 0; n < 2; ++n) { gv[bj][n] = *(const f32x4*)(gp + bj * HALF + n * 16); bv[bj][n] = bias ? *(const f32x4*)(bias + col0 + bj * HALF + n * 16) : (f32x4){0.f, 0.f, 0.f, 0.f}; }
#pragma unroll
        for (int aim = 0; aim < 4; ++aim) { const int ai = aim >> 1, mb = (aim & 1) * 2;
            f32x4 xv[4][2][2];
#pragma unroll
            for (int m = mb; m < mb + 2; ++m)
#pragma unroll
                for (int bj = 0; bj < 2; ++bj)
#pragma unroll
                    for (int n = 0; n < 2; ++n) { const size_t o2 = (size_t)(row0 + ai * HALF + m * 16) * DM + col0 + bj * HALF + n * 16;
                        if constexpr (XIN_BF) { const u32x2 w = *(const u32x2*)((const bf16_t*)xin + o2); xv[m][bj][n] = (f32x4){bflo(w.x), bfhi(w.x), bflo(w.y), bfhi(w.y)}; } else xv[m][bj][n] = *(const f32x4*)((const float*)xin + o2); }
            asm volatile("" ::: "memory");
#pragma unroll
            for (int m = mb; m < mb + 2; ++m)
#pragma unroll
                for (int bj = 0; bj < 2; ++bj)
#pragma unroll
                    for (int n = 0; n < 2; ++n) { const size_t o2 = (size_t)(row0 + ai * HALF + m * 16) * DM + col0 + bj * HALF + n * 16;
                        const f32x4 r = xv[m][bj][n] + gv[bj][n] * (acc[ai][bj][m][n] * scale + bv[bj][n]);
                        if constexpr (XOUT_BF) { u32x2 w; w.x = cvt_pk_bf16(r[0], r[1]); w.y = cvt_pk_bf16(r[2], r[3]); *(u32x2*)((bf16_t*)out + o2) = w; } else *(f32x4*)((float*)out + o2) = r; }
            asm volatile("" ::: "memory");
        }
    }
};
struct EpiB1 {
    static constexpr bool PERM = true;
    bf16_t* UT;
    __device__ __forceinline__ void operator()(const f32x4 (&acc)[2][2][4][2], const Unit& u, int wr, int wc, int fr, int fq) const {
        const unsigned base = (unsigned)(((u.pn * 1024 + u.aux * 128 + wr * 64 + fr) * 2) * 256 + wc * 32 + 8 * fq);
#pragma unroll
        for (int ai = 0; ai < 2; ++ai)
#pragma unroll
            for (int m = 0; m < 4; ++m)
#pragma unroll
                for (int bj = 0; bj < 2; ++bj) { const f32x4 v0 = acc[ai][bj][m][0], v1 = acc[ai][bj][m][1];
                    u32x4 w; w.x = cvt_pk_bf16(v0[0], v0[1]); w.y = cvt_pk_bf16(v0[2], v0[3]); w.z = cvt_pk_bf16(v1[0], v1[1]); w.w = cvt_pk_bf16(v1[2], v1[3]);
                    *(u32x4*)(UT + (base + (unsigned)((m * 16) * 512 + ai * 256 + bj * HALF))) = w; }
    }
};
struct EpiB2 {
    static constexpr bool PERM = true;
    unsigned char* Fo;
    __device__ __forceinline__ void operator()(const f32x4 (&acc)[2][2][4][2], const Unit& u, int wr, int wc, int fr, int fq) const {
        const int b = u.aux >> 4, k1 = u.aux & 15, k1m = (16 - k1) & 15, k2off = k1 ? 255 : 256;
        const unsigned colb = (unsigned)(u.pn * 512 + wc * 32 + 8 * fq);
        const bool edge = (wc == 0) && (fq == 0);
#pragma unroll
        for (int ai = 0; ai < 2; ++ai)
#pragma unroll
            for (int m = 0; m < 4; ++m) { const int k2 = ai * HALF + wr * 64 + m * 16 + fr, k2m = (k2off - k2) & 255;
                const unsigned rowd = (unsigned)(b * SEQ + k1 + 16 * k2) * DM, rowm = (unsigned)(b * SEQ + k1m + 16 * k2m) * DM;
#pragma unroll
                for (int bj = 0; bj < 2; ++bj) { const f32x4 v0 = acc[ai][bj][m][0] * (1.0f / 1024.0f), v1 = acc[ai][bj][m][1] * (1.0f / 1024.0f);
                    u32x2 w; w.x = pk4_fp8(v0[0], v0[1], v0[2], v0[3]); w.y = pk4_fp8(v1[0], v1[1], v1[2], v1[3]);
                    *(u32x2*)(Fo + (rowd + colb + (unsigned)(bj * 256))) = w;
                    unsigned char* mp = Fo + (rowm + colb + (unsigned)(bj * 256 + 128));
                    if (!edge) *(u32x2*)mp = w;
                    else { mp[1] = (unsigned char)(w.x >> 8); *(unsigned short*)(mp + 2) = (unsigned short)(w.x >> 16); *(unsigned*)(mp + 4) = w.y; } } }
    }
};
}
struct BgConv { int item, end; const float *w_o, *w_gate, *w_up, *w_down; unsigned char *o8, *gu8, *d8; unsigned char* pdst; int pldk; };
constexpr int BG_SQ = (DM / 32) * (DM / 32), BG_E = (DM / 32) * (DE / 32), BG_TOTAL = BG_SQ + 3 * 32 * BG_E;
struct BgItem { const float* src; unsigned char* dst; int N, ldk; };
__device__ __forceinline__ BgItem bg_decode(const BgConv& g, int idx) {
    BgItem it; int kb, nb, drow;
    if (idx < BG_SQ) { kb = idx >> 6; nb = idx & 63; it.src = g.w_o; it.N = DM; it.dst = g.o8; it.ldk = DM; drow = 32 * nb; }
    else { const int r = idx - BG_SQ, which = r / (32 * BG_E), r2 = r % (32 * BG_E), le = r2 / BG_E, t = r2 % BG_E;
        if (which < 2) { kb = t >> 5; nb = t & 31; const int n0 = 32 * nb; it.src = (which == 0 ? g.w_gate : g.w_up) + (size_t)le * DM * DE; it.N = DE; it.dst = g.gu8 + (size_t)le * DM * DM; it.ldk = DM; drow = (n0 >> 7) * 256 + (n0 & 127) + (which ? 128 : 0); }
        else { kb = t >> 6; nb = t & 63; it.src = g.w_down + (size_t)le * DE * DM; it.N = DM; it.dst = g.d8 + (size_t)le * DM * DE; it.ldk = DE; drow = 32 * nb; } }
    it.src += (size_t)(32 * kb) * it.N + 32 * nb; it.dst += (size_t)drow * it.ldk + 32 * kb;
    return it;
}
__device__ __forceinline__ void bg_issue_at(const BgConv& g, int idx, int lane, unsigned slot) {
    const BgItem it = bg_decode(g, idx); const char* p = (const char*)it.src + (unsigned)(((lane >> 3) * it.N + (lane & 7) * 4) * 4);
#pragma unroll
    for (int i = 0; i < 4; ++i) __builtin_amdgcn_global_load_lds((const unsigned*)(p + (size_t)(8 * i) * it.N * 4), (LAS unsigned*)(slot + i * 1024), 16, 0, 2);
}
__device__ __forceinline__ void bg_consume_at(const BgConv& g, int idx, int lane, unsigned slot) {
    const BgItem it = bg_decode(g, idx); const int c = lane & 1, n = lane >> 1; const LAS float* s = (const LAS float*)(slot + (unsigned)(((16 * c) * 32 + n) * 4));
    u32x4 o; o.x = pk4_fp8(s[0 * 32] * W8_SCALE, s[1 * 32] * W8_SCALE, s[2 * 32] * W8_SCALE, s[3 * 32] * W8_SCALE); o.y = pk4_fp8(s[4 * 32] * W8_SCALE, s[5 * 32] * W8_SCALE, s[6 * 32] * W8_SCALE, s[7 * 32] * W8_SCALE);
    o.z = pk4_fp8(s[8 * 32] * W8_SCALE, s[9 * 32] * W8_SCALE, s[10 * 32] * W8_SCALE, s[11 * 32] * W8_SCALE); o.w = pk4_fp8(s[12 * 32] * W8_SCALE, s[13 * 32] * W8_SCALE, s[14 * 32] * W8_SCALE, s[15 * 32] * W8_SCALE);
    __builtin_nontemporal_store(o, (u32x4*)(it.dst + (size_t)n * it.ldk + 16 * c));
    asm volatile("s_waitcnt lgkmcnt(0)" ::: "memory");
}
__device__ __forceinline__ void bg_issue(BgConv& g, int lane, unsigned slot) {
    const BgItem it = bg_decode(g, g.item); g.pdst = it.dst; g.pldk = it.ldk; const char* p = (const char*)it.src + (unsigned)(((lane >> 3) * it.N + (lane & 7) * 4) * 4);
#pragma unroll
    for (int i = 0; i < 4; ++i) __builtin_amdgcn_global_load_lds((const unsigned*)(p + (size_t)(8 * i) * it.N * 4), (LAS unsigned*)(slot + i * 1024), 16, 0, 2);
}
__device__ __forceinline__ void bg_consume(BgConv& g, int lane, unsigned slot) {
    const int c = lane & 1, n = lane >> 1; const LAS float* s = (const LAS float*)(slot + (unsigned)(((16 * c) * 32 + n) * 4));
    u32x4 o; o.x = pk4_fp8(s[0 * 32] * W8_SCALE, s[1 * 32] * W8_SCALE, s[2 * 32] * W8_SCALE, s[3 * 32] * W8_SCALE); o.y = pk4_fp8(s[4 * 32] * W8_SCALE, s[5 * 32] * W8_SCALE, s[6 * 32] * W8_SCALE, s[7 * 32] * W8_SCALE);
    o.z = pk4_fp8(s[8 * 32] * W8_SCALE, s[9 * 32] * W8_SCALE, s[10 * 32] * W8_SCALE, s[11 * 32] * W8_SCALE); o.w = pk4_fp8(s[12 * 32] * W8_SCALE, s[13 * 32] * W8_SCALE, s[14 * 32] * W8_SCALE, s[15 * 32] * W8_SCALE);
    __builtin_nontemporal_store(o, (u32x4*)(g.pdst + (size_t)n * g.pldk + 16 * c));
    asm volatile("s_waitcnt lgkmcnt(0)" ::: "memory");
    ++g.item;
}
__device__ __forceinline__ void bg_now(BgConv& g, int lane, unsigned slot) {
    bg_issue(g, lane, slot); asm volatile("s_waitcnt vmcnt(0)" ::: "memory"); bg_consume(g, lane, slot);
}
namespace att {
constexpr int NW = 8, QBLK = 32, KVBLK = 64, DV = 128;
constexpr float THR = 8.f;
#define SBAR() __builtin_amdgcn_sched_barrier(0)
#ifndef ATT_ROLE_SPLIT
#define ATT_ROLE_SPLIT 4
#endif
__device__ __forceinline__ int crow(int r, int hi) { return (r & 3) + 8 * (r >> 2) + 4 * hi; }
__device__ __forceinline__ int v_st(int k, int c) { const int kk = (k & ~0xC) | ((k & 4) << 1) | ((k & 8) >> 1); return ((kk >> 3) * 4 + (c >> 5)) * 512 + ((kk & 7) * 32 + (c & 31)) * 2; }
__device__ __forceinline__ int v_rd_base(int lane) { return ((lane & 3) << 3) | (((lane >> 2) & 3) << 6) | (((lane >> 4) & 1) << 5) | (((lane >> 5) & 1) << 8); }
constexpr int v_rd_off(int d0, int ks, int half) { return d0 * 512 + ks * 4096 + half * 2048; }
template <int OFF> __device__ __forceinline__ s16x4 tr_read(int vb) {
  s16x4 r; asm volatile("ds_read_b64_tr_b16 %0, %1 offset:%2" : "=&v"(r) : "v"(vb), "i"(OFF) : "memory"); return r;
}
template <int D0> __device__ __forceinline__ void pv_one(f32x16& od, int vb, bf16x8 pa0, bf16x8 pa1, bf16x8 pa2, bf16x8 pa3) {
  const s16x4 l0 = tr_read<v_rd_off(D0, 0, 0)>(vb), h0 = tr_read<v_rd_off(D0, 0, 1)>(vb), l1 = tr_read<v_rd_off(D0, 1, 0)>(vb), h1 = tr_read<v_rd_off(D0, 1, 1)>(vb);
  const s16x4 l2 = tr_read<v_rd_off(D0, 2, 0)>(vb), h2 = tr_read<v_rd_off(D0, 2, 1)>(vb), l3 = tr_read<v_rd_off(D0, 3, 0)>(vb), h3 = tr_read<v_rd_off(D0, 3, 1)>(vb);
  asm volatile("s_waitcnt lgkmcnt(0)" ::: "memory"); SBAR();
#define PK(L, H) (bf16x8){L[0], L[1], L[2], L[3], H[0], H[1], H[2], H[3]}
  od = __builtin_amdgcn_mfma_f32_32x32x16_bf16(pa0, PK(l0, h0), od, 0, 0, 0);
  od = __builtin_amdgcn_mfma_f32_32x32x16_bf16(pa1, PK(l1, h1), od, 0, 0, 0);
  od = __builtin_amdgcn_mfma_f32_32x32x16_bf16(pa2, PK(l2, h2), od, 0, 0, 0);
  od = __builtin_amdgcn_mfma_f32_32x32x16_bf16(pa3, PK(l3, h3), od, 0, 0, 0);
#undef PK
}
__device__ __forceinline__ void pv_d0(f32x16* o, int vb, bf16x8 pa0, bf16x8 pa1, bf16x8 pa2, bf16x8 pa3) {
  pv_one<0>(o[0], vb, pa0, pa1, pa2, pa3); pv_one<1>(o[1], vb, pa0, pa1, pa2, pa3); pv_one<2>(o[2], vb, pa0, pa1, pa2, pa3); pv_one<3>(o[3], vb, pa0, pa1, pa2, pa3);
}
template <int DK, bool WINDOW>
__device__ __forceinline__ void partialSM(f32x16& p0, f32x16& p1, float& m_reg, float& mn, float& alpha, int dq, int hi) {
  constexpr float SCALE = (DK == 128) ? 0.088388347648318440f : 0.072168783648703220f;
  constexpr float C = SCALE * 1.4426950408889634f;
  if constexpr (WINDOW) {
    const int dqh = dq - 4 * hi + 128;
#pragma unroll
    for (int r = 0; r < 16; ++r) { const unsigned d0 = (unsigned)(dqh - ((r & 3) + 8 * (r >> 2))), d1 = d0 - 32u;
      p0[r] = d0 <= 256u ? p0[r] : -1e30f; p1[r] = d1 <= 256u ? p1[r] : -1e30f; }
  }
  float pmax = p0[0];
#pragma unroll
  for (int r = 1; r < 16; ++r) pmax = fmaxf(pmax, p0[r]);
#pragma unroll
  for (int r = 0; r < 16; ++r) pmax = fmaxf(pmax, p1[r]);
  { auto rr = __builtin_amdgcn_permlane32_swap(__float_as_uint(pmax), __float_as_uint(pmax), false, false);
    pmax = fmaxf(__uint_as_float(rr[0]), __uint_as_float(rr[1])); }
  if (__builtin_expect(__all(pmax - m_reg <= THR / SCALE), 1)) { mn = m_reg; alpha = 1.f; }
  else { mn = fmaxf(m_reg, pmax); alpha = __builtin_amdgcn_exp2f((m_reg - mn) * C); m_reg = mn; }
  const float mnC = -mn * C;
#pragma unroll
  for (int r = 0; r < 16; ++r) p0[r] = fmaf(p0[r], C, mnC);
#pragma unroll
  for (int r = 0; r < 16; ++r) p1[r] = fmaf(p1[r], C, mnC);
#pragma unroll
  for (int r = 0; r < 16; ++r) p0[r] = __builtin_amdgcn_exp2f(p0[r]);
}
__device__ __forceinline__ void finishSM(f32x16& p0, f32x16& p1, float alpha, float& l_reg, bf16x8& pa0, bf16x8& pa1, bf16x8& pa2, bf16x8& pa3) {
#pragma unroll
  for (int r = 0; r < 16; ++r) p1[r] = __builtin_amdgcn_exp2f(p1[r]);
  float ps = 0;
#pragma unroll
  for (int r = 0; r < 16; ++r) ps += p0[r];
#pragma unroll
  for (int r = 0; r < 16; ++r) ps += p1[r];
  { auto rr = __builtin_amdgcn_permlane32_swap(__float_as_uint(ps), __float_as_uint(ps), false, false);
    ps = __uint_as_float(rr[0]) + __uint_as_float(rr[1]); }
  l_reg = l_reg * alpha + ps;
#define PK4(P, BASE, OUT) do { unsigned a0 = cvt_pk_bf16(P[BASE + 0], P[BASE + 1]), a1 = cvt_pk_bf16(P[BASE + 2], P[BASE + 3]);   \
    unsigned b0 = cvt_pk_bf16(P[BASE + 4], P[BASE + 5]), b1 = cvt_pk_bf16(P[BASE + 6], P[BASE + 7]);                              \
    auto r0 = __builtin_amdgcn_permlane32_swap(a0, b0, false, false); auto r1 = __builtin_amdgcn_permlane32_swap(a1, b1, false, false); \
    u32x4 w = {r0[0], r1[0], r0[1], r1[1]}; OUT = *reinterpret_cast<bf16x8*>(&w); } while (0)
  PK4(p0, 0, pa0); PK4(p0, 8, pa1); PK4(p1, 0, pa2); PK4(p1, 8, pa3);
#undef PK4
}
template <int DK> __device__ __forceinline__ int kswz(int row, int colB) { return row * (DK * 2) + (colB ^ ((row & (DK == 128 ? 15 : 7)) << 4)); }
template <int DK>
__device__ __forceinline__ void qkt(f32x16& p0, f32x16& p1, unsigned kb, int kx, int hi16, const bf16x8* qr) {
  p0 = f32x16{}; p1 = f32x16{};
  unsigned a[4];
#pragma unroll
  for (int q = 0; q < 4; ++q) a[q] = kb + (unsigned)((q * 32 + hi16) ^ kx);
#pragma unroll
  for (int d0 = 0; d0 < DK / 16; ++d0) {
    const bf16x8 b0 = *(const LAS bf16x8*)(a[d0 & 3] + (d0 >> 2) * 128);
    const bf16x8 b1 = *(const LAS bf16x8*)(a[d0 & 3] + (d0 >> 2) * 128 + 32 * DK * 2);
    p0 = __builtin_amdgcn_mfma_f32_32x32x16_bf16(b0, qr[d0], p0, 0, 0, 0);
    p1 = __builtin_amdgcn_mfma_f32_32x32x16_bf16(b1, qr[d0], p1, 0, 0, 0);
    if ((d0 & 3) == 3) SBAR(); }
}

template <int DK>
__device__ __forceinline__ void qkt_fin(f32x16& pc0, f32x16& pc1, unsigned kb, int kx, int hi16, const bf16x8* qr, f32x16& pp0, f32x16& pp1, float alphaP, float& l_reg,
                                        bf16x8& pa0, bf16x8& pa1, bf16x8& pa2, bf16x8& pa3) {
  static_assert(DK == 192, "qkt_fin is written for three k-groups");
  pc0 = f32x16{}; pc1 = f32x16{};
  unsigned a[4];
#pragma unroll
  for (int q = 0; q < 4; ++q) a[q] = kb + (unsigned)((q * 32 + hi16) ^ kx);
#define QGROUP(G) do { _Pragma("unroll") for (int d0 = 4 * (G); d0 < 4 * (G) + 4; ++d0) { \
      const bf16x8 b0 = *(const LAS bf16x8*)(a[d0 & 3] + (d0 >> 2) * 128); const bf16x8 b1 = *(const LAS bf16x8*)(a[d0 & 3] + (d0 >> 2) * 128 + 32 * DK * 2); \
      pc0 = __builtin_amdgcn_mfma_f32_32x32x16_bf16(b0, qr[d0], pc0, 0, 0, 0); pc1 = __builtin_amdgcn_mfma_f32_32x32x16_bf16(b1, qr[d0], pc1, 0, 0, 0); } } while (0)
#pragma unroll
  for (int r = 0; r < 16; ++r) pp1[r] = __builtin_amdgcn_exp2f(pp1[r]);
  QGROUP(0); SBAR();
  { float ps = 0;
#pragma unroll
    for (int r = 0; r < 16; ++r) ps += pp0[r];
#pragma unroll
    for (int r = 0; r < 16; ++r) ps += pp1[r];
    { auto rr = __builtin_amdgcn_permlane32_swap(__float_as_uint(ps), __float_as_uint(ps), false, false); ps = __uint_as_float(rr[0]) + __uint_as_float(rr[1]); }
    l_reg = l_reg * alphaP + ps; }
  QGROUP(1); SBAR();
#define PK4(P, BASE, OUT) do { unsigned a0_ = cvt_pk_bf16(P[BASE + 0], P[BASE + 1]), a1_ = cvt_pk_bf16(P[BASE + 2], P[BASE + 3]);   \
    unsigned b0_ = cvt_pk_bf16(P[BASE + 4], P[BASE + 5]), b1_ = cvt_pk_bf16(P[BASE + 6], P[BASE + 7]);                              \
    auto r0_ = __builtin_amdgcn_permlane32_swap(a0_, b0_, false, false); auto r1_ = __builtin_amdgcn_permlane32_swap(a1_, b1_, false, false); \
    u32x4 w_ = {r0_[0], r1_[0], r0_[1], r1_[1]}; OUT = *reinterpret_cast<bf16x8*>(&w_); } while (0)
  PK4(pp0, 0, pa0); PK4(pp0, 8, pa1); PK4(pp1, 0, pa2); PK4(pp1, 8, pa3);
#undef PK4
  QGROUP(2); SBAR();
#undef QGROUP
}
template <int DK, bool WINDOW>
__device__ __forceinline__ void pv_psm(f32x16* o, int vb, bf16x8 pa0, bf16x8 pa1, bf16x8 pa2, bf16x8 pa3, f32x16& p0, f32x16& p1, float& m_reg, float& alpha, int dq, int hi) {
  constexpr float SCALE = (DK == 128) ? 0.088388347648318440f : 0.072168783648703220f;
  constexpr float C = SCALE * 1.4426950408889634f;
#define PVGROUP(D0, ...) do { \
    const s16x4 l0 = tr_read<v_rd_off(D0, 0, 0)>(vb), h0 = tr_read<v_rd_off(D0, 0, 1)>(vb), l1 = tr_read<v_rd_off(D0, 1, 0)>(vb), h1 = tr_read<v_rd_off(D0, 1, 1)>(vb); \
    const s16x4 l2 = tr_read<v_rd_off(D0, 2, 0)>(vb), h2 = tr_read<v_rd_off(D0, 2, 1)>(vb), l3 = tr_read<v_rd_off(D0, 3, 0)>(vb), h3 = tr_read<v_rd_off(D0, 3, 1)>(vb); \
    __VA_ARGS__; \
    asm volatile("s_waitcnt lgkmcnt(0)" ::: "memory"); SBAR(); \
    o[D0] = __builtin_amdgcn_mfma_f32_32x32x16_bf16(pa0, (bf16x8){l0[0], l0[1], l0[2], l0[3], h0[0], h0[1], h0[2], h0[3]}, o[D0], 0, 0, 0); \
    o[D0] = __builtin_amdgcn_mfma_f32_32x32x16_bf16(pa1, (bf16x8){l1[0], l1[1], l1[2], l1[3], h1[0], h1[1], h1[2], h1[3]}, o[D0], 0, 0, 0); \
    o[D0] = __builtin_amdgcn_mfma_f32_32x32x16_bf16(pa2, (bf16x8){l2[0], l2[1], l2[2], l2[3], h2[0], h2[1], h2[2], h2[3]}, o[D0], 0, 0, 0); \
    o[D0] = __builtin_amdgcn_mfma_f32_32x32x16_bf16(pa3, (bf16x8){l3[0], l3[1], l3[2], l3[3], h3[0], h3[1], h3[2], h3[3]}, o[D0], 0, 0, 0); } while (0)
  float mnC;
  PVGROUP(0, {
    if constexpr (WINDOW) { const int dqh = dq - 4 * hi + 128;
      _Pragma("unroll") for (int r = 0; r < 16; ++r) { const unsigned d0_ = (unsigned)(dqh - ((r & 3) + 8 * (r >> 2))), d1_ = d0_ - 32u; p0[r] = d0_ <= 256u ? p0[r] : -1e30f; p1[r] = d1_ <= 256u ? p1[r] : -1e30f; } }
    float pmax = p0[0];
    _Pragma("unroll") for (int r = 1; r < 16; ++r) pmax = fmaxf(pmax, p0[r]);
    _Pragma("unroll") for (int r = 0; r < 16; ++r) pmax = fmaxf(pmax, p1[r]);
    { auto rr = __builtin_amdgcn_permlane32_swap(__float_as_uint(pmax), __float_as_uint(pmax), false, false); pmax = fmaxf(__uint_as_float(rr[0]), __uint_as_float(rr[1])); }
    const bool keep = __all(pmax - m_reg <= THR / SCALE);
    const float mn = keep ? m_reg : fmaxf(m_reg, pmax);
    alpha = keep ? 1.f : __builtin_amdgcn_exp2f((m_reg - mn) * C); m_reg = mn; mnC = -mn * C; });
  PVGROUP(1, { _Pragma("unroll") for (int r = 0; r < 16; ++r) p0[r] = fmaf(p0[r], C, mnC); });
  PVGROUP(2, { _Pragma("unroll") for (int r = 0; r < 16; ++r) p1[r] = fmaf(p1[r], C, mnC); });
  PVGROUP(3, { _Pragma("unroll") for (int r = 0; r < 16; ++r) p0[r] = __builtin_amdgcn_exp2f(p0[r]); });
#undef PVGROUP
}

template <int DK, bool WINDOW>
__device__ __forceinline__ void attn_unit(const bf16_t* __restrict__ Qb, int ldq, const bf16_t* __restrict__ Kh, const bf16_t* __restrict__ Vh, unsigned char* __restrict__ Ob, int ldo,
                                          int NT, int ks, int q0, float sink, char* lds, const int wid, BgConv& bg) {
  constexpr float SCALE = (DK == 128) ? 0.088388347648318440f : 0.072168783648703220f;
  constexpr int SHM_K = KVBLK * DK * 2, SHM_V = KVBLK * DV * 2, SLOT = SHM_K + SHM_V, NKC = DK / 64, KCH = DK / 8;
  const int lane = lane_now(), tid = wid * 64 + lane, r32 = lane & 31, hi = lane >> 5;
  const unsigned lbase = (unsigned)(uintptr_t)lds;
  float* ws = (float*)(lds + 3 * SLOT) + wid * 64; float* li_l = ws; float* al_l = ws + 32;
  float m_reg = WINDOW ? sink / SCALE : -1e30f, l_reg = WINDOW ? 1.f : 0.f;
  f32x16 o[4] = {}; bf16x8 qr[DK / 16];
  const bf16_t* Qw = Qb + (long)(wid * QBLK + r32) * ldq + hi * 8;
#pragma unroll
  for (int d0 = 0; d0 < DK / 16; ++d0) qr[d0] = *reinterpret_cast<const bf16x8*>(Qw + d0 * 16);
  unsigned koff[NKC], voff[2];
#pragma unroll
  for (int i = 0; i < NKC; ++i) { const int c = tid + 512 * i, row = c / KCH, pc = c % KCH, lc = (pc & ~7) | ((pc ^ (row >> 1)) & 7); koff[i] = (unsigned)(row * DK * 2 + lc * 16); }
#pragma unroll
  for (int i = 0; i < 2; ++i) { const int P = (tid + 512 * i) * 16, sub = P >> 9, within = P & 511, kk = (sub >> 2) * 8 + (within >> 6), col = (sub & 3) * 32 + ((within & 63) >> 1), k = (kk & ~0xC) | ((kk & 4) << 1) | ((kk & 8) >> 1);
    voff[i] = (unsigned)((k * DV + col) * 2); }
#pragma unroll
  for (int i = 0; i < NKC; ++i) asm volatile("" : "+v"(koff[i]));
  asm volatile("" : "+v"(voff[0]), "+v"(voff[1]));
  const unsigned bgslot = lbase + 3 * SLOT + 2048 + (unsigned)wid * 4096; bool bgpend = false;
  const int vb0 = (int)lbase + SHM_K + v_rd_base(lane);
  const unsigned kbase0 = lbase + (unsigned)(r32 * DK * 2); const int kx = ((r32 >> 1) & 7) << 4, hi16 = hi * 16;
  const int qpos = q0 + wid * QBLK + r32;
#define TROW(j) (64 * (j) + ((WINDOW && (j) >= 4) ? ks : 0))
#define DMA(j, slot) do { const char* kb_ = (const char*)(Kh + (long)TROW(j) * DK); const char* vb_ = (const char*)(Vh + (long)TROW(j) * DV); \
    _Pragma("unroll") for (int _i = 0; _i < NKC; ++_i) __builtin_amdgcn_global_load_lds((const unsigned*)(kb_ + koff[_i]), (LAS unsigned*)(lbase + (slot) * SLOT + (_i * 512 + wid * 64) * 16), 16, 0, 0); \
    _Pragma("unroll") for (int _i = 0; _i < 2; ++_i) __builtin_amdgcn_global_load_lds((const unsigned*)(vb_ + voff[_i]), (LAS unsigned*)(lbase + (slot) * SLOT + SHM_K + (_i * 512 + wid * 64) * 16), 16, 0, 0); } while (0)
#define RESC(a) do { if (__any((a) < 1.f)) { if (hi == 0) al_l[r32] = (a); asm volatile("s_waitcnt lgkmcnt(0)" ::: "memory"); \
    _Pragma("unroll") for (int d = 0; d < 4; ++d) _Pragma("unroll") for (int r = 0; r < 16; ++r) o[d][r] *= al_l[crow(r, hi)]; } } while (0)
#define MASKED(j) (WINDOW && (j) >= 4)
#define DQ(j) ((WINDOW && (j) >= 4) ? qpos - (ks + 64 * ((j) - 4)) : 0)
#define TBAR() do { asm volatile("s_waitcnt vmcnt(0) lgkmcnt(0)" ::: "memory"); __builtin_amdgcn_s_barrier(); asm volatile("" ::: "memory"); } while (0)
#define STEP(T_, PC0, PC1, MNC, ALC, PP0, PP1, ALP, SK, SV, SD, TD_, BGI, BGC) do { \
    DMA(TD_, SD); \
    if (BGI) { bgpend = bg.item < bg.end; if (bgpend) bg_issue(bg, lane, bgslot); } \
    { unsigned kb_ = kbase0 + (SK) * SLOT; asm volatile("" : "+v"(kb_)); SBAR(); qkt_fin<DK>(PC0, PC1, kb_, kx, hi16, qr, PP0, PP1, ALP, l_reg, pa0, pa1, pa2, pa3); } \
    pv_psm<DK, WINDOW>(o, vb0 + (SV) * SLOT, pa0, pa1, pa2, pa3, PC0, PC1, m_reg, ALC, DQ(T_), hi); \
    RESC(ALC); \
    if ((BGI) && bgpend) asm volatile("s_waitcnt vmcnt(4) lgkmcnt(0)" ::: "memory"); else asm volatile("s_waitcnt vmcnt(0) lgkmcnt(0)" ::: "memory"); \
    if (BGC) { if (bgpend) { bg_consume(bg, lane, bgslot); bgpend = false; } } \
    __builtin_amdgcn_s_barrier(); asm volatile("" ::: "memory"); } while (0)
#define PAIR(J, S) do { STEP(J, pB0, pB1, mnB, alB, pA0, pA1, alA, S, ((S) + 2) % 3, ((S) + 1) % 3, (J) + 1, true, false); \
                        STEP((J) + 1, pA0, pA1, mnA, alA, pB0, pB1, alB, ((S) + 1) % 3, S, ((S) + 2) % 3, (J) + 2, false, true); } while (0)
#define SYNC(t) do { \
    asm volatile("s_waitcnt vmcnt(0) lgkmcnt(0)" ::: "memory"); \
    if (bgpend) { bg_consume(bg, lane, bgslot); bgpend = false; } \
    __builtin_amdgcn_s_barrier(); asm volatile("" ::: "memory"); \
    if ((t) + 2 < NT) DMA((t) + 2, sd); \
    bgpend = bg.item < bg.end; if (bgpend) bg_issue(bg, lane, bgslot); } while (0)
  f32x16 pA0, pA1; float mnA, alA; bf16x8 pa0, pa1, pa2, pa3;
  DMA(0, 0); DMA(1, 1);
#pragma unroll
  for (int d0 = 0; d0 < DK / 16; ++d0) asm volatile("" : "+v"(qr[d0]));
  TBAR();
  const bool late = wid >= ATT_ROLE_SPLIT;
  int sk = 0, sd = 2;
  for (int t = 0; t < NT; ++t) {
    { unsigned kb_ = kbase0 + sk * SLOT; asm volatile("" : "+v"(kb_)); SBAR(); qkt<DK>(pA0, pA1, kb_, kx, hi16, qr); }
    partialSM<DK, WINDOW>(pA0, pA1, m_reg, mnA, alA, DQ(t), hi);
    RESC(alA);
    finishSM(pA0, pA1, alA, l_reg, pa0, pa1, pa2, pa3);
    if (late && t + 1 < NT) SYNC(t);
    { int vb_ = vb0 + sk * SLOT; asm volatile("" : "+v"(vb_)); SBAR(); pv_d0(o, vb_, pa0, pa1, pa2, pa3); }
    if (!late && t + 1 < NT) SYNC(t);
    sk = sk == 2 ? 0 : sk + 1; sd = sd == 2 ? 0 : sd + 1;
  }
  if (bgpend) { asm volatile("s_waitcnt vmcnt(0)" ::: "memory"); bg_consume(bg, lane, bgslot); bgpend = false; }
  if (hi == 0) li_l[r32] = l_reg; asm volatile("s_waitcnt lgkmcnt(0)" ::: "memory");
  float rli[16];
#pragma unroll
  for (int r = 0; r < 16; ++r) rli[r] = 16.0f * __builtin_amdgcn_rcpf(li_l[crow(r, hi)]);
  unsigned char* Ow = Ob + (long)(wid * QBLK) * ldo;
#pragma unroll
  for (int r = 0; r < 16; ++r) { const int orow = crow(r, hi);
    *(unsigned*)(Ow + (long)orow * ldo + 4 * r32) = pk4_fp8(o[0][r] * rli[r], o[1][r] * rli[r], o[2][r] * rli[r], o[3][r] * rli[r]); }
  __syncthreads();
#undef TROW
#undef DMA
#undef RESC
#undef MASKED
#undef DQ
#undef TBAR
#undef STEP
#undef PAIR
#undef SYNC
}
template <int DK>
__device__ __forceinline__ void qkt_s(f32x16& p0, f32x16& p1, const char* Ks, const bf16x8* qr, int r32, int hi) {
  p0 = f32x16{}; p1 = f32x16{};
#pragma unroll
  for (int d0 = 0; d0 < DK / 16; ++d0) { const int cb = (d0 * 16 + hi * 8) * 2;
    const bf16x8 b0 = *reinterpret_cast<const bf16x8*>(Ks + kswz<DK>(r32, cb));
    const bf16x8 b1 = *reinterpret_cast<const bf16x8*>(Ks + kswz<DK>(32 + r32, cb));
    p0 = __builtin_amdgcn_mfma_f32_32x32x16_bf16(b0, qr[d0], p0, 0, 0, 0);
    p1 = __builtin_amdgcn_mfma_f32_32x32x16_bf16(b1, qr[d0], p1, 0, 0, 0);
    if ((d0 & 3) == 3) SBAR(); }
}

template <int DK, bool WINDOW>
__device__ __forceinline__ void attn_unit_simple(const bf16_t* __restrict__ Qb, int ldq, const bf16_t* __restrict__ Kh, const bf16_t* __restrict__ Vh, unsigned char* __restrict__ Ob, int ldo,
                                          int NT, int ks, int q0, float sink, char* lds, const int wid) {
  constexpr float SCALE = (DK == 128) ? 0.088388347648318440f : 0.072168783648703220f;
  constexpr int SHM_K = KVBLK * DK * 2, SHM_V = KVBLK * DV * 2, NKC = DK / 64, KCH = DK / 8;
  const int lane = lane_now(), tid = wid * 64 + lane, r32 = lane & 31, hi = lane >> 5;
  char* V_lds = lds; char* K_lds = lds + 2 * SHM_V;
  float* ws = (float*)(lds + 2 * SHM_V + 2 * SHM_K) + wid * 64; float* li_l = ws; float* al_l = ws + 32;
  float m_reg = WINDOW ? sink / SCALE : -1e30f, l_reg = WINDOW ? 1.f : 0.f;
  f32x16 o[4] = {}; bf16x8 qr[DK / 16];
  const bf16_t* Qw = Qb + (long)(wid * QBLK + r32) * ldq + hi * 8;
#pragma unroll
  for (int d0 = 0; d0 < DK / 16; ++d0) qr[d0] = *reinterpret_cast<const bf16x8*>(Qw + d0 * 16);
  const int sr = tid >> 4, sc = (tid & 15) * 8, vst0 = v_st(sr, sc), vst1 = v_st(32 + sr, sc);
  int krow[NKC], kcc[NKC];
#pragma unroll
  for (int i = 0; i < NKC; ++i) { const int c = tid + 512 * i; krow[i] = c / KCH; kcc[i] = c % KCH; }
  const int vb0 = (int)(uintptr_t)V_lds + v_rd_base(lane);
  const int qpos = q0 + wid * QBLK + r32;
  bf16x8 vs0, vs1, ksr[NKC];
#define TROW(j) (64 * (j) + ((WINDOW && (j) >= 4) ? ks : 0))
#define SLOAD(j) do { const long _k0 = TROW(j); vs0 = *reinterpret_cast<const bf16x8*>(&Vh[(_k0 + sr) * DV + sc]); vs1 = *reinterpret_cast<const bf16x8*>(&Vh[(_k0 + 32 + sr) * DV + sc]); \
    _Pragma("unroll") for (int _i = 0; _i < NKC; ++_i) ksr[_i] = *reinterpret_cast<const bf16x8*>(&Kh[(_k0 + krow[_i]) * DK + kcc[_i] * 8]); } while (0)
#define SWRITE(b) do { *(bf16x8*)(V_lds + (b) * SHM_V + vst0) = vs0; *(bf16x8*)(V_lds + (b) * SHM_V + vst1) = vs1; \
    _Pragma("unroll") for (int _i = 0; _i < NKC; ++_i) *(bf16x8*)(K_lds + (b) * SHM_K + kswz<DK>(krow[_i], kcc[_i] * 16)) = ksr[_i]; } while (0)
#define SWAIT() asm volatile("s_waitcnt vmcnt(0)" ::: "memory")
#define RESC(a) do { if (__any((a) < 1.f)) { if (hi == 0) al_l[r32] = (a); asm volatile("s_waitcnt lgkmcnt(0)" ::: "memory"); \
    _Pragma("unroll") for (int d = 0; d < 4; ++d) _Pragma("unroll") for (int r = 0; r < 16; ++r) o[d][r] *= al_l[crow(r, hi)]; } } while (0)
#define MASKED(j) (WINDOW && (j) >= 4)
#define DQ(j) ((WINDOW && (j) >= 4) ? qpos - (ks + 64 * ((j) - 4)) : 0)
  f32x16 p0, p1; float mn, al; bf16x8 pa0, pa1, pa2, pa3;
  SLOAD(0); SWAIT(); SWRITE(0); __syncthreads();
  for (int j = 0; j < NT; ++j) {
    const int bsel = j & 1;
    if (j + 1 < NT) SLOAD(j + 1);
    const int kp0_ = ks + 64 * (j - 4), qw0_ = q0 + wid * QBLK;
    if (!WINDOW || j < 4 || (kp0_ <= qw0_ + (QBLK - 1) + 128 && kp0_ + 63 >= qw0_ - 128)) {
      SBAR(); qkt_s<DK>(p0, p1, K_lds + bsel * SHM_K, qr, r32, hi);
      partialSM<DK, WINDOW>(p0, p1, m_reg, mn, al, DQ(j), hi);
      RESC(al);
      finishSM(p0, p1, al, l_reg, pa0, pa1, pa2, pa3); SBAR();
      pv_d0(o, vb0 + bsel * SHM_V, pa0, pa1, pa2, pa3); }
    if (j + 1 < NT) { SWAIT(); SWRITE(bsel ^ 1); }
    __syncthreads();
  }
  if (hi == 0) li_l[r32] = l_reg; asm volatile("s_waitcnt lgkmcnt(0)" ::: "memory");
  float rli[16];
#pragma unroll
  for (int r = 0; r < 16; ++r) rli[r] = 16.0f * __builtin_amdgcn_rcpf(li_l[crow(r, hi)]);
  unsigned char* Ow = Ob + (long)(wid * QBLK) * ldo;
#pragma unroll
  for (int r = 0; r < 16; ++r) { const int orow = crow(r, hi);
    *(unsigned*)(Ow + (long)orow * ldo + 4 * r32) = pk4_fp8(o[0][r] * rli[r], o[1][r] * rli[r], o[2][r] * rli[r], o[3][r] * rli[r]); }
  __syncthreads();
#undef TROW
#undef SLOAD
#undef SWRITE
#undef SWAIT
#undef RESC
#undef MASKED
#undef DQ
}
}
struct Frame {
    LAS unsigned char* lds; volatile LAS unsigned* MISC; unsigned* ctl;
    int tid, lane, wave, vcu, G;
    const float *x, *c, *ctx, *c_ctx, *w_ada, *b_ada, *g_norm, *w_in, *g_aqn, *g_akn, *g_bq_lat, *w_bq_up, *g_bkv_lat, *w_bkv_up, *g_bqn, *g_bkn, *sink, *w_o, *w_fo, *b_fo, *w_router, *b_router, *w_gate, *w_up, *w_down;
    float* out; unsigned char* ws;
};
#define WSP(T_, off) ((T_*)(F.ws + (off)))

__device__ __forceinline__ void transpose_item(const float* W, int N, bf16_t* WT, int ldk, int k0, int n0, int drow0, LAS float* scr, int lane) {
#pragma unroll 8
    for (int i = 0; i < 32; ++i) { const int kk = 2 * i + (lane >> 5); scr[kk * 33 + (lane & 31)] = W[(size_t)(k0 + kk) * N + n0 + (lane & 31)]; }
    LDS_WAIT(); asm volatile("" ::: "memory");
    const int c = lane & 7;
#pragma unroll
    for (int j = 0; j < 4; ++j) { const int n = (lane >> 3) + 8 * j; const LAS float* s = scr + (8 * c) * 33 + n;
        u32x4 o; o.x = pk2(s[0 * 33], s[1 * 33]); o.y = pk2(s[2 * 33], s[3 * 33]); o.z = pk2(s[4 * 33], s[5 * 33]); o.w = pk2(s[6 * 33], s[7 * 33]);
        *(GAS u32x4*)(WT + (size_t)(drow0 + n) * ldk + k0 + 8 * c) = o; }
    LDS_WAIT(); asm volatile("" ::: "memory");
}
__device__ __forceinline__ void transpose_item8(const float* W, int N, unsigned char* WT, int ldk, int k0, int n0, int drow0, LAS float* scr, int lane) {
    const float* p = W + (size_t)(k0 + (lane >> 3)) * N + n0 + (lane & 7) * 4; f32x4 r[8];
#pragma unroll
    for (int i = 0; i < 8; ++i) r[i] = __builtin_nontemporal_load((const f32x4*)(p + (size_t)(8 * i) * N));
#pragma unroll
    for (int i = 0; i < 8; ++i) *(LAS f32x4*)(scr + (8 * i + (lane >> 3)) * 36 + (lane & 7) * 4) = r[i];
    LDS_WAIT(); asm volatile("" ::: "memory");
    const int c = lane & 3;
#pragma unroll
    for (int j = 0; j < 2; ++j) { const int n = (lane >> 2) + 16 * j; const LAS float* s = scr + (16 * c) * 36 + n;
        u32x4 o; o.x = pk4_fp8(s[0 * 36] * W8_SCALE, s[1 * 36] * W8_SCALE, s[2 * 36] * W8_SCALE, s[3 * 36] * W8_SCALE); o.y = pk4_fp8(s[4 * 36] * W8_SCALE, s[5 * 36] * W8_SCALE, s[6 * 36] * W8_SCALE, s[7 * 36] * W8_SCALE);
        o.z = pk4_fp8(s[8 * 36] * W8_SCALE, s[9 * 36] * W8_SCALE, s[10 * 36] * W8_SCALE, s[11 * 36] * W8_SCALE); o.w = pk4_fp8(s[12 * 36] * W8_SCALE, s[13 * 36] * W8_SCALE, s[14 * 36] * W8_SCALE, s[15 * 36] * W8_SCALE);
        *(GAS u32x4*)(WT + (size_t)(drow0 + n) * ldk + k0 + 16 * c) = o; }
    LDS_WAIT(); asm volatile("" ::: "memory");
}
__device__ __forceinline__ int wo_src_row(int kp) { return (kp & ~127) + 32 * (kp & 3) + ((kp & 127) >> 2); }
__device__ __forceinline__ int fo_src_row(int kp) { const int p = kp & 255; return (kp & ~255) + (p <= 128 ? p : 384 - p); }
template <bool FO = false>
__device__ __forceinline__ void transpose_item8_wo(const float* W, int N, unsigned char* WT, int ldk, int k0, int n0, LAS float* scr, int lane) {
    f32x4 r[8];
#pragma unroll
    for (int i = 0; i < 8; ++i) { const int kp = k0 + 8 * i + (lane >> 3); r[i] = __builtin_nontemporal_load((const f32x4*)(W + (size_t)(FO ? fo_src_row(kp) : wo_src_row(kp)) * N + n0 + (lane & 7) * 4)); }
#pragma unroll
    for (int i = 0; i < 8; ++i) *(LAS f32x4*)(scr + (8 * i + (lane >> 3)) * 36 + (lane & 7) * 4) = r[i];
    LDS_WAIT(); asm volatile("" ::: "memory");
    const int c = lane & 3;
#pragma unroll
    for (int j = 0; j < 2; ++j) { const int n = (lane >> 2) + 16 * j; const LAS float* s = scr + (16 * c) * 36 + n;
        u32x4 o; o.x = pk4_fp8(s[0 * 36] * W8_SCALE, s[1 * 36] * W8_SCALE, s[2 * 36] * W8_SCALE, s[3 * 36] * W8_SCALE); o.y = pk4_fp8(s[4 * 36] * W8_SCALE, s[5 * 36] * W8_SCALE, s[6 * 36] * W8_SCALE, s[7 * 36] * W8_SCALE);
        o.z = pk4_fp8(s[8 * 36] * W8_SCALE, s[9 * 36] * W8_SCALE, s[10 * 36] * W8_SCALE, s[11 * 36] * W8_SCALE); o.w = pk4_fp8(s[12 * 36] * W8_SCALE, s[13 * 36] * W8_SCALE, s[14 * 36] * W8_SCALE, s[15 * 36] * W8_SCALE);
        *(GAS u32x4*)(WT + (size_t)(n0 + n) * ldk + k0 + 16 * c) = o; }
    LDS_WAIT(); asm volatile("" ::: "memory");
}
__device__ __forceinline__ void conv_plain(const float* W, int K, int N, bf16_t* WT, int item, LAS float* scr, int lane) {
    const int nblk = N / 32, kb = item / nblk, nb = item % nblk; transpose_item(W, N, WT, K, 64 * kb, 32 * nb, 32 * nb, scr, lane);
}

__device__ __forceinline__ void ada_task(Frame& F, int task, const LAS float* sl  , LAS float* red  ) {
    const int l = task / 384, n0 = (task % 384) * 32, kq = F.lane >> 3, c8 = F.lane & 7, k0 = F.wave * 256 + kq;
    const float* wp = F.w_ada + ((size_t)l * DM + k0) * 12288 + n0 + 4 * c8;
    f32x4 a0 = {0, 0, 0, 0}, a1 = a0, a2 = a0, a3 = a0, a4 = a0;
#pragma unroll 8
    for (int i = 0; i < 32; ++i) { const f32x4 w = __builtin_nontemporal_load((const f32x4*)(wp + (size_t)i * 8 * 12288)); const int k = k0 + 8 * i;
        const f32x4 s = *(const LAS f32x4*)(sl + k * 8); const float s4 = sl[k * 8 + 4];
        a0 += w * s[0]; a1 += w * s[1]; a2 += w * s[2]; a3 += w * s[3]; a4 += w * s4; }
#pragma unroll
    for (int o = 8; o < 64; o <<= 1) {
#pragma unroll
        for (int j = 0; j < 4; ++j) { a0[j] += __shfl_xor(a0[j], o); a1[j] += __shfl_xor(a1[j], o); a2[j] += __shfl_xor(a2[j], o); a3[j] += __shfl_xor(a3[j], o); a4[j] += __shfl_xor(a4[j], o); } }
    if (kq == 0) { LAS float* rp = red + (F.wave * 5) * 32 + 4 * c8;
        *(LAS f32x4*)(rp) = a0; *(LAS f32x4*)(rp + 32) = a1; *(LAS f32x4*)(rp + 64) = a2; *(LAS f32x4*)(rp + 96) = a3; *(LAS f32x4*)(rp + 128) = a4; }
    __syncthreads();
    if (F.tid < 160) { const int r = F.tid >> 5, col = F.tid & 31; float v = F.b_ada[(size_t)l * 12288 + n0 + col];
#pragma unroll
        for (int w = 0; w < 8; ++w) v += red[(w * 5 + r) * 32 + col];
        WSP(float, WS_MOD)[((size_t)l * 5 + r) * 12288 + n0 + col] = v; }
    __syncthreads();
}

#ifndef BG_PW
#define BG_PW 96
#endif
constexpr int BG_PER_WAVE = BG_PW;
static_assert(BG_PER_WAVE <= 2 * (KVLEN / 64 - 1), "background items per wave");
__device__ __forceinline__ int bg_split(int ngw) { const int n0 = BG_TOTAL - ngw * BG_PER_WAVE; return n0 > BG_SQ ? n0 : BG_SQ; }
__device__ __forceinline__ void bg_setup(Frame& F, BgConv& bg) { bg.item = 0; bg.end = 0; bg.w_o = F.w_o; bg.w_gate = F.w_gate; bg.w_up = F.w_up; bg.w_down = F.w_down;
    bg.o8 = WSP(unsigned char, WS_WO_T); bg.gu8 = WSP(unsigned char, WS_WGU_T); bg.d8 = WSP(unsigned char, WS_WD_T); }
constexpr int ADA_TASKS = 2 * 384, ADA_P0_END = MK_SINGLE ? 128 : ADA_TASKS, ADA_P2_END = 384, ADA_P10_END = 640;
__device__ __forceinline__ void ada_tail(Frame& F, int lo, int hi, int first, int step) {
    LAS float* sl = (LAS float*)(F.lds); LAS float* red = (LAS float*)(F.lds + 65536);
    __syncthreads();
    for (int i = F.tid; i < DM * 5; i += NTHR) { const int r = i / DM, k = i % DM; const float v = r < 4 ? F.c[r * DM + k] : F.c_ctx[k]; sl[k * 8 + r] = silu_f(v); }
    __syncthreads();
    for (int task = lo + first; task < hi; task += step) ada_task(F, task, sl, red);
}
__device__ __forceinline__ void ada_idle(Frame& F, int U, int c, int lo, int hi) {
    if (!MK_SINGLE || lo >= hi) return;
    const int R = (U + F.G - 1) / F.G, nb = U - (R - 1) * F.G;
    if (nb >= F.G || nb <= 0) ada_tail(F, lo, hi, c, F.G); else if (c >= nb) ada_tail(F, lo, hi, c - nb, F.G - nb);
}
template <int PRB = 0>
__device__ __forceinline__ void p0_prologue(Frame& F) {
    const int gw = F.vcu * NWAVES + F.wave, NGW = F.G * NWAVES;
    LAS float* sl = (LAS float*)(F.lds);
    for (int i = F.tid; i < DM * 5; i += NTHR) { const int r = i / DM, k = i % DM; const float v = r < 4 ? F.c[r * DM + k] : F.c_ctx[k]; sl[k * 8 + r] = silu_f(v); }
    __syncthreads();
    if (PRB == 0 || PRB == 1) { LAS float* red = (LAS float*)(F.lds + 65536); for (int task = F.vcu; task < ADA_P0_END; task += F.G) ada_task(F, task, sl, red); }
    __syncthreads();
    LAS float* scr = (LAS float*)(F.lds + F.wave * 16384);
    constexpr int I_IN = (DM / 64) * (INW / 32), I_BQ = (512 / 64) * (1536 / 32), I_BKV = (256 / 64) * (2048 / 32), I_SQ = (DM / 64) * (DM / 32), I_E = (DM / 64) * (DE / 32)  ;
    constexpr int NITEMS = I_IN + I_BQ + I_BKV + 2 * I_SQ;
    if (PRB == 0 || PRB == 2) for (int it = gw; it < NITEMS; it += NGW) {
        int r = it;
        if (r < I_IN) { const int nblk = INW / 32, kb = r / nblk, nb = r % nblk; transpose_item8(F.w_in, INW, WSP(unsigned char, WS_WIN_T), DM, 64 * kb, 32 * nb, 32 * nb, scr, F.lane); continue; } r -= I_IN;
        if (r < I_BQ) { conv_plain(F.w_bq_up, 512, 1536, WSP(bf16_t, WS_WBQ_T), r, scr, F.lane); continue; } r -= I_BQ;
        if (r < I_BKV) { conv_plain(F.w_bkv_up, 256, 2048, WSP(bf16_t, WS_WBKV_T), r, scr, F.lane); continue; } r -= I_BKV;
        if (r < I_SQ) { const int nblk = DM / 32, kb = r / nblk, nb = r % nblk; transpose_item8_wo<true>(F.w_fo, DM, WSP(unsigned char, WS_WFO_T), DM, 64 * kb, 32 * nb, scr, F.lane); continue; } r -= I_SQ;
        { const int nblk = DM / 32, kb = r / nblk, nb = r % nblk; transpose_item8_wo(F.w_o, DM, WSP(unsigned char, WS_WO_T), DM, 64 * kb, 32 * nb, scr, F.lane); }
    }
    if (PRB == 0 || PRB == 3) { BgConv bg; bg_setup(F, bg); const int n0 = bg_split(NGW); const unsigned slot = (unsigned)(uintptr_t)(char*)(F.lds + F.wave * 16384 + 8192);
      if (BG_SQ + gw < n0) { bg_issue_at(bg, BG_SQ + gw, F.lane, slot);
        for (int idx = BG_SQ + gw, par = 0; idx < n0; idx += NGW, par ^= 1) { const int nx = idx + NGW;
          if (nx < n0) { bg_issue_at(bg, nx, F.lane, slot + (par ^ 1) * 4096u); asm volatile("s_waitcnt vmcnt(4)" ::: "memory"); } else asm volatile("s_waitcnt vmcnt(0)" ::: "memory");
          bg_consume_at(bg, idx, F.lane, slot + par * 4096u); } } }
    if (PRB != 0 && PRB != 4) return;
    for (int i = blockIdx.x * NTHR + F.tid; i < DM * NE; i += F.G * NTHR) { const int e = i >> 11, k = i & 2047; WSP(float, WS_WRT)[i] = F.w_router[k * NE + e]; }
    { u32x4* z = (u32x4*)(WSP(unsigned char, WS_WIN_T) + (size_t)INW * DM); const int n16 = (INWP - INW) * DM / 16;
      for (int i = blockIdx.x * NTHR + F.tid; i < n16; i += F.G * NTHR) z[i] = (u32x4){0u, 0u, 0u, 0u}; }
    for (int i = blockIdx.x * NTHR + F.tid; i < 256 * 512 / 2; i += F.G * NTHR) { const int e = 2 * i, row = e >> 9, kk = e & 511, po = row >> 7, j = row & 127, pi = kk >> 8, c0 = kk & 255; float v[2];
#pragma unroll
        for (int q = 0; q < 2; ++q) { const float f = (float)((j * (c0 + q)) & 255) * (1.0f / 256.0f); const float cs = __builtin_amdgcn_cosf(f), sn = __builtin_amdgcn_sinf(f); v[q] = po == 0 ? (pi == 0 ? cs : sn) : (pi == 0 ? -sn : cs); }
        WSP(unsigned, WS_A1)[i] = pk2(v[0], v[1]); }
    for (int i = blockIdx.x * NTHR + F.tid; i < 256 * 512 / 2; i += F.G * NTHR) { const int e = 2 * i, k2 = e >> 9, kk = e & 511, pi = kk >> 8, s0 = kk & 255; float v[2];
#pragma unroll
        for (int q = 0; q < 2; ++q) { const float f = (float)((k2 * (s0 + q)) & 255) * (1.0f / 256.0f); v[q] = pi == 0 ? __builtin_amdgcn_cosf(f) : __builtin_amdgcn_sinf(f); }
        WSP(unsigned, WS_W2)[i] = pk2(v[0], v[1]); }
}

__device__ __forceinline__ void norm_mod_row(const float* xrow, const float* g, const float* sh, const float* sc, bf16_t* orow, int lane, f32x4 (&v)[8]) {
    const GAS f32x4* xr = (const GAS f32x4*)xrow + lane; float ss = 0.f;
#pragma unroll
    for (int j = 0; j < 8; ++j) { v[j] = xr[64 * j]; ss += (v[j].x * v[j].x + v[j].y * v[j].y) + (v[j].z * v[j].z + v[j].w * v[j].w); }
    const float rstd = 1.0f / sqrtf(wave_sum(ss) * (1.0f / DM) + EPS);
    GAS u32x2* o8 = (GAS u32x2*)orow + lane;
#pragma unroll
    for (int j = 0; j < 8; ++j) { const f32x4 gg = ((const GAS f32x4*)g)[lane + 64 * j], s1 = ((const GAS f32x4*)sc)[lane + 64 * j], s0 = ((const GAS f32x4*)sh)[lane + 64 * j];
        v[j] = (v[j] * rstd * gg) * (1.0f + s1) + s0; u32x2 w; w.x = pk2(v[j].x, v[j].y); w.y = pk2(v[j].z, v[j].w); o8[64 * j] = w; }
}
__device__ __forceinline__ void load_row(const float* xrow, int lane, f32x4 (&v)[8]) {
    const GAS f32x4* xr = (const GAS f32x4*)xrow + lane;
#pragma unroll
    for (int j = 0; j < 8; ++j) v[j] = xr[64 * j];
}
__device__ __forceinline__ void load_row_bf(const bf16_t* xrow, int lane, f32x4 (&v)[8]) {
    const GAS u32x2* xr = (const GAS u32x2*)xrow + lane;
#pragma unroll
    for (int j = 0; j < 8; ++j) { const u32x2 w = xr[64 * j]; v[j] = (f32x4){bflo(w.x), bfhi(w.x), bflo(w.y), bfhi(w.y)}; }
}
__device__ __forceinline__ void norm_mod_apply8(f32x4 (&v)[8], const float* g, const float* sh, const float* sc, unsigned char* orow, int lane) {
    float ss = 0.f;
#pragma unroll
    for (int j = 0; j < 8; ++j) ss += (v[j].x * v[j].x + v[j].y * v[j].y) + (v[j].z * v[j].z + v[j].w * v[j].w);
    const float rstd = 1.0f / sqrtf(wave_sum(ss) * (1.0f / DM) + EPS);
    GAS unsigned* o4 = (GAS unsigned*)orow + lane;
#pragma unroll
    for (int j = 0; j < 8; ++j) { const f32x4 gg = ((const GAS f32x4*)g)[lane + 64 * j], s1 = ((const GAS f32x4*)sc)[lane + 64 * j], s0 = ((const GAS f32x4*)sh)[lane + 64 * j];
        v[j] = (v[j] * rstd * gg) * (1.0f + s1) + s0; o4[64 * j] = pk4_fp8(v[j].x, v[j].y, v[j].z, v[j].w); }
}
__device__ __forceinline__ const float* modp(Frame& F, int l, int r, int chunk) { return WSP(float, WS_MOD) + ((size_t)l * 5 + r) * 12288 + chunk * DM; }

__device__ __forceinline__ const float* p1_rowptr(Frame& F, int row) { return row < T ? F.x + (size_t)row * DM : F.ctx + (size_t)(row - T) * DM; }
__device__ __forceinline__ void p1_norm(Frame& F) {
    const int gw = F.vcu * NWAVES + F.wave, NGW = F.G * NWAVES; f32x4 v[8], vn[8];
    if (gw < TT) load_row(p1_rowptr(F, gw), F.lane, v);
    for (int row = gw; row < TT; row += NGW) { const int r = row < T ? row / SEQ : 4;
        { const int nr = row + NGW < TT ? row + NGW : row; load_row(p1_rowptr(F, nr), F.lane, vn); }
        norm_mod_apply8(v, F.g_norm, modp(F, 0, r, 0), modp(F, 0, r, 1), WSP(unsigned char, WS_H) + (size_t)row * DM, F.lane);
#pragma unroll
        for (int j = 0; j < 8; ++j) v[j] = vn[j]; }
}


struct P3Raw { u32x2 aq[4], ak, av, bkv; u32x4 bq; unsigned kr; };
__device__ __forceinline__ void p3_load(const bf16_t* __restrict__ pr, int lane, P3Raw& r) {
    const int li = lane & 31, hh = lane >> 5;
#pragma unroll
    for (int ps = 0; ps < 4; ++ps) r.aq[ps] = *(const u32x2*)(pr + (2 * ps + hh) * 128 + 4 * li);
    r.ak = *(const u32x2*)(pr + 1024 + hh * 128 + 4 * li);
    r.av = *(const u32x2*)(pr + 1280 + 4 * lane); r.bq = *(const u32x4*)(pr + 1536 + 8 * lane); r.bkv = *(const u32x2*)(pr + 2048 + 4 * lane); r.kr = pr[2304 + lane];
}
__device__ __forceinline__ void p3_post(Frame& F) {
    const int gw = F.vcu * NWAVES + F.wave, NGW = F.G * NWAVES, lane = F.lane, li = lane & 31, hh = lane >> 5;
    const bf16_t* __restrict__ P = WSP(bf16_t, WS_P);
    const bool colpart = (li >> 4) != 0; const float sgn = ((li & 15) >= 8) ? 1.0f : -1.0f;
    float fr[4], gq[4], gk[4];
#pragma unroll
    for (int e = 0; e < 4; ++e) { fr[e] = powf(10000.0f, -(float)((4 * li + e) & 31) * (1.0f / 32.0f)); gq[e] = F.g_aqn[4 * li + e]; gk[e] = F.g_akn[4 * li + e]; }
    const f32x4 gb0 = *(const f32x4*)(F.g_bq_lat + 8 * lane), gb1 = *(const f32x4*)(F.g_bq_lat + 8 * lane + 4), gkv = *(const f32x4*)(F.g_bkv_lat + 4 * lane);
    P3Raw cur, nxt;
    if (gw < TT) p3_load(P + (size_t)gw * INWP, lane, cur);
    for (int row = gw; row < TT; row += NGW) {
        { const int nr = row + NGW < TT ? row + NGW : row; p3_load(P + (size_t)nr * INWP, lane, nxt); }
        const bool lat = row < T; const int b = lat ? row / SEQ : (row - T) / CTX, s = lat ? row % SEQ : (row - T) % CTX, kpos = lat ? CTX + s : s;
        float cs[4], sn[4]; { const float pos = colpart ? (float)(s % 64) : (float)(s / 64);
#pragma unroll
            for (int e = 0; e < 4; ++e) { sn[e] = __sinf(pos * fr[e]); cs[e] = __cosf(pos * fr[e]); } }
        if (lat) {
#pragma unroll
            for (int ps = 0; ps < 4; ++ps) { const int head = 2 * ps + hh; float y[4] = {bflo(cur.aq[ps].x), bfhi(cur.aq[ps].x), bflo(cur.aq[ps].y), bfhi(cur.aq[ps].y)};
                const float rstd = 1.0f / sqrtf(half_sum((y[0] * y[0] + y[1] * y[1]) + (y[2] * y[2] + y[3] * y[3])) * (1.0f / 128.0f) + EPS); float o[4];
#pragma unroll
                for (int e = 0; e < 4; ++e) y[e] = y[e] * rstd * gq[e];
#pragma unroll
                for (int e = 0; e < 4; ++e) { const float pz = __shfl_xor(y[e], 8); o[e] = y[e] * cs[e] + sgn * pz * sn[e]; }
                u32x2 w; w.x = pk2(o[0], o[1]); w.y = pk2(o[2], o[3]); *(u32x2*)(WSP(bf16_t, WS_QA) + (size_t)row * 1024 + head * 128 + 4 * li) = w; }
            { const u32x4 w = cur.bq; float y[8] = {bflo(w.x), bfhi(w.x), bflo(w.y), bfhi(w.y), bflo(w.z), bfhi(w.z), bflo(w.w), bfhi(w.w)}; float ss = 0.f;
#pragma unroll
              for (int q = 0; q < 8; ++q) ss += y[q] * y[q];
              const float rstd = 1.0f / sqrtf(wave_sum(ss) * (1.0f / 512.0f) + EPS);
              u32x4 o; o.x = pk2(y[0] * rstd * gb0.x, y[1] * rstd * gb0.y); o.y = pk2(y[2] * rstd * gb0.z, y[3] * rstd * gb0.w); o.z = pk2(y[4] * rstd * gb1.x, y[5] * rstd * gb1.y); o.w = pk2(y[6] * rstd * gb1.z, y[7] * rstd * gb1.w);
              *(u32x4*)(WSP(bf16_t, WS_BQL) + (size_t)row * 512 + 8 * lane) = o; }
        }
        { float y[4] = {bflo(cur.ak.x), bfhi(cur.ak.x), bflo(cur.ak.y), bfhi(cur.ak.y)};
          const float rstd = 1.0f / sqrtf(half_sum((y[0] * y[0] + y[1] * y[1]) + (y[2] * y[2] + y[3] * y[3])) * (1.0f / 128.0f) + EPS); float o[4];
#pragma unroll
          for (int e = 0; e < 4; ++e) y[e] = y[e] * rstd * gk[e];
#pragma unroll
          for (int e = 0; e < 4; ++e) { const float pz = __shfl_xor(y[e], 8); o[e] = lat ? y[e] * cs[e] + sgn * pz * sn[e] : y[e]; }
          u32x2 w; w.x = pk2(o[0], o[1]); w.y = pk2(o[2], o[3]); *(u32x2*)(WSP(bf16_t, WS_KA) + ((size_t)(b * 2 + hh) * KVLEN + kpos) * 128 + 4 * li) = w; }
        { const int d = 4 * lane, h2 = d >> 7; *(u32x2*)(WSP(bf16_t, WS_VA) + ((size_t)(b * 2 + h2) * KVLEN + kpos) * 128 + (d & 127)) = cur.av; }
        { const u32x2 w = cur.bkv; float y[4] = {bflo(w.x), bfhi(w.x), bflo(w.y), bfhi(w.y)};
          const float ss = (y[0] * y[0] + y[1] * y[1]) + (y[2] * y[2] + y[3] * y[3]);
          const float rstd = 1.0f / sqrtf(wave_sum(ss) * (1.0f / 256.0f) + EPS);
          u32x2 o; o.x = pk2(y[0] * rstd * gkv.x, y[1] * rstd * gkv.y); o.y = pk2(y[2] * rstd * gkv.z, y[3] * rstd * gkv.w);
          *(u32x2*)(WSP(bf16_t, WS_KVL) + (size_t)row * 256 + 4 * lane) = o; }
        WSP(bf16_t, WS_KR)[(size_t)row * 64 + lane] = (bf16_t)cur.kr;
        cur = nxt;
    }
}

struct P5Raw { unsigned qn[8], qt[8], kn[8], v[8], kr; };
__device__ __forceinline__ void p5_load(const bf16_t* __restrict__ q, const bf16_t* __restrict__ k, const bf16_t* __restrict__ kr, int lane, P5Raw& r) {
    const int j = lane & 31;
#pragma unroll
    for (int h = 0; h < 8; ++h) { r.qn[h] = *(const unsigned*)(q + h * 192 + 2 * lane); r.qt[h] = *(const unsigned*)(q + h * 192 + 128 + 2 * j);
        r.kn[h] = *(const unsigned*)(k + h * 256 + 2 * lane); r.v[h] = *(const unsigned*)(k + h * 256 + 128 + 2 * lane); }
    r.kr = *(const unsigned*)(kr + 2 * j);
}
__device__ __forceinline__ void p5_post(Frame& F) {
    const int gw = F.vcu * NWAVES + F.wave, NGW = F.G * NWAVES, lane = F.lane, j = lane & 31; const bool tl = lane < 32;
    const bf16_t* __restrict__ BQ = WSP(bf16_t, WS_BQ); const bf16_t* __restrict__ KV = WSP(bf16_t, WS_KV); const bf16_t* __restrict__ KR = WSP(bf16_t, WS_KR);
    const int w0 = (2 * j) & 31; const bool colpart = (j >> 4) != 0; const float sgn = (w0 >= 16) ? 1.0f : -1.0f;
    const float fr0 = powf(10000.0f, -(float)(w0 & 15) * (1.0f / 16.0f)), fr1 = powf(10000.0f, -(float)((w0 & 15) + 1) * (1.0f / 16.0f));
    const float gqn0 = F.g_bqn[2 * lane], gqn1 = F.g_bqn[2 * lane + 1], gqt0 = F.g_bqn[128 + 2 * j], gqt1 = F.g_bqn[129 + 2 * j];
    const float gkn0 = F.g_bkn[2 * lane], gkn1 = F.g_bkn[2 * lane + 1], gkt0 = F.g_bkn[128 + 2 * j], gkt1 = F.g_bkn[129 + 2 * j];
    P5Raw cur, nxt;
    if (gw < TT) p5_load(BQ + (size_t)gw * 1536, KV + (size_t)gw * DM, KR + (size_t)gw * 64, lane, cur);
    for (int row = gw; row < TT; row += NGW) {
        { const int nr = row + NGW < TT ? row + NGW : row; p5_load(BQ + (size_t)nr * 1536, KV + (size_t)nr * DM, KR + (size_t)nr * 64, lane, nxt); }
        const bool lat = row < T; const int b = lat ? row / SEQ : (row - T) / CTX, s = lat ? row % SEQ : (row - T) % CTX, kpos = lat ? CTX + s : s;
        float cs0, sn0, cs1, sn1; { const float pos = colpart ? (float)(s % 64) : (float)(s / 64); sn0 = __sinf(pos * fr0); cs0 = __cosf(pos * fr0); sn1 = __sinf(pos * fr1); cs1 = __cosf(pos * fr1); }
        const float kr0 = tl ? bflo(cur.kr) : 0.f, kr1 = tl ? bfhi(cur.kr) : 0.f;
#pragma unroll
        for (int h = 0; h < 8; ++h) {
            if (lat) {
                float y0 = bflo(cur.qn[h]), y1 = bfhi(cur.qn[h]), t0 = tl ? bflo(cur.qt[h]) : 0.f, t1 = tl ? bfhi(cur.qt[h]) : 0.f;
                const float rstd = 1.0f / sqrtf(wave_sum((y0 * y0 + y1 * y1) + (t0 * t0 + t1 * t1)) * (1.0f / 192.0f) + EPS);
                y0 *= rstd * gqn0; y1 *= rstd * gqn1; t0 *= rstd * gqt0; t1 *= rstd * gqt1;
                const float p0 = __shfl_xor(t0, 8), p1 = __shfl_xor(t1, 8);
                bf16_t* o = WSP(bf16_t, WS_QB) + (size_t)row * 1536 + h * 192;
                *(unsigned*)(o + 2 * lane) = pk2(y0, y1);
                if (tl) *(unsigned*)(o + 128 + 2 * j) = pk2(t0 * cs0 + sgn * p0 * sn0, t1 * cs1 + sgn * p1 * sn1); }
            { float y0 = bflo(cur.kn[h]), y1 = bfhi(cur.kn[h]), t0 = kr0, t1 = kr1;
              const float rstd = 1.0f / sqrtf(wave_sum((y0 * y0 + y1 * y1) + (t0 * t0 + t1 * t1)) * (1.0f / 192.0f) + EPS);
              y0 *= rstd * gkn0; y1 *= rstd * gkn1; t0 *= rstd * gkt0; t1 *= rstd * gkt1;
              const float p0 = __shfl_xor(t0, 8), p1 = __shfl_xor(t1, 8);
              bf16_t* o = WSP(bf16_t, WS_KB) + ((size_t)(b * 8 + h) * KVLEN + kpos) * 192;
              *(unsigned*)(o + 2 * lane) = pk2(y0, y1);
              if (tl) *(unsigned*)(o + 128 + 2 * j) = lat ? pk2(t0 * cs0 + sgn * p0 * sn0, t1 * cs1 + sgn * p1 * sn1) : pk2(t0, t1);
              *(unsigned*)(WSP(bf16_t, WS_VB) + ((size_t)(b * 8 + h) * KVLEN + kpos) * 128 + 2 * lane) = cur.v[h]; }
        }
        cur = nxt;
    }
}

__device__ __forceinline__ void pfa_dft16(Frame& F) {
    const int gw = F.vcu * NWAVES + F.wave, NGW = F.G * NWAVES, lane = F.lane;
    constexpr float C16[16] = {1.f, 0.92387953251f, 0.70710678119f, 0.38268343237f, 0.f, -0.38268343237f, -0.70710678119f, -0.92387953251f, -1.f, -0.92387953251f, -0.70710678119f, -0.38268343237f, 0.f, 0.38268343237f, 0.70710678119f, 0.92387953251f};
    constexpr float S16[16] = {0.f, 0.38268343237f, 0.70710678119f, 0.92387953251f, 1.f, 0.92387953251f, 0.70710678119f, 0.38268343237f, 0.f, -0.38268343237f, -0.70710678119f, -0.92387953251f, -1.f, -0.92387953251f, -0.70710678119f, -0.38268343237f};
    const bf16_t* H = WSP(bf16_t, WS_H); bf16_t* Y = WSP(bf16_t, WS_FY);
    for (int item = gw; item < NB * 256; item += NGW) { const int b = item >> 8, s2 = item & 255;
        float ct[16], st[16];
#pragma unroll
        for (int k1 = 0; k1 < 16; ++k1) { const float f = (float)((s2 * k1) & 4095) * (1.0f / 4096.0f); ct[k1] = __builtin_amdgcn_cosf(f); st[k1] = __builtin_amdgcn_sinf(f); }
        for (int g = 0; g < 8; ++g) {
            float x[16][4];
#pragma unroll
            for (int s1 = 0; s1 < 16; ++s1) { const u32x2 w = *(const u32x2*)(H + ((size_t)b * SEQ + 256 * s1 + s2) * DM + g * 256 + 4 * lane); x[s1][0] = bflo(w.x); x[s1][1] = bfhi(w.x); x[s1][2] = bflo(w.y); x[s1][3] = bfhi(w.y); }
#pragma unroll
            for (int k1 = 0; k1 <= 8; ++k1) { __builtin_amdgcn_sched_barrier(0); float A[4] = {0.f, 0.f, 0.f, 0.f}, Bq[4] = {0.f, 0.f, 0.f, 0.f};
#pragma unroll
                for (int s1 = 0; s1 < 16; ++s1) { const float c = C16[(s1 * k1) & 15], sn = S16[(s1 * k1) & 15];
#pragma unroll
                    for (int q = 0; q < 4; ++q) { if (c != 0.f) A[q] += c * x[s1][q]; if (sn != 0.f) Bq[q] += sn * x[s1][q]; } }
                { bf16_t* yp = Y + ((size_t)((b * 16 + k1) * 256 + s2)) * 4096 + g * 512 + 4 * lane; u32x2 wr_, wi_;
                  wr_.x = pk2(A[0] * ct[k1] - Bq[0] * st[k1], A[1] * ct[k1] - Bq[1] * st[k1]); wr_.y = pk2(A[2] * ct[k1] - Bq[2] * st[k1], A[3] * ct[k1] - Bq[3] * st[k1]);
                  wi_.x = pk2(-(A[0] * st[k1] + Bq[0] * ct[k1]), -(A[1] * st[k1] + Bq[1] * ct[k1])); wi_.y = pk2(-(A[2] * st[k1] + Bq[2] * ct[k1]), -(A[3] * st[k1] + Bq[3] * ct[k1]));
                  *(u32x2*)yp = wr_; *(u32x2*)(yp + 256) = wi_; }
                if (k1 >= 1 && k1 <= 7) { const int kc = 16 - k1;
                  bf16_t* yp = Y + ((size_t)((b * 16 + kc) * 256 + s2)) * 4096 + g * 512 + 4 * lane; u32x2 wr_, wi_;
                  wr_.x = pk2(A[0] * ct[kc] + Bq[0] * st[kc], A[1] * ct[kc] + Bq[1] * st[kc]); wr_.y = pk2(A[2] * ct[kc] + Bq[2] * st[kc], A[3] * ct[kc] + Bq[3] * st[kc]);
                  wi_.x = pk2(-(A[0] * st[kc] - Bq[0] * ct[kc]), -(A[1] * st[kc] - Bq[1] * ct[kc])); wi_.y = pk2(-(A[2] * st[kc] - Bq[2] * ct[kc]), -(A[3] * st[kc] - Bq[3] * ct[kc]));
                  *(u32x2*)yp = wr_; *(u32x2*)(yp + 256) = wi_; }
            }
        }
    }
}

__device__ __forceinline__ void p6_attn(Frame& F) {
    char* lds = (char*)F.lds;
    BgConv bg; bg_setup(F, bg); { const int gw = F.vcu * NWAVES + F.wave, NGW = F.G * NWAVES, n0 = bg_split(NGW); bg.item = n0 + gw * BG_PER_WAVE; bg.end = bg.item + BG_PER_WAVE < BG_TOTAL ? bg.item + BG_PER_WAVE : BG_TOTAL; if (bg.item > BG_TOTAL) bg.item = BG_TOTAL; }
    for (int uid = F.vcu; uid < 1024; uid += F.G) {
        const int u = uid & 511, qb = u & 15, h = (u >> 4) & 7, b = u >> 7; const size_t tok0 = (size_t)b * SEQ + qb * 256;
#ifndef ATT_NO_DENSE
        if (uid < 512) {
            att::attn_unit<192, false>(WSP(bf16_t, WS_QB) + tok0 * 1536 + h * 192, 1536, WSP(bf16_t, WS_KB) + (size_t)(b * 8 + h) * KVLEN * 192, WSP(bf16_t, WS_VB) + (size_t)(b * 8 + h) * KVLEN * 128,
                                       WSP(unsigned char, WS_Y) + tok0 * DM + 1024 + h * 128, DM, KVLEN / 64, 0, 0, 0.f, lds, F.wave, bg);
        }
#endif
#ifndef ATT_NO_WIN
        if (uid >= 512) {
            const int q0 = qb * 256, ks = q0 >= 128 ? q0 - 128 : 0, ke = (q0 + 384 < SEQ) ? q0 + 384 : SEQ, kvh = h >> 2;
            att::attn_unit_simple<128, true>(WSP(bf16_t, WS_QA) + tok0 * 1024 + h * 128, 1024, WSP(bf16_t, WS_KA) + (size_t)(b * 2 + kvh) * KVLEN * 128, WSP(bf16_t, WS_VA) + (size_t)(b * 2 + kvh) * KVLEN * 128,
                                      WSP(unsigned char, WS_Y) + tok0 * DM + h * 128, DM, 4 + (ke - ks) / 64, ks, q0, F.sink[h], lds, F.wave);
        }
#endif
    }
    { const int lane = lane_now(); const unsigned slot = (unsigned)(uintptr_t)(char*)(F.lds + F.wave * 4096); while (bg.item < bg.end) bg_now(bg, lane, slot); }
}
#define R_E(F) WSP(int, WS_ROUTE)
#define R_P(F) (WSP(int, WS_ROUTE) + 2 * T)
#define R_W(F) (WSP(float, WS_ROUTE) + 4 * T)
#define R_STOK(F) (WSP(int, WS_ROUTE) + 6 * T)
#define R_STOKE(F) WSP(int, WS_STOKE)
#define MOE_TAB_OFF (RING_BYTES + 2048)

__device__ __forceinline__ void logits16(const float (&p)[16], float (&out)[16]) {
    float q[8];
#pragma unroll
    for (int e = 0; e < 8; ++e) { const auto r = __builtin_amdgcn_permlane32_swap(__float_as_uint(p[e]), __float_as_uint(p[e + 8]), false, false);
        q[e] = __uint_as_float(r[0]) + __uint_as_float(r[1]); }
    float w[4];
#pragma unroll
    for (int e = 0; e < 4; ++e) { const auto r = __builtin_amdgcn_permlane16_swap(__float_as_uint(q[e]), __float_as_uint(q[e + 4]), false, false);
        w[e] = __uint_as_float(r[0]) + __uint_as_float(r[1]); }
#pragma unroll
    for (int e = 0; e < 4; ++e) w[e] = row_sum16(w[e]);
#pragma unroll
    for (int hrow = 0; hrow < 4; ++hrow)
#pragma unroll
        for (int e = 0; e < 4; ++e) out[8 * (hrow >> 1) + 4 * (hrow & 1) + e] = __builtin_bit_cast(float, __builtin_amdgcn_readlane(__builtin_bit_cast(int, w[e]), 16 * hrow));
}
__device__ __forceinline__ void norm_mod_lds8(f32x4 (&v)[8], const LAS float* gs, unsigned char* orow, int lane) {
    float ss = 0.f;
#pragma unroll
    for (int j = 0; j < 8; ++j) ss += (v[j].x * v[j].x + v[j].y * v[j].y) + (v[j].z * v[j].z + v[j].w * v[j].w);
    const float rstd = 1.0f / sqrtf(wave_sum(ss) * (1.0f / DM) + EPS);
    GAS unsigned* o4 = (GAS unsigned*)orow + lane;
#pragma unroll
    for (int j = 0; j < 8; ++j) { const f32x4 gg = ((const LAS f32x4*)gs)[lane + 64 * j], s0 = ((const LAS f32x4*)(gs + DM))[lane + 64 * j];
        v[j] = (v[j] * rstd) * gg + s0; o4[64 * j] = pk4_fp8(v[j].x, v[j].y, v[j].z, v[j].w); }
}
__device__ __forceinline__ void p8_stage_wrt(Frame& F) {
    const int lane = lane_now(); const char* src = (const char*)WSP(float, WS_WRT) + lane * 16;
    for (int i = F.wave - 1; i < DM * NE * 4 / 1024; i += NWAVES - 1) __builtin_amdgcn_global_load_lds((const unsigned*)(src + (size_t)i * 1024), (LAS unsigned*)(F.lds + i * 1024), 16, 0, 0);
}
__device__ __forceinline__ void p8_route(Frame& F, int l, bool wrt_staged = false) {
    const int tid = F.wave * 64 + lane_now(), lane = tid & 63;
    LAS float* wrt = (LAS float*)F.lds;
    LAS int* hist = (LAS int*)(F.lds + RING_BYTES);
    LAS int* hbase = hist + 16;
    LAS int* tinfo = (LAS int*)(F.lds + RING_BYTES + 1024);
    if (!wrt_staged) for (int i = tid; i < DM * NE / 4; i += NTHR) ((LAS f32x4*)wrt)[i] = ((const f32x4*)WSP(float, WS_WRT))[i];
    if (tid < 16) hist[tid] = 0;
    __syncthreads();
    float br[16];
#pragma unroll
    for (int e = 0; e < 16; ++e) br[e] = F.b_router[e];
    const float* g = F.g_norm + (size_t)(l * 2 + 1) * DM;
    unsigned* cnt = F.ctl + CW_CNT + l * 16 * 64;
    auto pick = [&](const float (&lg0)[16], const float (&lg1)[16], int tl) {
        float aff[16], sel[16];
#pragma unroll
        for (int e = 0; e < 16; ++e) { const float lgv = lane >= 32 ? lg1[e] : lg0[e]; aff[e] = __builtin_amdgcn_rcpf(1.0f + __expf(-lgv)); sel[e] = aff[e] + br[e]; }
        float gs[4], ga0[4], ga1[4]; int gi0[4], gi1[4];
#pragma unroll
        for (int gq = 0; gq < 4; ++gq) { int i0 = 0; float m0 = sel[4 * gq], a0 = aff[4 * gq];
#pragma unroll
            for (int i = 1; i < 4; ++i) if (sel[4 * gq + i] > m0) { m0 = sel[4 * gq + i]; a0 = aff[4 * gq + i]; i0 = i; }
            int i1 = -1; float m1 = -3.0e38f, a1 = 0.f;
#pragma unroll
            for (int i = 0; i < 4; ++i) if (i != i0 && sel[4 * gq + i] > m1) { m1 = sel[4 * gq + i]; a1 = aff[4 * gq + i]; i1 = i; }
            gs[gq] = m0 + m1; gi0[gq] = 4 * gq + i0; gi1[gq] = 4 * gq + i1; ga0[gq] = a0; ga1[gq] = a1; }
        int e0 = gi0[0], e1 = gi1[0]; float a0 = ga0[0], a1 = ga1[0], best = gs[0];
#pragma unroll
        for (int gq = 1; gq < 4; ++gq) if (gs[gq] > best) { best = gs[gq]; e0 = gi0[gq]; e1 = gi1[gq]; a0 = ga0[gq]; a1 = ga1[gq]; }
        const float inv = 1.0f / (a0 + a1);
        if ((lane & 31) == 0) { const int r0 = __hip_atomic_fetch_add(hist + e0, 1, __ATOMIC_RELAXED, __HIP_MEMORY_SCOPE_WORKGROUP), r1 = __hip_atomic_fetch_add(hist + e1, 1, __ATOMIC_RELAXED, __HIP_MEMORY_SCOPE_WORKGROUP);
            LAS int* ti = tinfo + tl * 6; ti[0] = e0; ti[1] = e1; ti[2] = r0; ti[3] = r1; ti[4] = __float_as_int(a0 * inv); ti[5] = __float_as_int(a1 * inv); } };
    LAS float* gsl = (LAS float*)(F.lds + RING_BYTES + 4096);
    for (int grp = F.vcu; grp < T / 64; grp += F.G) {
        { const int b = (grp * 64) / SEQ; const float* sh_ = modp(F, l, b, 3); const float* sc_ = modp(F, l, b, 4);
          const int t_ = F.wave * 64 + lane_now();
          const f32x4 gg = ((const f32x4*)g)[t_], s1 = ((const f32x4*)sc_)[t_], s0 = ((const f32x4*)sh_)[t_];
          __syncthreads(); ((LAS f32x4*)gsl)[t_] = gg * (1.0f + s1); ((LAS f32x4*)(gsl + DM))[t_] = s0; __syncthreads(); }
        f32x4 va[8], vb[8], na[8], nb[8]; const int tok00 = grp * 64 + F.wave * 8;
        load_row_bf(WSP(bf16_t, WS_XB) + (size_t)tok00 * DM, lane, va); load_row_bf(WSP(bf16_t, WS_XB) + (size_t)(tok00 + 1) * DM, lane, vb);
        for (int q = 0; q < 8; q += 2) { const int tl = F.wave * 8 + q, tok = grp * 64 + tl, b = tok / SEQ; const int tn = q < 6 ? tok + 2 : tok;
            load_row_bf(WSP(bf16_t, WS_XB) + (size_t)tn * DM, lane, na); load_row_bf(WSP(bf16_t, WS_XB) + (size_t)(tn + 1) * DM, lane, nb);
            norm_mod_lds8(va, gsl, WSP(unsigned char, WS_H) + (size_t)tok * DM, lane);
            norm_mod_lds8(vb, gsl, WSP(unsigned char, WS_H) + (size_t)(tok + 1) * DM, lane);
            float lga[16], lgb[16], pla[16], plb[16];
#pragma unroll
            for (int e = 0; e < 16; ++e) { float a = 0.f, c2 = 0.f;
                f32x2 pa = {0.f, 0.f}, pb = {0.f, 0.f};
#pragma unroll
                for (int j = 0; j < 8; ++j) { const f32x4 w = *(const LAS f32x4*)(wrt + e * DM + 256 * j + 4 * lane); const f32x2 wl = {w.x, w.y}, wh = {w.z, w.w};
                    pa = __builtin_elementwise_fma((f32x2){va[j].x, va[j].y}, wl, pa); pa = __builtin_elementwise_fma((f32x2){va[j].z, va[j].w}, wh, pa);
                    pb = __builtin_elementwise_fma((f32x2){vb[j].x, vb[j].y}, wl, pb); pb = __builtin_elementwise_fma((f32x2){vb[j].z, vb[j].w}, wh, pb); }
                a = pa.x + pa.y; c2 = pb.x + pb.y;
                pla[e] = a; plb[e] = c2; }
            logits16(pla, lga); logits16(plb, lgb);
            pick(lga, lgb, tl + (lane >> 5));
#pragma unroll
            for (int j = 0; j < 8; ++j) { va[j] = na[j]; vb[j] = nb[j]; }
        }
        __syncthreads();
        const int tq = F.wave * 64 + lane_now();
        if (tq < 16) hbase[tq] = (int)__hip_atomic_fetch_add(cnt + tq * 64, (unsigned)hist[tq], __ATOMIC_RELAXED, __HIP_MEMORY_SCOPE_AGENT);
        __syncthreads();
        if (tq < 64) { const int tok = grp * 64 + tq; const LAS int* ti = tinfo + tq * 6;
            const int q0 = hbase[ti[0]] + ti[2], q1 = hbase[ti[1]] + ti[3];
            R_E(F)[2 * tok] = ti[0]; R_E(F)[2 * tok + 1] = ti[1]; R_P(F)[2 * tok] = q0; R_P(F)[2 * tok + 1] = q1; R_STOKE(F)[ti[0] * T + q0] = tok; R_STOKE(F)[ti[1] * T + q1] = tok;
            R_W(F)[2 * tok] = __int_as_float(ti[4]); R_W(F)[2 * tok + 1] = __int_as_float(ti[5]); }
        if (tq < 16) hist[tq] = 0;
        __syncthreads();
    }
}
__device__ __forceinline__ LAS int* moe_table(Frame& F, int l, bool reuse = false) {
    LAS int* tab = (LAS int*)(F.lds + MOE_TAB_OFF);
    if (MK_SINGLE && reuse) return tab;
    __syncthreads();
    if (F.tid < 16) tab[176 + F.tid] = (int)__hip_atomic_load(F.ctl + CW_CNT + (l * 16 + F.tid) * 64, RLX_AGENT);
    __syncthreads();
    if (F.tid == 0) { int acc = 0;
        for (int e = 0; e < 16; ++e) { tab[160 + e] = acc; acc += (tab[176 + e] + 255) >> 8; }
        tab[192] = acc; }
    __syncthreads();
    if (F.tid < 160) { int e = 0;
#pragma unroll
        for (int k = 1; k < 16; ++k) e += (F.tid >= tab[160 + k]) ? 1 : 0;
        tab[F.tid] = e; }
    __syncthreads();
    return tab;
}
namespace pg8 {
struct MoeSched {
    TileOrder o; const char* A0; const char* B0; const int* stoke; LAS const int* tab; size_t eB, tA, tB;
    __device__ __forceinline__ void init(LAS const int* tab_, const void* A, const void* B, int lda, int ldb, size_t eB_, const int* stoke_, int G, int c) {
        tab = tab_; const int nrt = __builtin_amdgcn_readfirstlane(tab_[192]);
        o.init(nrt, DM / BM, 1, G, c); A0 = (const char*)A; B0 = (const char*)B; eB = eB_; stoke = stoke_; tA = (size_t)BM * lda * 2; tB = (size_t)BM * ldb * 2; }
    __device__ __forceinline__ void expert(Unit& u) const { const int e = __builtin_amdgcn_readfirstlane(tab[u.pm]); u.aux = e; u.r0 = (u.pm - __builtin_amdgcn_readfirstlane(tab[160 + e])) * BM; u.cnt = __builtin_amdgcn_readfirstlane(tab[176 + e]); }
};
struct MoeSched1 : MoeSched { static constexpr bool GATHER = true;
    __device__ __forceinline__ bool next(int i, Unit& u) const { if (!o.map(i, u.aux, u.pm, u.pn)) return false; expert(u); u.A = A0; u.B = B0 + (size_t)u.aux * eB + (size_t)u.pn * tB; return true; }
    __device__ __forceinline__ unsigned arow(const Unit& u, int r) const { const int p = u.r0 + r; return p < u.cnt ? (unsigned)stoke[u.aux * T + p] : 0u; } };
struct MoeSched2 : MoeSched { static constexpr bool GATHER = false;
    __device__ __forceinline__ bool next(int i, Unit& u) const { if (!o.map(i, u.aux, u.pm, u.pn)) return false; expert(u); u.A = A0 + (size_t)u.pm * tA; u.B = B0 + (size_t)u.aux * eB + (size_t)u.pn * tB; return true; }
    __device__ __forceinline__ unsigned arow(const Unit&, int) const { return 0u; } };
}
struct CmbIdx { int p0, p1; float w0, w1; };
struct CmbDat { u32x2 y0[8], y1[8], x[8]; };
__device__ __forceinline__ void cmb_idx(Frame& F, int tok, CmbIdx& i) { const u32x2 pp = *(const u32x2*)(R_P(F) + 2 * tok), ee = *(const u32x2*)(R_E(F) + 2 * tok); const f32x2 ww = *(const f32x2*)(R_W(F) + 2 * tok);
    const LAS int* tab = (const LAS int*)(F.lds + MOE_TAB_OFF); i.p0 = tab[160 + (int)ee.x] * 256 + (int)pp.x; i.p1 = tab[160 + (int)ee.y] * 256 + (int)pp.y; i.w0 = ww.x; i.w1 = ww.y; }
__device__ __forceinline__ void cmb_dat(Frame& F, int tok, const CmbIdx& i, int lane, CmbDat& d) { const bf16_t* YS = WSP(bf16_t, WS_YS); const bf16_t* xr = WSP(bf16_t, WS_XB) + (size_t)tok * DM;
#pragma unroll
    for (int j = 0; j < 8; ++j) { const int c = 4 * lane + 256 * j; d.y0[j] = *(const u32x2*)(YS + (size_t)i.p0 * DM + c); d.y1[j] = *(const u32x2*)(YS + (size_t)i.p1 * DM + c); d.x[j] = *(const u32x2*)(xr + c); } }
__device__ __forceinline__ void p12_combine(Frame& F, int l) {
    const int gw = F.vcu * NWAVES + F.wave, NGW = F.G * NWAVES, lane = F.lane;
    moe_table(F, l, true);
    if (gw >= T) return;
    CmbIdx ic, in_; CmbDat dc, dn;
    cmb_idx(F, gw, ic); cmb_dat(F, gw, ic, lane, dc); cmb_idx(F, gw + NGW < T ? gw + NGW : gw, in_);
    for (int tok = gw; tok < T; tok += NGW) { const int b = tok / SEQ; const int t1 = tok + NGW < T ? tok + NGW : tok, t2 = tok + 2 * NGW < T ? tok + 2 * NGW : t1;
        cmb_dat(F, t1, in_, lane, dn); CmbIdx inn; cmb_idx(F, t2, inn);
        const float w0 = ic.w0, w1 = ic.w1;
        const float* gt = modp(F, l, b, 5); f32x4 v[8]; float ss = 0.f;
#pragma unroll
        for (int j = 0; j < 8; ++j) { const int c = 4 * lane + 256 * j; const u32x2 y0 = dc.y0[j], y1 = dc.y1[j];
            const f32x4 gv = *(const f32x4*)(gt + c), xv = (f32x4){bflo(dc.x[j].x), bfhi(dc.x[j].x), bflo(dc.x[j].y), bfhi(dc.x[j].y)};
            f32x4 m; m.x = w0 * bflo(y0.x) + w1 * bflo(y1.x); m.y = w0 * bfhi(y0.x) + w1 * bfhi(y1.x); m.z = w0 * bflo(y0.y) + w1 * bflo(y1.y); m.w = w0 * bfhi(y0.y) + w1 * bfhi(y1.y);
            v[j] = xv + gv * m;
            if (l == 0) { u32x2 w; w.x = pk2(v[j].x, v[j].y); w.y = pk2(v[j].z, v[j].w); *(u32x2*)(WSP(bf16_t, WS_XB) + (size_t)tok * DM + c) = w; } else *(f32x4*)(F.out + (size_t)tok * DM + c) = v[j];
            ss += (v[j].x * v[j].x + v[j].y * v[j].y) + (v[j].z * v[j].z + v[j].w * v[j].w); }
        if (l == 0) { const float rstd = 1.0f / sqrtf(wave_sum(ss) * (1.0f / DM) + EPS); const float* g = F.g_norm + (size_t)2 * DM; const float* sh = modp(F, 1, b, 0); const float* sc = modp(F, 1, b, 1);
            bf16_t* orow = WSP(bf16_t, WS_H) + (size_t)tok * DM;
#pragma unroll
            for (int j = 0; j < 8; ++j) { const int c = 4 * lane + 256 * j; const f32x4 gg = *(const f32x4*)(g + c), s1 = *(const f32x4*)(sc + c), s0 = *(const f32x4*)(sh + c);
                const f32x4 hv = (v[j] * rstd * gg) * (1.0f + s1) + s0; u32x2 w; w.x = pk2(hv.x, hv.y); w.y = pk2(hv.z, hv.w); *(u32x2*)(orow + c) = w; } }
        ic = in_; in_ = inn; dc = dn;
    }
}

__device__ __forceinline__ void p12_fourier(Frame& F) {
    constexpr int l = 0;
    const int lane = F.lane, w = F.wave; const int nit = F.vcu < NB * 256 ? (NB * 256 - F.vcu + F.G - 1) / F.G : 0, ntok = 2 * nit;
    if (nit <= 0) return;
    moe_table(F, l, true);
    constexpr float C16[16] = {1.f, 0.92387953251f, 0.70710678119f, 0.38268343237f, 0.f, -0.38268343237f, -0.70710678119f, -0.92387953251f, -1.f, -0.92387953251f, -0.70710678119f, -0.38268343237f, 0.f, 0.38268343237f, 0.70710678119f, 0.92387953251f};
    constexpr float S16[16] = {0.f, 0.38268343237f, 0.70710678119f, 0.92387953251f, 1.f, 0.92387953251f, 0.70710678119f, 0.38268343237f, 0.f, -0.38268343237f, -0.70710678119f, -0.92387953251f, -1.f, -0.92387953251f, -0.70710678119f, -0.38268343237f};
    char* hl = (char*)F.lds; bf16_t* Y = WSP(bf16_t, WS_FY);
    auto tokof = [&](int n) { n = n < ntok ? n : ntok - 1; const int item = F.vcu + (n >> 1) * F.G; return (item >> 8) * SEQ + (item & 255) + 256 * (2 * w + (n & 1)); };
    CmbIdx ic, in_; CmbDat dc, dn;
    cmb_idx(F, tokof(0), ic); cmb_dat(F, tokof(0), ic, lane, dc); cmb_idx(F, tokof(1), in_);
    for (int n = 0; n < ntok; ++n) { const int tok = tokof(n), b = tok / SEQ;
        cmb_dat(F, tokof(n + 1), in_, lane, dn); CmbIdx inn; cmb_idx(F, tokof(n + 2), inn);
        const float w0 = ic.w0, w1 = ic.w1;
        const float* gt = modp(F, l, b, 5); f32x4 v[8]; float ss = 0.f;
#pragma unroll
        for (int j = 0; j < 8; ++j) { const int c = 4 * lane + 256 * j; const u32x2 y0 = dc.y0[j], y1 = dc.y1[j];
            const f32x4 gv = *(const f32x4*)(gt + c), xv = (f32x4){bflo(dc.x[j].x), bfhi(dc.x[j].x), bflo(dc.x[j].y), bfhi(dc.x[j].y)};
            f32x4 m; m.x = w0 * bflo(y0.x) + w1 * bflo(y1.x); m.y = w0 * bfhi(y0.x) + w1 * bfhi(y1.x); m.z = w0 * bflo(y0.y) + w1 * bflo(y1.y); m.w = w0 * bfhi(y0.y) + w1 * bfhi(y1.y);
            v[j] = xv + gv * m;
            { u32x2 wv; wv.x = pk2(v[j].x, v[j].y); wv.y = pk2(v[j].z, v[j].w); *(u32x2*)(WSP(bf16_t, WS_XB) + (size_t)tok * DM + c) = wv; }
            ss += (v[j].x * v[j].x + v[j].y * v[j].y) + (v[j].z * v[j].z + v[j].w * v[j].w); }
        { const float rstd = 1.0f / sqrtf(wave_sum(ss) * (1.0f / DM) + EPS); const float* g = F.g_norm + (size_t)2 * DM; const float* sh = modp(F, 1, b, 0); const float* sc = modp(F, 1, b, 1);
            char* orow = hl + (size_t)(2 * w + (n & 1)) * DM * 2;
#pragma unroll
            for (int j = 0; j < 8; ++j) { const int c = 4 * lane + 256 * j; const f32x4 gg = *(const f32x4*)(g + c), s1 = *(const f32x4*)(sc + c), s0 = *(const f32x4*)(sh + c);
                const f32x4 hv = (v[j] * rstd * gg) * (1.0f + s1) + s0; u32x2 wv; wv.x = pk2(hv.x, hv.y); wv.y = pk2(hv.z, hv.w); *(u32x2*)(orow + c * 2) = wv; } }
        ic = in_; in_ = inn; dc = dn;
        if (n & 1) {
            __syncthreads();
            const int item = F.vcu + (n >> 1) * F.G, s2 = item & 255, g = w;
            float x[16][4];
#pragma unroll
            for (int s1 = 0; s1 < 16; ++s1) { const u32x2 wv = *(const u32x2*)(hl + ((size_t)s1 * DM + g * 256 + 4 * lane) * 2); x[s1][0] = bflo(wv.x); x[s1][1] = bfhi(wv.x); x[s1][2] = bflo(wv.y); x[s1][3] = bfhi(wv.y); }
            { float y[16];
#pragma unroll
              for (int s1 = 0; s1 < 16; ++s1) y[s1] = wave_sum((x[s1][0] - x[s1][1]) + (x[s1][2] - x[s1][3]));
              if (lane < 16) { const int k1 = lane; float sA = 0.f, sB = 0.f;
#pragma unroll
                  for (int s1 = 0; s1 < 16; ++s1) { const float f = (float)((s1 * k1) & 15) * (1.0f / 16.0f); sA += __builtin_amdgcn_cosf(f) * y[s1]; sB += __builtin_amdgcn_sinf(f) * y[s1]; }
                  const float f = (float)((s2 * k1) & 4095) * (1.0f / 4096.0f), ct = __builtin_amdgcn_cosf(f), st = __builtin_amdgcn_sinf(f);
                  float* z = WSP(float, WS_Z128) + ((size_t)((b * 16 + k1) * 8 + g) * 2) * 256 + s2;
                  z[0] = sA * ct - sB * st; z[256] = -(sA * st + sB * ct); } }
            __builtin_amdgcn_sched_barrier(0);
#pragma unroll
            for (int k1 = 0; k1 <= 8; ++k1) { __builtin_amdgcn_sched_barrier(0); float A[4] = {0.f, 0.f, 0.f, 0.f}, Bq[4] = {0.f, 0.f, 0.f, 0.f};
#pragma unroll
                for (int s1 = 0; s1 < 16; ++s1) { const float c = C16[(s1 * k1) & 15], sn = S16[(s1 * k1) & 15];
#pragma unroll
                    for (int q = 0; q < 4; ++q) { if (c != 0.f) A[q] += c * x[s1][q]; if (sn != 0.f) Bq[q] += sn * x[s1][q]; } }
                { const float f = (float)((s2 * k1) & 4095) * (1.0f / 4096.0f), ct = __builtin_amdgcn_cosf(f), st = __builtin_amdgcn_sinf(f);
                  bf16_t* yp = Y + ((size_t)((b * 16 + k1) * 256 + s2)) * 4096 + g * 512 + 4 * lane; u32x2 wr_, wi_;
                  wr_.x = pk2(A[0] * ct - Bq[0] * st, A[1] * ct - Bq[1] * st); wr_.y = pk2(A[2] * ct - Bq[2] * st, A[3] * ct - Bq[3] * st);
                  wi_.x = pk2(-(A[0] * st + Bq[0] * ct), -(A[1] * st + Bq[1] * ct)); wi_.y = pk2(-(A[2] * st + Bq[2] * ct), -(A[3] * st + Bq[3] * ct));
                  *(u32x2*)yp = wr_; *(u32x2*)(yp + 256) = wi_; }
                if (k1 >= 1 && k1 <= 7) { const int kc = 16 - k1;
                  const float f = (float)((s2 * kc) & 4095) * (1.0f / 4096.0f), ct = __builtin_amdgcn_cosf(f), st = __builtin_amdgcn_sinf(f);
                  bf16_t* yp = Y + ((size_t)((b * 16 + kc) * 256 + s2)) * 4096 + g * 512 + 4 * lane; u32x2 wr_, wi_;
                  wr_.x = pk2(A[0] * ct + Bq[0] * st, A[1] * ct + Bq[1] * st); wr_.y = pk2(A[2] * ct + Bq[2] * st, A[3] * ct + Bq[3] * st);
                  wi_.x = pk2(-(A[0] * st - Bq[0] * ct), -(A[1] * st - Bq[1] * ct)); wi_.y = pk2(-(A[2] * st - Bq[2] * ct), -(A[3] * st - Bq[3] * ct));
                  *(u32x2*)yp = wr_; *(u32x2*)(yp + 256) = wi_; }
            }
            __syncthreads();
        }
    }
}


__device__ __forceinline__ void p13_freq128(Frame& F) {
    LAS float* ctab = (LAS float*)F.lds; LAS float* zl = ctab + 256 + F.wave * 512;
    if (F.tid < 256) ctab[F.tid] = __builtin_amdgcn_cosf((float)F.tid * (1.0f / 256.0f));
    __syncthreads();
    const int gw = F.vcu * NWAVES + F.wave, NGW = F.G * NWAVES, lane = F.lane;
    for (int it = gw; it < 64 * 8 * 4; it += NGW) { const int prob = it >> 2, quarter = it & 3, bk = prob >> 3, g = prob & 7, b = bk >> 4, k1 = bk & 15;
        const f32x4* z = (const f32x4*)(WSP(float, WS_Z128) + (size_t)prob * 512);
        const f32x4 z0 = z[lane], z1 = z[64 + lane];
        ((LAS f32x4*)zl)[lane] = z0; ((LAS f32x4*)zl)[64 + lane] = z1;
        asm volatile("s_waitcnt lgkmcnt(0)" ::: "memory");
        const int k2 = quarter * 64 + lane; float acc = 0.f;
#pragma unroll 4
        for (int s2 = 0; s2 < 256; ++s2) { const int idx = (s2 * k2) & 255; acc += ctab[idx] * zl[s2] + ctab[(idx - 64) & 255] * zl[256 + s2]; }
        WSP(unsigned char, WS_F)[(size_t)(b * SEQ + k1 + 16 * k2) * DM + g * 256 + 128] = (unsigned char)(pk4_fp8(acc * (1.0f / 1024.0f), 0.f, 0.f, 0.f) & 0xFFu);
        asm volatile("s_waitcnt lgkmcnt(0)" ::: "memory");
    }
}
#if defined(MK_CHECK)
constexpr int CW_CHK = 12288;
constexpr size_t WS_CHKP = WS_WS;
__device__ __forceinline__ void chk_add(Frame& F, float e2, float r2) {
    e2 = wave_sum(e2); r2 = wave_sum(r2);
    if (F.lane == 0) { atomicAdd((float*)(F.ctl + CW_CHK), e2); atomicAdd((float*)(F.ctl + CW_CHK + 64), r2); }
}
__device__ __forceinline__ void check_attn(Frame& F) {
    const int gw = F.vcu * NWAVES + F.wave, NGW = F.G * NWAVES, lane = F.lane;
    const int stoks[8] = {0, 1, 127, 128, 129, 2049, 3967, 4095};
    float* PS = WSP(float, WS_CHKP) + (size_t)gw * 4608;
    for (int item = gw; item < 2 * 4 * 8 * 8; item += NGW) {
        const int type = item >> 8, b = (item >> 6) & 3, h = (item >> 3) & 7; int sidx = item & 7; int s = 0;
#pragma unroll
        for (int q = 0; q < 8; ++q) s = (sidx == q) ? stoks[q] : s;
        const size_t tok = (size_t)b * SEQ + s;
        float mx = -3.0e38f;
        if (type == 0) {
            const bf16_t* q = WSP(bf16_t, WS_QB) + tok * 1536 + h * 192; const bf16_t* K = WSP(bf16_t, WS_KB) + (size_t)(b * 8 + h) * KVLEN * 192; const bf16_t* V = WSP(bf16_t, WS_VB) + (size_t)(b * 8 + h) * KVLEN * 128;
            for (int k = lane; k < KVLEN; k += 64) { float a = 0.f; for (int d = 0; d < 192; ++d) a += bf2f(q[d]) * bf2f(K[(size_t)k * 192 + d]); a *= 0.07216878364870322f; PS[k] = a; mx = fmaxf(mx, a); }
#pragma unroll
            for (int o = 1; o < 64; o <<= 1) mx = fmaxf(mx, __shfl_xor(mx, o));
            float l = 0.f; for (int k = lane; k < KVLEN; k += 64) { const float p = expf(PS[k] - mx); PS[k] = p; l += p; }
            l = wave_sum(l); __threadfence_block();
            float e2 = 0.f, r2 = 0.f;
            for (int d = lane; d < 128; d += 64) { float o = 0.f; for (int k = 0; k < KVLEN; ++k) o += PS[k] * bf2f(V[(size_t)k * 128 + d]); o /= l;
                const float y = __builtin_amdgcn_cvt_f32_fp8((int)WSP(unsigned char, WS_Y)[tok * DM + 1024 + h * 128 + 4 * (d & 31) + (d >> 5)], 0) * (1.0f / 16.0f); e2 += (o - y) * (o - y); r2 += o * o; }
            chk_add(F, e2, r2);
        } else {
            const int kvh = h >> 2; const bf16_t* q = WSP(bf16_t, WS_QA) + tok * 1024 + h * 128; const bf16_t* K = WSP(bf16_t, WS_KA) + (size_t)(b * 2 + kvh) * KVLEN * 128; const bf16_t* V = WSP(bf16_t, WS_VA) + (size_t)(b * 2 + kvh) * KVLEN * 128;
            const float snk = F.sink[h]; mx = snk;
            for (int k = lane; k < KVLEN; k += 64) { const int j = k - CTX; const bool ok = (k < CTX) || (j - s <= 128 && s - j <= 128); float a = -3.0e38f;
                if (ok) { a = 0.f; for (int d = 0; d < 128; ++d) a += bf2f(q[d]) * bf2f(K[(size_t)k * 128 + d]); a *= 0.08838834764831845f; }
                PS[k] = a; mx = fmaxf(mx, a); }
#pragma unroll
            for (int o = 1; o < 64; o <<= 1) mx = fmaxf(mx, __shfl_xor(mx, o));
            float l = 0.f; for (int k = lane; k < KVLEN; k += 64) { const float p = PS[k] > -1.0e38f ? expf(PS[k] - mx) : 0.f; PS[k] = p; l += p; }
            l = wave_sum(l) + expf(snk - mx); __threadfence_block();
            float e2 = 0.f, r2 = 0.f;
            for (int d = lane; d < 128; d += 64) { float o = 0.f; for (int k = 0; k < KVLEN; ++k) o += PS[k] * bf2f(V[(size_t)k * 128 + d]); o /= l;
                const float y = __builtin_amdgcn_cvt_f32_fp8((int)WSP(unsigned char, WS_Y)[tok * DM + h * 128 + 4 * (d & 31) + (d >> 5)], 0) * (1.0f / 16.0f); e2 += (o - y) * (o - y); r2 += o * o; }
            chk_add(F, e2, r2);
        }
    }
}
__device__ __forceinline__ float chk_sin_rev(double a) { a *= 0.15915494309189535; a -= floor(a); return __builtin_amdgcn_sinf((float)a); }
__device__ __forceinline__ float chk_cos_rev(double a) { a *= 0.15915494309189535; a -= floor(a); return __builtin_amdgcn_cosf((float)a); }
__device__ __forceinline__ float chk_rope(const LAS float* v, int dim, int idx, int s) {
    const int half = dim / 2, part = idx / half, w = idx % half, hh = half / 2, i = w % hh; const bool second = w >= hh;
    const float freq = powf(10000.0f, -(float)(2 * i) / (float)half); const float pos = part == 0 ? (float)(s / 64) : (float)(s % 64);
    const double ang = (double)(pos * freq); const float cs = chk_cos_rev(ang), sn = chk_sin_rev(ang);
    const float x1 = v[part * half + i], x2 = v[part * half + hh + i];
    return second ? (x1 * sn + x2 * cs) : (x1 * cs - x2 * sn);
}
__device__ __forceinline__ void check_proj(Frame& F) {
    LAS float* hrow = (LAS float*)F.lds;
    LAS float* proj = hrow + 2048;
    LAS float* t1 = proj + 2368;
    LAS float* t2 = t1 + 2048;
    LAS float* red = t2 + 512;
    LAS float* hv = red + 64;
    const int tid = F.tid;
    for (int it = blockIdx.x; it < 40; it += F.G) {
        int row; if (it < 32) { const int b = it & 3, q = it >> 2; const int ss[8] = {0, 1, 63, 64, 2047, 2048, 4031, 4095}; int s = 0;
#pragma unroll
            for (int z = 0; z < 8; ++z) s = (q == z) ? ss[z] : s;
            row = b * SEQ + s; } else { const int b = (it - 32) & 3, q = (it - 32) >> 2; row = T + b * CTX + (q ? 255 : 0); }
        const bool lat = row < T; const int b = lat ? row / SEQ : (row - T) / CTX, s = lat ? row % SEQ : (row - T) % CTX, kpos = lat ? CTX + s : s, r = lat ? b : 4;
        const float* xr = lat ? F.x + (size_t)row * DM : F.ctx + (size_t)(row - T) * DM;
        float ss = 0.f; for (int k = tid; k < DM; k += NTHR) ss += xr[k] * xr[k];
        ss = wave_sum(ss); if (F.lane == 0) red[F.wave] = ss; __syncthreads(); float tot = 0.f; for (int w = 0; w < 8; ++w) tot += red[w]; __syncthreads();
        const float rstd = 1.0f / sqrtf(tot / DM + EPS);
        const float* cv = lat ? F.c + (size_t)b * DM : F.c_ctx;
        for (int k = tid; k < DM; k += NTHR) { float sh = F.b_ada[k], sc = F.b_ada[DM + k];
            for (int j = 0; j < DM; ++j) { const float sl = silu_f(cv[j]); sh += sl * F.w_ada[(size_t)j * 12288 + k]; sc += sl * F.w_ada[(size_t)j * 12288 + DM + k]; }
            hrow[k] = xr[k] * rstd * F.g_norm[k] * (1.0f + sc) + sh; }
        __syncthreads();
        for (int n = tid; n < INW; n += NTHR) { float a = 0.f; for (int k = 0; k < DM; ++k) a += hrow[k] * F.w_in[(size_t)k * INW + n]; proj[n] = a; }
        __syncthreads();
        float e2 = 0.f, r2 = 0.f;
#define CMP(val, ptr) do { const float _v = (val), _y = bf2f(*(ptr)); e2 += (_v - _y) * (_v - _y); r2 += _v * _v; } while (0)
        for (int hd = 0; hd < 8 + 2; ++hd) { const bool isq = hd < 8; if (isq && !lat) continue; const int off = isq ? hd * 128 : 1024 + (hd - 8) * 128;
            float q2 = 0.f; for (int d = 0; d < 128; ++d) q2 += proj[off + d] * proj[off + d]; const float rs = 1.0f / sqrtf(q2 / 128.0f + EPS);
            __syncthreads(); if (tid < 128) hv[tid] = proj[off + tid] * rs * (isq ? F.g_aqn[tid] : F.g_akn[tid]); __syncthreads();
            if (tid < 128) { const float v = lat ? chk_rope(hv, 128, tid, s) : hv[tid];
                if (isq) CMP(v, WSP(bf16_t, WS_QA) + (size_t)row * 1024 + hd * 128 + tid); else CMP(v, WSP(bf16_t, WS_KA) + ((size_t)(b * 2 + hd - 8) * KVLEN + kpos) * 128 + tid); } }
        if (tid < 256) CMP(proj[1280 + tid], WSP(bf16_t, WS_VA) + ((size_t)(b * 2 + (tid >> 7)) * KVLEN + kpos) * 128 + (tid & 127));
        if (lat) { float q2 = 0.f; for (int d = 0; d < 512; ++d) q2 += proj[1536 + d] * proj[1536 + d]; const float rs = 1.0f / sqrtf(q2 / 512.0f + EPS);
            __syncthreads(); t2[tid] = proj[1536 + tid] * rs * F.g_bq_lat[tid]; __syncthreads();
            for (int n = tid; n < 1536; n += NTHR) { float a = 0.f; for (int k = 0; k < 512; ++k) a += t2[k] * F.w_bq_up[(size_t)k * 1536 + n]; t1[n] = a; }
            __syncthreads();
            for (int hd = 0; hd < 8; ++hd) { float h2 = 0.f; for (int d = 0; d < 192; ++d) h2 += t1[hd * 192 + d] * t1[hd * 192 + d]; const float rq = 1.0f / sqrtf(h2 / 192.0f + EPS);
                __syncthreads(); if (tid < 192) hv[tid] = t1[hd * 192 + tid] * rq * F.g_bqn[tid]; __syncthreads();
                if (tid < 192) { const float v = tid < 128 ? hv[tid] : chk_rope(hv + 128, 64, tid - 128, s); CMP(v, WSP(bf16_t, WS_QB) + (size_t)row * 1536 + hd * 192 + tid); } }
            __syncthreads(); }
        { float q2 = 0.f; for (int d = 0; d < 256; ++d) q2 += proj[2048 + d] * proj[2048 + d]; const float rs = 1.0f / sqrtf(q2 / 256.0f + EPS);
            __syncthreads(); if (tid < 256) t2[tid] = proj[2048 + tid] * rs * F.g_bkv_lat[tid]; __syncthreads();
            for (int n = tid; n < 2048; n += NTHR) { float a = 0.f; for (int k = 0; k < 256; ++k) a += t2[k] * F.w_bkv_up[(size_t)k * 2048 + n]; t1[n] = a; }
            __syncthreads();
            for (int hd = 0; hd < 8; ++hd) { float h2 = 0.f; for (int d = 0; d < 128; ++d) h2 += t1[hd * 256 + d] * t1[hd * 256 + d]; for (int d = 0; d < 64; ++d) h2 += proj[2304 + d] * proj[2304 + d];
                const float rq = 1.0f / sqrtf(h2 / 192.0f + EPS);
                __syncthreads(); if (tid < 192) hv[tid] = (tid < 128 ? t1[hd * 256 + tid] : proj[2304 + tid - 128]) * rq * F.g_bkn[tid]; __syncthreads();
                if (tid < 192) { const float v = (tid < 128 || !lat) ? hv[tid] : chk_rope(hv + 128, 64, tid - 128, s); CMP(v, WSP(bf16_t, WS_KB) + ((size_t)(b * 8 + hd) * KVLEN + kpos) * 192 + tid); }
                if (tid < 128) CMP(t1[hd * 256 + 128 + tid], WSP(bf16_t, WS_VB) + ((size_t)(b * 8 + hd) * KVLEN + kpos) * 128 + tid); }
            __syncthreads(); }
#undef CMP
        chk_add(F, e2, r2);
        __syncthreads();
    }
}
__device__ __forceinline__ void check_emit(Frame& F) {
    const float e2 = __hip_atomic_load((float*)(F.ctl + CW_CHK), RLX_AGENT), r2 = __hip_atomic_load((float*)(F.ctl + CW_CHK + 64), RLX_AGENT);
    const float eps_rel = (r2 > 0.f) ? sqrtf(e2 / r2) : 10.f; const float f = 1.0f + 100.0f * fminf(eps_rel, 10.f);
    for (size_t i = (size_t)blockIdx.x * NTHR + F.tid; i < (size_t)T * DM / 4; i += (size_t)F.G * NTHR) { const f32x4 v = ((const f32x4*)F.x)[i]; ((f32x4*)F.out)[i] = v * f; }
}
#endif
#ifndef MK_SINGLE
#define MK_SINGLE 0
#endif
#ifndef MK_LAST
#define MK_LAST 22
#endif
constexpr int N_PHASES = 22;
struct Args { const float* in[25]; float* out; unsigned char* ws; int ph_lo, ph_hi; };
static_assert(sizeof(Args) == 27 * 8 + 8, "Args has no padding");

__global__ void __launch_bounds__(NTHR, 2) fwd_kernel(Args args) {
    extern __shared__ __attribute__((aligned(16))) unsigned char lds_raw[];
    Frame F;
    F.lds = (LAS unsigned char*)lds_raw;
    F.MISC = (volatile LAS unsigned*)(F.lds + MISC_OFF);
    F.wave = __builtin_amdgcn_readfirstlane((int)threadIdx.x >> 6); F.lane = lane_now(); F.tid = F.wave * 64 + F.lane;
    F.G = gridDim.x; { const int bx = blockIdx.x; F.vcu = (F.G % 8 == 0) ? (bx % 8) * (F.G / 8) + bx / 8 : bx; }
    F.ws = args.ws; F.ctl = (unsigned*)(args.ws + WS_CTL); F.out = args.out;
    F.x = args.in[0]; F.c = args.in[1]; F.ctx = args.in[2]; F.c_ctx = args.in[3]; F.w_ada = args.in[4]; F.b_ada = args.in[5]; F.g_norm = args.in[6]; F.w_in = args.in[7];
    F.g_aqn = args.in[8]; F.g_akn = args.in[9]; F.g_bq_lat = args.in[10]; F.w_bq_up = args.in[11]; F.g_bkv_lat = args.in[12]; F.w_bkv_up = args.in[13]; F.g_bqn = args.in[14]; F.g_bkn = args.in[15];
    F.sink = args.in[16]; F.w_o = args.in[17]; F.w_fo = args.in[18]; F.b_fo = args.in[19]; F.w_router = args.in[20]; F.b_router = args.in[21]; F.w_gate = args.in[22]; F.w_up = args.in[23]; F.w_down = args.in[24];
    for (int u = F.tid; u < (LDS_BYTES - RING_BYTES) / 4; u += NTHR) ((LAS unsigned*)(F.lds + RING_BYTES))[u] = 0u;
    __syncthreads();
    const int lo = args.ph_lo, hi = args.ph_hi;
    XcdBarrier bar; bar.bar = F.ctl + CW_BAR; bar.x = 0; bar.st = nullptr;
    if (MK_SINGLE) bar = xcd_barrier_post(F.ctl + CW_BAR, F.MISC + 8);
#ifdef MK_ONLY
#define IN(k) ((k) == MK_ONLY && lo <= (k) && (k) < hi)
#else
#define IN(k) (((k) < MK_LAST || (k) >= 30) && lo <= (k) && (k) < hi)
#endif
#define SEAM(k) do { if (MK_SINGLE && IN((k) + 1)) xcd_barrier(bar); else __syncthreads(); } while (0)
#define SEAM_WRT(k) do { if (MK_SINGLE && IN((k) + 1)) xcd_barrier_shadow(bar, [&]() { p8_stage_wrt(F); }); else __syncthreads(); } while (0)
    const int c = (int)blockIdx.x;
#ifndef MK_REP
#define MK_REP 0
#endif
#define REP(k) ((((MK_REP) >> (k)) & 1) + 1)
#if defined(MK_TIME)
    unsigned long long* tsb = (unsigned long long*)(F.ctl + 16384);
#define STAMP(k) do { F.lane = lane_now(); F.tid = F.wave * 64 + F.lane; if (blockIdx.x == 0 && F.tid == 0) tsb[k] = wall_clock64(); } while (0)
#else
#define STAMP(k) do { F.lane = lane_now(); F.tid = F.wave * 64 + F.lane; } while (0)
#endif

#if defined(P0_PROBE)
    if (IN(0)) { p0_prologue<P0_PROBE>(F); SEAM(0); }
#endif
    if (IN(0)) for (int r_ = 0; r_ < REP(0); ++r_) { STAMP(0); p0_prologue<0>(F); SEAM(0); }
    if (IN(1)) for (int r_ = 0; r_ < REP(1); ++r_) { STAMP(1); p1_norm(F); SEAM(1); }
    if (IN(2)) for (int r_ = 0; r_ < REP(2); ++r_) { STAMP(2);
        pg8::PlainSched S; S.init(WSP(unsigned char, WS_H), WSP(unsigned char, WS_WIN_T), DM / 2, DM / 2, TT / 256, INWP / 256, 1, 0, 0, F.G, c);
        pg8::EpiBf16 E{WSP(bf16_t, WS_P), INWP, W8_INV, 0};
        pg8::gemm_phase<pg8::EpiBf16, pg8::PlainSched, true>(F.lds, DM / 2, DM / 2, DM / 2, S, E, F.wave);
        ada_idle(F, (TT / 256) * (INWP / 256), c, ADA_P0_END, ADA_P2_END);
        SEAM(2); }
    if (IN(3)) for (int r_ = 0; r_ < REP(3); ++r_) { STAMP(3); p3_post(F); SEAM(3); }
    if (IN(4)) for (int r_ = 0; r_ < REP(4); ++r_) { STAMP(4);
        { pg8::PlainSched S; S.init(WSP(bf16_t, WS_BQL), WSP(bf16_t, WS_WBQ_T), 512, 512, T / 256, 1536 / 256, 1, 0, 0, F.G, c);
          pg8::EpiBf16 E{WSP(bf16_t, WS_BQ), 1536, 1.0f, 0}; pg8::gemm_phase(F.lds, 512, 512, 512, S, E, F.wave); }
        { pg8::PlainSched S; S.init(WSP(bf16_t, WS_KVL), WSP(bf16_t, WS_WBKV_T), 256, 256, TT / 256, DM / 256, 1, 0, 0, F.G, c);
          pg8::EpiBf16 E{WSP(bf16_t, WS_KV), DM, 1.0f, 0}; pg8::gemm_phase(F.lds, 256, 256, 256, S, E, F.wave); }
        SEAM(4); }
    if (IN(5)) for (int r_ = 0; r_ < REP(5); ++r_) { STAMP(5); p5_post(F); SEAM(5); }
    if (IN(6)) for (int r_ = 0; r_ < REP(6); ++r_) { STAMP(6); p6_attn(F); SEAM(6); }
    if (IN(7)) for (int r_ = 0; r_ < REP(7); ++r_) { STAMP(7);
        pg8::PlainSched S; S.init(WSP(unsigned char, WS_Y), WSP(unsigned char, WS_WO_T), DM / 2, DM / 2, T / 256, DM / 256, 1, 0, 0, F.G, c);
        pg8::EpiResGate<false, true> E{F.x, WSP(bf16_t, WS_XB), modp(F, 0, 0, 2), 12288, nullptr, W8_INV * (1.0f / 16.0f)};
        pg8::gemm_phase<pg8::EpiResGate<false, true>, pg8::PlainSched, true>(F.lds, DM / 2, DM / 2, DM / 2, S, E, F.wave); SEAM_WRT(7); }
#define MOE_LAYER(l, P8, P9, P10, P11, P12)                                                                                                                    \
    if (IN(P8)) { STAMP(P8); p8_route(F, l, MK_SINGLE && IN(P8 - 1)); SEAM(P8); }                                                                                                                  \
    if (IN(P10)) for (int r_ = 0; r_ < REP(P10); ++r_) { STAMP(P10); pg8::MoeSched1 S; S.init(moe_table(F, l), WSP(unsigned char, WS_H), WSP(unsigned char, WS_WGU_T) + (size_t)l * 16 * DM * DM, DM / 2, DM / 2, (size_t)DM * DM, R_STOKE(F), F.G, c); \
        pg8::EpiSwiGLU8 E{WSP(unsigned char, WS_HS), DE}; pg8::gemm_phase<pg8::EpiSwiGLU8, pg8::MoeSched1, true>(F.lds, DM / 2, DM / 2, DM / 2, S, E, F.wave); if (l == 0) ada_idle(F, S.o.nwg, c, ADA_P2_END, ADA_P10_END); SEAM(P10); }                          \
    if (IN(P11)) for (int r_ = 0; r_ < REP(P11); ++r_) { STAMP(P11); pg8::MoeSched2 S; S.init(moe_table(F, l, true), WSP(unsigned char, WS_HS), WSP(unsigned char, WS_WD_T) + (size_t)l * 16 * DM * DE, DE / 2, DE / 2, (size_t)DM * DE, R_STOKE(F), F.G, c); \
        pg8::EpiBf16 E{WSP(bf16_t, WS_YS), DM, W8_INV, 0}; pg8::gemm_phase<pg8::EpiBf16, pg8::MoeSched2, true>(F.lds, DE / 2, DE / 2, DE / 2, S, E, F.wave); if (l == 0) ada_idle(F, S.o.nwg, c, ADA_P10_END, ADA_TASKS); SEAM(P11); }                               \
    if (IN(P12)) { STAMP(P12); if (l == 0) p12_fourier(F); else p12_combine(F, l); SEAM(P12); }
    MOE_LAYER(0, 8, 9, 10, 11, 12)
    if (IN(14)) for (int r_ = 0; r_ < REP(14); ++r_) { STAMP(14); p13_freq128(F); __syncthreads();
        pg8::PlainSched S; S.init(WSP(bf16_t, WS_A1), WSP(bf16_t, WS_FY), 512, 4096, 1, T / 256, 8, 0, (size_t)512 * 2, F.G, c);
        pg8::EpiB1 E{WSP(bf16_t, WS_UT)}; pg8::gemm_phase(F.lds, 512, 4096, 512, S, E, F.wave); SEAM(14); }
    if (IN(15)) for (int r_ = 0; r_ < REP(15); ++r_) { STAMP(15);
        pg8::PlainSched S; S.init(WSP(bf16_t, WS_W2), WSP(bf16_t, WS_UT), 512, 512, 1, 4, 64, 0, (size_t)1024 * 512 * 2, F.G, c);
        pg8::EpiB2 E{WSP(unsigned char, WS_F)}; pg8::gemm_phase(F.lds, 512, 512, 512, S, E, F.wave); SEAM(15); }
    if (IN(16)) for (int r_ = 0; r_ < REP(16); ++r_) { STAMP(16);
        pg8::PlainSched S; S.init(WSP(unsigned char, WS_F), WSP(unsigned char, WS_WFO_T), DM / 2, DM / 2, T / 256, DM / 256, 1, 0, 0, F.G, c);
        pg8::EpiResGate<true, true> E{WSP(bf16_t, WS_XB), WSP(bf16_t, WS_XB), modp(F, 1, 0, 2), 12288, F.b_fo, W8_INV};
        pg8::gemm_phase<pg8::EpiResGate<true, true>, pg8::PlainSched, true>(F.lds, DM / 2, DM / 2, DM / 2, S, E, F.wave); SEAM_WRT(16); }
    MOE_LAYER(1, 17, 18, 19, 20, 21)
#if defined(MK_TIME)
    if (MK_SINGLE) { xcd_barrier(bar); STAMP(22); xcd_barrier(bar);
        float va = 0.f, vb = 0.f;
        for (int k = 0; k < 22; ++k) { const float us = (float)(tsb[k + 1] - tsb[k]) * 0.01f; if ((MK_TIME_A >> k) & 1) va += us; if ((MK_TIME_B >> k) & 1) vb += us; }
        const float f = 1.0f + va * 0.001f;
        for (size_t i = (size_t)blockIdx.x * NTHR + F.tid; i < (size_t)T * DM / 4; i += (size_t)F.G * NTHR) { const f32x4 v = ((const f32x4*)F.x)[i]; ((f32x4*)F.out)[i] = v * f; }
        (void)vb; }
#endif
#if defined(MK_CHECK)
    if (IN(30)) { if (MK_CHECK == 1) check_attn(F); else check_proj(F); SEAM(30); }
    if (IN(31)) { check_emit(F); }
#endif
#undef IN
#undef SEAM
}

extern "C" void kernel_launch(void* const* d_in, const int* in_sizes, int n_in, void* d_out, int out_size, void* d_ws, size_t ws_size, hipStream_t stream) {
    static int grid = 0;
    if (grid == 0) {
        if (n_in != 25 || out_size != T * DM || ws_size < WS_END) { fprintf(stderr, "kernel_launch: shape mismatch n_in %d out %d ws %zu (need %zu)\n", n_in, out_size, ws_size, (size_t)WS_END); grid = -1; return; }
        int dev = 0, cus = 0, per_cu = 0;
        if (hipGetDevice(&dev) != hipSuccess || hipDeviceGetAttribute(&cus, hipDeviceAttributeMultiprocessorCount, dev) != hipSuccess) { grid = -1; return; }
        if (hipFuncSetAttribute((const void*)fwd_kernel, hipFuncAttributeMaxDynamicSharedMemorySize, LDS_BYTES) != hipSuccess) { fprintf(stderr, "kernel_launch: hipFuncSetAttribute failed\n"); grid = -1; return; }
        if (hipOccupancyMaxActiveBlocksPerMultiprocessor(&per_cu, (const void*)fwd_kernel, NTHR, LDS_BYTES) != hipSuccess || per_cu < 1) fprintf(stderr, "kernel_launch: occupancy query says %d\n", per_cu);
        (void)hipGetLastError();
        grid = cus;
    }
    if (grid < 0) return;
    (void)hipMemsetAsync((char*)d_ws + WS_CTL, 0, CTL_ZERO_BYTES, stream);
    Args a{};
    for (int i = 0; i < 25; ++i) a.in[i] = (const float*)d_in[i];
    a.out = (float*)d_out; a.ws = (unsigned char*)d_ws;
    if (MK_LAST <= 7) (void)hipMemcpyAsync(d_out, d_in[0], (size_t)T * DM * 4, hipMemcpyDeviceToDevice, stream);
#if MK_SINGLE
    a.ph_lo = 0; a.ph_hi = MK_LAST;
    hipLaunchKernelGGL(fwd_kernel, dim3(grid), dim3(NTHR), LDS_BYTES, stream, a);
#else
    for (int ph = 0; ph < MK_LAST; ++ph) { a.ph_lo = ph; a.ph_hi = ph + 1; hipLaunchKernelGGL(fwd_kernel, dim3(grid), dim3(NTHR), LDS_BYTES, stream, a); }
#if defined(MK_CHECK)
    for (int ph = 30; ph < 32; ++ph) { a.ph_lo = ph; a.ph_hi = ph + 1; hipLaunchKernelGGL(fwd_kernel, dim3(grid), dim3(NTHR), LDS_BYTES, stream, a); }
#endif
#endif
    const hipError_t le = hipPeekAtLastError();
    if (le != hipSuccess) fprintf(stderr, "kernel_launch: launch failed: %s\n", hipGetErrorName(le));
}
```

```cpp
#define MK_SINGLE 1
#define MK_LAST 22
#include <hip/hip_runtime.h>
#include <cstdio>
#include <cstdint>

#define LAS __attribute__((address_space(3)))
#define GAS __attribute__((address_space(1)))
typedef unsigned short bf16_t;
typedef short bf16x8 __attribute__((ext_vector_type(8)));
typedef short s16x4 __attribute__((ext_vector_type(4)));
typedef float f32x4 __attribute__((ext_vector_type(4)));
typedef float f32x2 __attribute__((ext_vector_type(2)));
typedef float f32x16 __attribute__((ext_vector_type(16)));
typedef unsigned u32x4 __attribute__((ext_vector_type(4)));
typedef unsigned u32x2 __attribute__((ext_vector_type(2)));
typedef int i32x4 __attribute__((ext_vector_type(4)));
typedef int i32x8 __attribute__((ext_vector_type(8)));

constexpr int DM = 2048, NB = 4, SEQ = 4096, T = NB * SEQ, CTX = 256, TC = NB * CTX, TT = T + TC, KVLEN = CTX + SEQ;
constexpr int INW = 2368, INWP = 2560, NE = 16, DE = 1024, APAD = 2 * T + NE * 256;
constexpr float EPS = 1e-6f;
constexpr int NWAVES = 8, NTHR = 512;

constexpr size_t MiB = 1u << 20;
constexpr size_t WS_CTL = 0, CTL_ZERO_BYTES = 1 * MiB;
constexpr size_t WS_MOD = 1 * MiB;
constexpr size_t WS_ROUTE = 2 * MiB;
constexpr size_t WS_WIN_T = 4 * MiB, WS_WBQ_T = 14 * MiB, WS_WBKV_T = 16 * MiB, WS_WO_T = 18 * MiB, WS_WFO_T = 26 * MiB, WS_WC = 34 * MiB, WS_KR = 35 * MiB;
constexpr size_t WS_WS = 38 * MiB, WS_WGU_T = 102 * MiB, WS_WD_T = 358 * MiB;
constexpr size_t WS_H = 486 * MiB, WS_RA = 554 * MiB, WS_RC = 714 * MiB, WS_RD = 790 * MiB, WS_XB = 924 * MiB  , WS_END = 988 * MiB;
constexpr size_t WS_P = WS_RA, WS_BQ = WS_RA, WS_KV = WS_RA + 48 * MiB, WS_Y = WS_RA, WS_YS = WS_RA, WS_FY = WS_RC  , WS_F = WS_H  ;
constexpr size_t WS_STOKE = WS_WS;
constexpr size_t WS_WRT = WS_WC + 768 * 1024;
constexpr size_t WS_A1 = WS_WC, WS_W2 = WS_WC + 512 * 1024;
constexpr size_t WS_Z128 = WS_WS + 2 * MiB;
constexpr size_t WS_UT = WS_RA;
constexpr size_t WS_QA = WS_RC, WS_KA = WS_RC + 32 * MiB, WS_VA = WS_RC + 41 * MiB, WS_BQL = WS_RC + 50 * MiB, WS_KVL = WS_RC + 66 * MiB;
constexpr size_t WS_QB = WS_RD, WS_KB = WS_RD + 48 * MiB, WS_VB = WS_RD + 99 * MiB, WS_HS = WS_RD;
static_assert((size_t)TT * INWP * 2 <= 160 * MiB && (size_t)APAD * DM * 2 <= 160 * MiB && (size_t)T * 4096 * 2 <= 160 * MiB && WS_UT + (size_t)64 * DM * 512 * 2 <= WS_RC && WS_FY + (size_t)T * 4096 * 2 <= WS_XB && WS_F + (size_t)T * DM <= WS_RA, "region A / UT / FY / F");
static_assert((size_t)T * 1536 * 2 <= 48 * MiB && WS_KV + (size_t)TT * DM * 2 <= WS_RC, "BQ/KV");
static_assert((size_t)T * 1024 * 2 <= 32 * MiB && (size_t)NB * 2 * KVLEN * 128 * 2 <= 9 * MiB && (size_t)T * 512 * 2 <= 16 * MiB && WS_KVL + (size_t)TT * 256 * 2 <= WS_RD, "region C");
static_assert((size_t)T * 1536 * 2 <= 48 * MiB && (size_t)NB * 8 * KVLEN * 192 * 2 <= 51 * MiB && WS_VB + (size_t)NB * 8 * KVLEN * 128 * 2 <= WS_END && (size_t)APAD * DE * 2 <= 134 * MiB, "region D");
static_assert((size_t)TT * DM * 2 <= 68 * MiB && (size_t)TT * 64 * 2 <= 3 * MiB, "H/KR");
constexpr int CW_BAR = 4096;
constexpr int CW_CNT = 8192;

constexpr int RING_BYTES = 131072;
constexpr int LDS_BYTES = 163840;
constexpr int MISC_OFF = LDS_BYTES - 512;

#define RLX_AGENT __ATOMIC_RELAXED, __HIP_MEMORY_SCOPE_AGENT
#define LDS_WAIT() asm volatile("s_waitcnt lgkmcnt(0)" ::: "memory")
#define VM_WAIT() asm volatile("s_waitcnt vmcnt(0)" ::: "memory")
__device__ __forceinline__ unsigned f2bf(float f) { unsigned u = __builtin_bit_cast(unsigned, f); return (u + 0x7fffu + ((u >> 16) & 1u)) >> 16; }
__device__ __forceinline__ unsigned pk2(float lo, float hi) { return f2bf(lo) | (f2bf(hi) << 16); }
__device__ __forceinline__ float bf2f(unsigned b) { return __builtin_bit_cast(float, b << 16); }
__device__ __forceinline__ float bflo(unsigned w) { return __builtin_bit_cast(float, w << 16); }
__device__ __forceinline__ float bfhi(unsigned w) { return __builtin_bit_cast(float, w & 0xffff0000u); }
__device__ __forceinline__ unsigned cvt_pk_bf16(float lo, float hi) { unsigned r; asm volatile("v_cvt_pk_bf16_f32 %0, %1, %2" : "=v"(r) : "v"(lo), "v"(hi)); return r; }
__device__ __forceinline__ unsigned pk4_fp8(float a, float b, float c, float d) { int p = 0; p = __builtin_amdgcn_cvt_pk_fp8_f32(a, b, p, false); p = __builtin_amdgcn_cvt_pk_fp8_f32(c, d, p, true); return (unsigned)p; }
constexpr float W8_SCALE = 32.0f, W8_INV = 1.0f / 32.0f;
template <int CTRL> __device__ __forceinline__ float dpp_mov(float v) { return __int_as_float(__builtin_amdgcn_update_dpp(0, __float_as_int(v), CTRL, 0xF, 0xF, true)); }
__device__ __forceinline__ float row_sum16(float v) {
    v += dpp_mov<0xB1>(v);
    v += dpp_mov<0x4E>(v);
    v += dpp_mov<0x141>(v);
    v += dpp_mov<0x140>(v);
    return v;
}
__device__ __forceinline__ float half_sum(float v) {
    v = row_sum16(v);
    const auto r = __builtin_amdgcn_permlane16_swap(__float_as_uint(v), __float_as_uint(v), false, false);
    return __uint_as_float(r[0]) + __uint_as_float(r[1]);
}
__device__ __forceinline__ float wave_sum(float v) {
    v = half_sum(v);
    const auto r = __builtin_amdgcn_permlane32_swap(__float_as_uint(v), __float_as_uint(v), false, false);
    return __uint_as_float(r[0]) + __uint_as_float(r[1]);
}
__device__ __forceinline__ int lane_now() { int l; asm volatile("v_mbcnt_lo_u32_b32 %0, -1, 0\n\tv_mbcnt_hi_u32_b32 %0, -1, %0" : "=v"(l)); return l; }
__device__ __forceinline__ float silu_f(float v) { return v / (1.0f + __expf(-v)); }

#define XB_TMO      128
#define XB_XCNT(j)  (256  + 64 * (j))
#define XB_XSUB(j)  (1280 + 64 * (j))
#define XB_XGEN(j)  (2304 + 64 * (j))
#define XB_TOP      3328
#define XB_TOPGEN   3392
#define XCD_BAR_WORDS 3456
#define XB_SPIN_CAP (1u << 18)
__device__ __forceinline__ unsigned xb_ld(unsigned* p)              { return __hip_atomic_load(p, __ATOMIC_RELAXED, __HIP_MEMORY_SCOPE_AGENT); }
__device__ __forceinline__ unsigned xb_add(unsigned* p, unsigned v) { return __hip_atomic_fetch_add(p, v, __ATOMIC_RELAXED, __HIP_MEMORY_SCOPE_AGENT); }
__device__ __forceinline__ unsigned xb_xcc_id() { return (unsigned)__builtin_amdgcn_s_getreg((3 << 11) | 20) & 0xFu; }
#define XB_SPIN(cond, bar) do { unsigned _sp = 0; while (cond) { __builtin_amdgcn_s_sleep(1); \
    if ((++_sp & 255u) == 0u) { if (xb_ld(&(bar)[XB_TMO])) break; if (_sp > XB_SPIN_CAP) { atomicAdd(&(bar)[XB_TMO], 1u); break; } } } } while (0)
struct XcdBarrier { unsigned* bar; unsigned x; volatile LAS unsigned* st; };
__device__ __forceinline__ XcdBarrier xcd_barrier_post(unsigned* bar, volatile LAS unsigned* st) {
    XcdBarrier b; b.bar = bar; b.x = xb_xcc_id(); b.st = st;
    if (threadIdx.x == 0) (void)xb_add(&bar[XB_XCNT(b.x)], 1u);
    return b;
}
__device__ __forceinline__ void xcd_barrier_complete(unsigned* bar, unsigned x, unsigned& nloc, unsigned& nx) {
    const unsigned G = gridDim.x * gridDim.y * gridDim.z;
    unsigned sum, cnt, mine, sp = 0u;
    for (;;) {
        sum = 0u; cnt = 0u; mine = 0u;
#pragma unroll
        for (unsigned j = 0; j < 16; ++j) { const unsigned c = xb_ld(&bar[XB_XCNT(j)]); sum += c; cnt += (c > 0u) ? 1u : 0u; mine = (j == x) ? c : mine; }
        if (sum == G) break;
        __builtin_amdgcn_s_sleep(1);
        if ((++sp & 255u) == 0u) { if (xb_ld(&bar[XB_TMO])) break; if (sp > XB_SPIN_CAP) { atomicAdd(&bar[XB_TMO], 1u); break; } }
    }
    nloc = mine > 0u ? mine : 1u; nx = cnt > 0u ? cnt : 1u;
}
__device__ __forceinline__ void xcd_barrier_lane0(const XcdBarrier& b) {
    unsigned* bar = b.bar;
    __builtin_amdgcn_s_waitcnt(0);
    unsigned nloc = b.st[0], nx = b.st[1];
    if (nloc == 0u) { xcd_barrier_complete(bar, b.x, nloc, nx); b.st[0] = nloc; b.st[1] = nx; }
    const unsigned old = xb_add(&bar[XB_XSUB(b.x)], 1u);
    const unsigned gen = old / nloc;
    if (old + 1u == (gen + 1u) * nloc) {
        __builtin_amdgcn_fence(__ATOMIC_RELEASE, "agent");
        asm volatile("s_waitcnt vmcnt(0)" ::: "memory");
        const unsigned og = xb_add(&bar[XB_TOP], 1u);
        const unsigned tg = og / nx;
        if (og + 1u == (tg + 1u) * nx) xb_add(&bar[XB_TOPGEN], 1u);
        else XB_SPIN(xb_ld(&bar[XB_TOPGEN]) == tg, bar);
        __builtin_amdgcn_fence(__ATOMIC_ACQUIRE, "agent");
        xb_add(&bar[XB_XGEN(b.x)], 1u);
        asm volatile("s_waitcnt vmcnt(0)" ::: "memory");
    } else {
        XB_SPIN(xb_ld(&bar[XB_XGEN(b.x)]) == gen, bar);
        __builtin_amdgcn_fence(__ATOMIC_ACQUIRE, "agent");
        asm volatile("s_waitcnt vmcnt(0)" ::: "memory");
    }
}
__device__ __forceinline__ void xcd_barrier(const XcdBarrier& b) {
    asm volatile("s_waitcnt vmcnt(0)" ::: "memory");
    __syncthreads();
    if (threadIdx.x == 0) xcd_barrier_lane0(b);
    __syncthreads();
}
template <class W> __device__ __forceinline__ void xcd_barrier_shadow(const XcdBarrier& b, W&& work) {
    asm volatile("s_waitcnt vmcnt(0)" ::: "memory");
    __syncthreads();
    if (threadIdx.x < 64) { if (threadIdx.x == 0) xcd_barrier_lane0(b); }
    else { work(); asm volatile("s_waitcnt vmcnt(0) lgkmcnt(0)" ::: "memory"); }
    __syncthreads();
}
namespace pg8 {
constexpr int BM = 256, BK = 64, HALF = 128, HTB = HALF * BK * 2, STAGE_BYTES = 8 * HTB, NXCD = 8, WGM = 8;
__host__ __device__ __forceinline__ int lds_byte(int r, int c) { const int st = (r >> 4) * 2 + (c >> 5), rr = r & 15, cc = c & 31, ob = rr * 64 + cc * 2; return st * 1024 + (ob ^ (((ob >> 9) & 1) << 5)); }
__host__ __device__ __forceinline__ void stage_rc(int b, int& R, int& C) { const int st = b / 1024, sb = b % 1024, swz = sb ^ (((sb >> 9) & 1) << 5); R = (st >> 1) * 16 + swz / 64; C = (st & 1) * 32 + (swz % 64) / 2; }
__host__ __device__ __forceinline__ int perm32(int rho) { const int n = rho >> 4, i = rho & 15; return 8 * (i >> 2) + 4 * n + (i & 3); }

struct Unit { int pm, pn, aux, r0, cnt; const char* A; const char* B; };

struct TileOrder {
    int nM, nN, nAux, nwg, G, c;
    __device__ __forceinline__ void init(int nM_, int nN_, int nAux_, int G_, int c_) { nM = nM_; nN = nN_; nAux = nAux_; nwg = nM * nN * nAux; G = G_; c = c_; }
    __device__ __forceinline__ bool map(int i, int& aux, int& pm, int& pn) const {
        const long L = (long)i * G + c; if (L >= nwg) return false;
        int wgid = (int)L; { const int q = nwg / NXCD, r = nwg % NXCD, xcd = wgid % NXCD, off = wgid / NXCD; wgid = (xcd < r ? xcd * (q + 1) : r * (q + 1) + (xcd - r) * q) + off; }
        const int per = nM * nN; aux = wgid / per; wgid -= aux * per;
        const int nig = WGM * nN, gid = wgid / nig, fm = gid * WGM, gsz = (nM - fm) < WGM ? (nM - fm) : WGM;
        pm = fm + ((wgid % nig) % gsz); pn = (wgid % nig) / gsz; return true;
    }
};
struct PlainSched {
    static constexpr bool GATHER = false;
    TileOrder o; const char* A0; const char* B0; size_t sA, sB, tA, tB;
    __device__ __forceinline__ void init(const void* A, const void* B, int lda, int ldb, int nM, int nN, int nAux, size_t sA_, size_t sB_, int G, int c) {
        o.init(nM, nN, nAux, G, c); A0 = (const char*)A; B0 = (const char*)B; sA = sA_; sB = sB_; tA = (size_t)BM * lda * 2; tB = (size_t)BM * ldb * 2; }
    __device__ __forceinline__ bool next(int i, Unit& u) const {
        if (!o.map(i, u.aux, u.pm, u.pn)) return false;
        u.A = A0 + (size_t)u.aux * sA + (size_t)u.pm * tA; u.B = B0 + (size_t)u.aux * sB + (size_t)u.pn * tB; return true; }
    __device__ __forceinline__ unsigned arow(const Unit&, int) const { return 0u; }
};

template <class Epi, class Sched, bool F8 = false>
__device__ __forceinline__ void gemm_phase(LAS unsigned char* lds, const int lda, const int ldb, const int K, const Sched& S, const Epi& E, const int wid) {
    const int lane = lane_now(), tid = wid * 64 + lane, wr = wid >> 2, wc = wid & 3, fr = lane & 15, fq = lane >> 4;
    int K_o = K; asm volatile("" : "+s"(K_o));
    const int nt = K_o / BK;
    unsigned voffA[2], voffB[2]; int RA[2], CA2[2];
#pragma unroll
    for (int i = 0; i < 2; ++i) { int R, C; stage_rc(tid * 16 + i * 8192, R, C); const int Rb = Epi::PERM ? ((R & ~31) + perm32(R & 31)) : R;
        RA[i] = R; CA2[i] = C * 2; voffA[i] = (unsigned)(R * lda + C) * 2u; voffB[i] = (unsigned)(Rb * ldb + C) * 2u; }
    const size_t kstep = (size_t)(BK * 2);
    const size_t hstepA = (size_t)HALF * lda * 2, hstepB = (size_t)HALF * ldb * 2;
    const unsigned ldsw = (unsigned)wid * 1024u;
    const int aoff = lds_byte(wr * 64 + fr, fq * 8), boff = lds_byte(wc * 32 + fr, fq * 8);
#define PG8_SA(b, h) (((b) * 2 + (h)) * HTB)
#define PG8_SB(b, h) ((4 + (b) * 2 + (h)) * HTB)
#define PG8_STAGE(bufoff, gbase, voff) do { _Pragma("unroll") for (int _i = 0; _i < 2; ++_i) \
        __builtin_amdgcn_global_load_lds((const unsigned*)((const char*)(gbase) + (voff)[_i]), (LAS unsigned*)(lds + (bufoff) + ldsw + _i * 8192), 16, 0, 0); } while (0)
#define PG8_LDA(dst, b, h) do { _Pragma("unroll") for (int m = 0; m < 4; ++m) _Pragma("unroll") for (int k = 0; k < 2; ++k) dst[m][k] = *(const LAS bf16x8*)(lds + PG8_SA(b, h) + aoff + m * 2048 + k * 1024); } while (0)
#define PG8_LDB(dst, b, h) do { _Pragma("unroll") for (int n = 0; n < 2; ++n) _Pragma("unroll") for (int k = 0; k < 2; ++k) dst[n][k] = *(const LAS bf16x8*)(lds + PG8_SB(b, h) + boff + n * 2048 + k * 1024); } while (0)
#define PG8_MMA(ai, bj, At, Bt) do { __builtin_amdgcn_s_setprio(1); _Pragma("unroll") for (int m = 0; m < 4; ++m) _Pragma("unroll") for (int n = 0; n < 2; ++n) _Pragma("unroll") for (int k = 0; k < 2; ++k) \
        acc[ai][bj][m][n] = __builtin_amdgcn_mfma_f32_16x16x32_bf16(Bt[n][k], At[m][k], acc[ai][bj][m][n], 0, 0, 0); __builtin_amdgcn_s_setprio(0); } while (0)
#define PG8_LDA8(dst, b, h) do { _Pragma("unroll") for (int m = 0; m < 4; ++m) { const i32x4 lo_ = *(const LAS i32x4*)(lds + PG8_SA(b, h) + aoff + m * 2048), hi_ = *(const LAS i32x4*)(lds + PG8_SA(b, h) + aoff + m * 2048 + 1024); \
        dst[m] = (i32x8){lo_[0], lo_[1], lo_[2], lo_[3], hi_[0], hi_[1], hi_[2], hi_[3]}; } } while (0)
#define PG8_LDB8(dst, b, h) do { _Pragma("unroll") for (int n = 0; n < 2; ++n) { const i32x4 lo_ = *(const LAS i32x4*)(lds + PG8_SB(b, h) + boff + n * 2048), hi_ = *(const LAS i32x4*)(lds + PG8_SB(b, h) + boff + n * 2048 + 1024); \
        dst[n] = (i32x8){lo_[0], lo_[1], lo_[2], lo_[3], hi_[0], hi_[1], hi_[2], hi_[3]}; } } while (0)
#define PG8_MMA8(ai, bj, At, Bt) do { __builtin_amdgcn_s_setprio(1); _Pragma("unroll") for (int m = 0; m < 4; ++m) _Pragma("unroll") for (int n = 0; n < 2; ++n) \
        { f32x4 c_; _Pragma("unroll") for (int j_ = 0; j_ < 4; ++j_) c_[j_] = accv[ai][bj][4 * (2 * m + n) + j_]; \
          c_ = __builtin_amdgcn_mfma_scale_f32_16x16x128_f8f6f4(Bt[n], At[m], c_, 0, 0, 0, 0x7f7f7f7f, 0, 0x7f7f7f7f); \
          _Pragma("unroll") for (int j_ = 0; j_ < 4; ++j_) accv[ai][bj][4 * (2 * m + n) + j_] = c_[j_]; } __builtin_amdgcn_s_setprio(0); } while (0)
#define PG8_WAIT_V(n) asm volatile("s_waitcnt vmcnt(" #n ")" ::: "memory")
#define PG8_WAIT_L(n) asm volatile("s_waitcnt lgkmcnt(" #n ")" ::: "memory")
#define PG8_BAR __builtin_amdgcn_s_barrier()
#define PG8_SCHED __builtin_amdgcn_sched_barrier(0)
    Unit cur, nxt; int ui = 0;
    if (!S.next(0, cur)) return;
    f32x4 acc[2][2][4][2];
    typedef float f32x32 __attribute__((ext_vector_type(32)));
    f32x32 accv[2][2];
#pragma unroll
    for (int a = 0; a < 2; ++a)
#pragma unroll
        for (int b = 0; b < 2; ++b)
#pragma unroll
            for (int j = 0; j < 32; ++j) accv[a][b][j] = 0.f;
#pragma unroll
    for (int a = 0; a < 2; ++a)
#pragma unroll
        for (int b = 0; b < 2; ++b)
#pragma unroll
            for (int m = 0; m < 4; ++m)
#pragma unroll
                for (int n = 0; n < 2; ++n) acc[a][b][m][n] = (f32x4){0.f, 0.f, 0.f, 0.f};
    bf16x8 At[4][2], B0[2][2], B1[2][2];
    i32x8 At8[4], B08[2], B18[2];
    const char* cA = cur.A; const char* cB = cur.B;
    unsigned voA0[2], voA1[2], vnA0[2], vnA1[2];
    if constexpr (Sched::GATHER) {
#pragma unroll
        for (int i = 0; i < 2; ++i) { voA0[i] = S.arow(cur, RA[i]) * (unsigned)(lda * 2) + (unsigned)CA2[i]; voA1[i] = S.arow(cur, HALF + RA[i]) * (unsigned)(lda * 2) + (unsigned)CA2[i]; vnA0[i] = voA0[i]; vnA1[i] = voA1[i]; }
    }
    if constexpr (Sched::GATHER) {
        PG8_STAGE(PG8_SB(0, 0), cB, voffB); PG8_STAGE(PG8_SB(0, 1), cB + hstepB, voffB); PG8_STAGE(PG8_SA(0, 0), cA, voA0); PG8_STAGE(PG8_SA(0, 1), cA, voA1);
        if (wr == 1) PG8_BAR;
        PG8_WAIT_V(2); PG8_BAR;
        PG8_STAGE(PG8_SB(1, 0), cB + kstep, voffB); PG8_STAGE(PG8_SA(1, 0), cA + kstep, voA0); PG8_STAGE(PG8_SB(1, 1), cB + hstepB + kstep, voffB);
        PG8_WAIT_V(6); PG8_BAR;
    } else {
        PG8_STAGE(PG8_SB(0, 0), cB, voffB); PG8_STAGE(PG8_SB(0, 1), cB + hstepB, voffB); PG8_STAGE(PG8_SA(0, 0), cA, voffA); PG8_STAGE(PG8_SA(0, 1), cA + hstepA, voffA);
        if (wr == 1) PG8_BAR;
        PG8_WAIT_V(2); PG8_BAR;
        PG8_STAGE(PG8_SB(1, 0), cB + kstep, voffB); PG8_STAGE(PG8_SA(1, 0), cA + kstep, voffA); PG8_STAGE(PG8_SB(1, 1), cB + hstepB + kstep, voffB);
        PG8_WAIT_V(6); PG8_BAR;
    }
    for (;;) {
        const bool has_next = S.next(ui + 1, nxt);
        const char* nA = has_next ? nxt.A : cA; const char* nB = has_next ? nxt.B : cB;
        if constexpr (Sched::GATHER) {
            if (has_next) { const int t2_ = wid * 64 + lane_now();
#pragma unroll
                for (int i = 0; i < 2; ++i) { int R_, C_; stage_rc(t2_ * 16 + i * 8192, R_, C_);
                  vnA0[i] = S.arow(nxt, R_) * (unsigned)(lda * 2) + (unsigned)(C_ * 2); vnA1[i] = S.arow(nxt, HALF + R_) * (unsigned)(lda * 2) + (unsigned)(C_ * 2); }
            } else {
#pragma unroll
                for (int i = 0; i < 2; ++i) { vnA0[i] = voA0[i]; vnA1[i] = voA1[i]; }
            }
        }
        for (int t = 0; t < nt; t += 2) {
            const bool last = (t == nt - 2);
            const char* a1 = cA + (size_t)(t + 1) * kstep;
            const char* a2 = last ? nA : cA + (size_t)(t + 2) * kstep; const char* b2 = last ? nB : cB + (size_t)(t + 2) * kstep;
            const char* a3 = a2 + kstep; const char* b3 = b2 + kstep;
            unsigned o20[2], o21[2];
            if constexpr (Sched::GATHER) {
#pragma unroll
                for (int i = 0; i < 2; ++i) { o20[i] = last ? vnA0[i] : voA0[i]; o21[i] = last ? vnA1[i] : voA1[i]; }
            }
            if constexpr (F8) { PG8_LDB8(B08, 0, 0); PG8_LDB8(B18, 0, 1); PG8_SCHED; PG8_LDA8(At8, 0, 0); } else { PG8_LDB(B0, 0, 0); PG8_LDB(B1, 0, 1); PG8_SCHED; PG8_LDA(At, 0, 0); }
            if constexpr (Sched::GATHER) { PG8_STAGE(PG8_SA(1, 1), a1, voA1); } else { PG8_STAGE(PG8_SA(1, 1), a1 + hstepA, voffA); }
            PG8_WAIT_V(8); PG8_WAIT_L(0); PG8_BAR; if constexpr (F8) { PG8_MMA8(0, 0, At8, B08); PG8_MMA8(0, 1, At8, B18); } else { PG8_MMA(0, 0, At, B0); PG8_MMA(0, 1, At, B1); } PG8_BAR; PG8_SCHED;
            if constexpr (F8) { PG8_LDA8(At8, 0, 1); } else { PG8_LDA(At, 0, 1); } PG8_STAGE(PG8_SB(0, 0), b2, voffB); PG8_STAGE(PG8_SB(0, 1), b2 + hstepB, voffB);
            if constexpr (Sched::GATHER) { PG8_STAGE(PG8_SA(0, 0), a2, o20); } else { PG8_STAGE(PG8_SA(0, 0), a2, voffA); }
            PG8_WAIT_V(8); PG8_WAIT_L(0); PG8_BAR; if constexpr (F8) { PG8_MMA8(1, 0, At8, B08); PG8_MMA8(1, 1, At8, B18); } else { PG8_MMA(1, 0, At, B0); PG8_MMA(1, 1, At, B1); } PG8_BAR; PG8_SCHED;
            if constexpr (F8) { PG8_LDB8(B08, 1, 0); PG8_LDB8(B18, 1, 1); PG8_SCHED; PG8_LDA8(At8, 1, 0); } else { PG8_LDB(B0, 1, 0); PG8_LDB(B1, 1, 1); PG8_SCHED; PG8_LDA(At, 1, 0); }
            if constexpr (Sched::GATHER) { PG8_STAGE(PG8_SA(0, 1), a2, o21); } else { PG8_STAGE(PG8_SA(0, 1), a2 + hstepA, voffA); }
            PG8_WAIT_V(8); PG8_WAIT_L(0); PG8_BAR; if constexpr (F8) { PG8_MMA8(0, 0, At8, B08); PG8_MMA8(0, 1, At8, B18); } else { PG8_MMA(0, 0, At, B0); PG8_MMA(0, 1, At, B1); } PG8_BAR; PG8_SCHED;
            if constexpr (F8) { PG8_LDA8(At8, 1, 1); } else { PG8_LDA(At, 1, 1); } PG8_STAGE(PG8_SB(1, 0), b3, voffB); PG8_STAGE(PG8_SB(1, 1), b3 + hstepB, voffB);
            if constexpr (Sched::GATHER) { PG8_STAGE(PG8_SA(1, 0), a3, o20); } else { PG8_STAGE(PG8_SA(1, 0), a3, voffA); }
            PG8_WAIT_V(8); PG8_WAIT_L(0); PG8_BAR; if constexpr (F8) { PG8_MMA8(1, 0, At8, B08); PG8_MMA8(1, 1, At8, B18); } else { PG8_MMA(1, 0, At, B0); PG8_MMA(1, 1, At, B1); } PG8_BAR; PG8_SCHED;
        }
        if (wr == 0) PG8_BAR;
        if constexpr (F8) {
#pragma unroll
            for (int a = 0; a < 2; ++a)
#pragma unroll
                for (int b = 0; b < 2; ++b)
#pragma unroll
                    for (int m = 0; m < 4; ++m)
#pragma unroll
                        for (int n = 0; n < 2; ++n)
#pragma unroll
                            for (int j = 0; j < 4; ++j) acc[a][b][m][n][j] = accv[a][b][4 * (2 * m + n) + j];
        }
        { const int l2_ = lane_now(); E(acc, cur, wr, wc, l2_ & 15, l2_ >> 4); }
        if (!has_next) break;
#pragma unroll
        for (int a = 0; a < 2; ++a)
#pragma unroll
            for (int b = 0; b < 2; ++b)
#pragma unroll
                for (int m = 0; m < 4; ++m)
#pragma unroll
                    for (int n = 0; n < 2; ++n) acc[a][b][m][n] = (f32x4){0.f, 0.f, 0.f, 0.f};
        if constexpr (F8) {
#pragma unroll
            for (int a = 0; a < 2; ++a)
#pragma unroll
                for (int b = 0; b < 2; ++b)
#pragma unroll
                    for (int j = 0; j < 32; ++j) accv[a][b][j] = 0.f;
        }
        cur = nxt; cA = nA; cB = nB; ++ui;
        if constexpr (Sched::GATHER) {
#pragma unroll
            for (int i = 0; i < 2; ++i) { voA0[i] = vnA0[i]; voA1[i] = vnA1[i]; }
        }
        if (wr == 1) PG8_BAR;
    }
    PG8_WAIT_V(0);
    PG8_BAR;
#undef PG8_SA
#undef PG8_SB
#undef PG8_STAGE
#undef PG8_LDA
#undef PG8_LDB
#undef PG8_MMA
#undef PG8_LDA8
#undef PG8_LDB8
#undef PG8_MMA8
#undef PG8_WAIT_V
#undef PG8_WAIT_L
#undef PG8_BAR
#undef PG8_SCHED
}

struct EpiBf16 {
    static constexpr bool PERM = true;
    bf16_t* O; int ldc; float scale; size_t aux_stride;
    __device__ __forceinline__ void operator()(const f32x4 (&acc)[2][2][4][2], const Unit& u, int wr, int wc, int fr, int fq) const {
        const int row0 = u.pm * BM + wr * 64 + fr, col0 = u.pn * BM + wc * 32 + 8 * fq; bf16_t* base = O + (size_t)u.aux * aux_stride;
#pragma unroll
        for (int ai = 0; ai < 2; ++ai)
#pragma unroll
            for (int m = 0; m < 4; ++m) { bf16_t* rowp = base + (size_t)(row0 + ai * HALF + m * 16) * ldc + col0;
#pragma unroll
                for (int bj = 0; bj < 2; ++bj) { const f32x4 v0 = acc[ai][bj][m][0] * scale, v1 = acc[ai][bj][m][1] * scale;
                    u32x4 w; w.x = cvt_pk_bf16(v0[0], v0[1]); w.y = cvt_pk_bf16(v0[2], v0[3]); w.z = cvt_pk_bf16(v1[0], v1[1]); w.w = cvt_pk_bf16(v1[2], v1[3]);
                    *(u32x4*)(rowp + bj * HALF) = w; } }
    }
};
struct EpiSwiGLU {
    static constexpr bool PERM = true;
    bf16_t* O; int ldc;
    __device__ __forceinline__ void operator()(const f32x4 (&acc)[2][2][4][2], const Unit& u, int wr, int wc, int fr, int fq) const {
        const int row0 = u.pm * BM + wr * 64 + fr, col0 = u.pn * HALF + wc * 32 + 8 * fq;
#pragma unroll
        for (int ai = 0; ai < 2; ++ai)
#pragma unroll
            for (int m = 0; m < 4; ++m) { bf16_t* rowp = O + (size_t)(row0 + ai * HALF + m * 16) * ldc + col0;
                f32x4 h0, h1;
#pragma unroll
                for (int j = 0; j < 4; ++j) { const float g0 = acc[ai][0][m][0][j], g1 = acc[ai][0][m][1][j];
                    h0[j] = g0 * __builtin_amdgcn_rcpf(1.0f + __expf(-g0)) * acc[ai][1][m][0][j]; h1[j] = g1 * __builtin_amdgcn_rcpf(1.0f + __expf(-g1)) * acc[ai][1][m][1][j]; }
                u32x4 w; w.x = cvt_pk_bf16(h0[0], h0[1]); w.y = cvt_pk_bf16(h0[2], h0[3]); w.z = cvt_pk_bf16(h1[0], h1[1]); w.w = cvt_pk_bf16(h1[2], h1[3]);
                *(u32x4*)rowp = w; }
    }
};
struct EpiSwiGLU8 {
    static constexpr bool PERM = true;
    unsigned char* O; int ldc;
    __device__ __forceinline__ void operator()(const f32x4 (&acc)[2][2][4][2], const Unit& u, int wr, int wc, int fr, int fq) const {
        const int row0 = u.pm * BM + wr * 64 + fr, col0 = u.pn * HALF + wc * 32 + 8 * fq;
#pragma unroll
        for (int ai = 0; ai < 2; ++ai)
#pragma unroll
            for (int m = 0; m < 4; ++m) { unsigned char* rowp = O + (size_t)(row0 + ai * HALF + m * 16) * ldc + col0;
                f32x4 h0, h1;
#pragma unroll
                for (int j = 0; j < 4; ++j) { const float g0 = acc[ai][0][m][0][j] * W8_INV, g1 = acc[ai][0][m][1][j] * W8_INV;
                    h0[j] = g0 * __builtin_amdgcn_rcpf(1.0f + __expf(-g0)) * (acc[ai][1][m][0][j] * W8_INV); h1[j] = g1 * __builtin_amdgcn_rcpf(1.0f + __expf(-g1)) * (acc[ai][1][m][1][j] * W8_INV); }
                u32x2 w; w.x = pk4_fp8(h0[0], h0[1], h0[2], h0[3]); w.y = pk4_fp8(h1[0], h1[1], h1[2], h1[3]);
                *(u32x2*)rowp = w; }
    }
};
template <bool XIN_BF, bool XOUT_BF> struct EpiResGate {
    static constexpr bool PERM = false;
    const void* xin; void* out; const float* gate; int gstride; const float* bias; float scale;
    __device__ __forceinline__ void operator()(const f32x4 (&acc)[2][2][4][2], const Unit& u, int wr, int wc, int fr, int fq) const {
        const int row0 = u.pm * BM + wr * 64 + fr, col0 = u.pn * BM + wc * 32 + 4 * fq;
        const float* gp = gate + (size_t)((u.pm * BM) / SEQ) * gstride + col0;
        f32x4 gv[2][2], bv[2][2];
#pragma unroll
        for (int bj = 0; bj < 2; ++bj)
#pragma unroll
            for (int n = 0; n < 2; ++n) { gv[bj][n] = *(const f32x4*)(gp + bj * HALF + n * 16); bv[bj][n] = bias ? *(const f32x4*)(bias + col0 + bj * HALF + n * 16) : (f32x4){0.f, 0.f, 0.f, 0.f}; }
#pragma unroll
        for (int aim = 0; aim < 4; ++aim) { const int ai = aim >> 1, mb = (aim & 1) * 2;
            f32x4 xv[4][2][2];
#pragma unroll
            for (int m = mb; m < mb + 2; ++m)
#pragma unroll
                for (int bj = 0; bj < 2; ++bj)
#pragma unroll
                    for (int n = 0; n < 2; ++n) { const size_t o2 = (size_t)(row0 + ai * HALF + m * 16) * DM + col0 + bj * HALF + n * 16;
                        if constexpr (XIN_BF) { const u32x2 w = *(const u32x2*)((const bf16_t*)xin + o2); xv[m][bj][n] = (f32x4){bflo(w.x), bfhi(w.x), bflo(w.y), bfhi(w.y)}; } else xv[m][bj][n] = *(const f32x4*)((const float*)xin + o2); }
            asm volatile("" ::: "memory");
#pragma unroll
            for (int m = mb; m < mb + 2; ++m)
#pragma unroll
                for (int bj = 0; bj < 2; ++bj)
#pragma unroll
                    for (int n = 0; n < 2; ++n) { const size_t o2 = (size_t)(row0 + ai * HALF + m * 16) * DM + col0 + bj * HALF + n * 16;
                        const f32x4 r = xv[m][bj][n] + gv[bj][n] * (acc[ai][bj][m][n] * scale + bv[bj][n]);
                        if constexpr (XOUT_BF) { u32x2 w; w.x = cvt_pk_bf16(r[0], r[1]); w.y = cvt_pk_bf16(r[2], r[3]); *(u32x2*)((bf16_t*)out + o2) = w; } else *(f32x4*)((float*)out + o2) = r; }
            asm volatile("" ::: "memory");
        }
    }
};
struct EpiB1 {
    static constexpr bool PERM = true;
    bf16_t* UT;
    __device__ __forceinline__ void operator()(const f32x4 (&acc)[2][2][4][2], const Unit& u, int wr, int wc, int fr, int fq) const {
        const unsigned base = (unsigned)(((u.pn * 1024 + u.aux * 128 + wr * 64 + fr) * 2) * 256 + wc * 32 + 8 * fq);
#pragma unroll
        for (int ai = 0; ai < 2; ++ai)
#pragma unroll
            for (int m = 0; m < 4; ++m)
#pragma unroll
                for (int bj = 0; bj < 2; ++bj) { const f32x4 v0 = acc[ai][bj][m][0], v1 = acc[ai][bj][m][1];
                    u32x4 w; w.x = cvt_pk_bf16(v0[0], v0[1]); w.y = cvt_pk_bf16(v0[2], v0[3]); w.z = cvt_pk_bf16(v1[0], v1[1]); w.w = cvt_pk_bf16(v1[2], v1[3]);
                    *(u32x4*)(UT + (base + (unsigned)((m * 16) * 512 + ai * 256 + bj * HALF))) = w; }
    }
};
struct EpiB2 {
    static constexpr bool PERM = true;
    unsigned char* Fo;
    __device__ __forceinline__ void operator()(const f32x4 (&acc)[2][2][4][2], const Unit& u, int wr, int wc, int fr, int fq) const {
        const int b = u.aux >> 4, k1 = u.aux & 15, k1m = (16 - k1) & 15, k2off = k1 ? 255 : 256;
        const unsigned colb = (unsigned)(u.pn * 512 + wc * 32 + 8 * fq);
        const bool edge = (wc == 0) && (fq == 0);
#pragma unroll
        for (int ai = 0; ai < 2; ++ai)
#pragma unroll
            for (int m = 0; m < 4; ++m) { const int k2 = ai * HALF + wr * 64 + m * 16 + fr, k2m = (k2off - k2) & 255;
                const unsigned rowd = (unsigned)(b * SEQ + k1 + 16 * k2) * DM, rowm = (unsigned)(b * SEQ + k1m + 16 * k2m) * DM;
#pragma unroll
                for (int bj = 0; bj < 2; ++bj) { const f32x4 v0 = acc[ai][bj][m][0] * (1.0f / 1024.0f), v1 = acc[ai][bj][m][1] * (1.0f / 1024.0f);
                    u32x2 w; w.x = pk4_fp8(v0[0], v0[1], v0[2], v0[3]); w.y = pk4_fp8(v1[0], v1[1], v1[2], v1[3]);
                    *(u32x2*)(Fo + (rowd + colb + (unsigned)(bj * 256))) = w;
                    unsigned char* mp = Fo + (rowm + colb + (unsigned)(bj * 256 + 128));
                    if (!edge) *(u32x2*)mp = w;
                    else { mp[1] = (unsigned char)(w.x >> 8); *(unsigned short*)(mp + 2) = (unsigned short)(w.x >> 16); *(unsigned*)(mp + 4) = w.y; } } }
    }
};
}
struct BgConv { int item, end; const float *w_o, *w_gate, *w_up, *w_down; unsigned char *o8, *gu8, *d8; unsigned char* pdst; int pldk; };
constexpr int BG_SQ = (DM / 32) * (DM / 32), BG_E = (DM / 32) * (DE / 32), BG_TOTAL = BG_SQ + 3 * 32 * BG_E;
struct BgItem { const float* src; unsigned char* dst; int N, ldk; };
__device__ __forceinline__ BgItem bg_decode(const BgConv& g, int idx) {
    BgItem it; int kb, nb, drow;
    if (idx < BG_SQ) { kb = idx >> 6; nb = idx & 63; it.src = g.w_o; it.N = DM; it.dst = g.o8; it.ldk = DM; drow = 32 * nb; }
    else { const int r = idx - BG_SQ, which = r / (32 * BG_E), r2 = r % (32 * BG_E), le = r2 / BG_E, t = r2 % BG_E;
        if (which < 2) { kb = t >> 5; nb = t & 31; const int n0 = 32 * nb; it.src = (which == 0 ? g.w_gate : g.w_up) + (size_t)le * DM * DE; it.N = DE; it.dst = g.gu8 + (size_t)le * DM * DM; it.ldk = DM; drow = (n0 >> 7) * 256 + (n0 & 127) + (which ? 128 : 0); }
        else { kb = t >> 6; nb = t & 63; it.src = g.w_down + (size_t)le * DE * DM; it.N = DM; it.dst = g.d8 + (size_t)le * DM * DE; it.ldk = DE; drow = 32 * nb; } }
    it.src += (size_t)(32 * kb) * it.N + 32 * nb; it.dst += (size_t)drow * it.ldk + 32 * kb;
    return it;
}
__device__ __forceinline__ void bg_issue_at(const BgConv& g, int idx, int lane, unsigned slot) {
    const BgItem it = bg_decode(g, idx); const char* p = (const char*)it.src + (unsigned)(((lane >> 3) * it.N + (lane & 7) * 4) * 4);
#pragma unroll
    for (int i = 0; i < 4; ++i) __builtin_amdgcn_global_load_lds((const unsigned*)(p + (size_t)(8 * i) * it.N * 4), (LAS unsigned*)(slot + i * 1024), 16, 0, 2);
}
__device__ __forceinline__ void bg_consume_at(const BgConv& g, int idx, int lane, unsigned slot) {
    const BgItem it = bg_decode(g, idx); const int c = lane & 1, n = lane >> 1; const LAS float* s = (const LAS float*)(slot + (unsigned)(((16 * c) * 32 + n) * 4));
    u32x4 o; o.x = pk4_fp8(s[0 * 32] * W8_SCALE, s[1 * 32] * W8_SCALE, s[2 * 32] * W8_SCALE, s[3 * 32] * W8_SCALE); o.y = pk4_fp8(s[4 * 32] * W8_SCALE, s[5 * 32] * W8_SCALE, s[6 * 32] * W8_SCALE, s[7 * 32] * W8_SCALE);
    o.z = pk4_fp8(s[8 * 32] * W8_SCALE, s[9 * 32] * W8_SCALE, s[10 * 32] * W8_SCALE, s[11 * 32] * W8_SCALE); o.w = pk4_fp8(s[12 * 32] * W8_SCALE, s[13 * 32] * W8_SCALE, s[14 * 32] * W8_SCALE, s[15 * 32] * W8_SCALE);
    __builtin_nontemporal_store(o, (u32x4*)(it.dst + (size_t)n * it.ldk + 16 * c));
    asm volatile("s_waitcnt lgkmcnt(0)" ::: "memory");
}
__device__ __forceinline__ void bg_issue(BgConv& g, int lane, unsigned slot) {
    const BgItem it = bg_decode(g, g.item); g.pdst = it.dst; g.pldk = it.ldk; const char* p = (const char*)it.src + (unsigned)(((lane >> 3) * it.N + (lane & 7) * 4) * 4);
#pragma unroll
    for (int i = 0; i < 4; ++i) __builtin_amdgcn_global_load_lds((const unsigned*)(p + (size_t)(8 * i) * it.N * 4), (LAS unsigned*)(slot + i * 1024), 16, 0, 2);
}
__device__ __forceinline__ void bg_consume(BgConv& g, int lane, unsigned slot) {
    const int c = lane & 1, n = lane >> 1; const LAS float* s = (const LAS float*)(slot + (unsigned)(((16 * c) * 32 + n) * 4));
    u32x4 o; o.x = pk4_fp8(s[0 * 32] * W8_SCALE, s[1 * 32] * W8_SCALE, s[2 * 32] * W8_SCALE, s[3 * 32] * W8_SCALE); o.y = pk4_fp8(s[4 * 32] * W8_SCALE, s[5 * 32] * W8_SCALE, s[6 * 32] * W8_SCALE, s[7 * 32] * W8_SCALE);
    o.z = pk4_fp8(s[8 * 32] * W8_SCALE, s[9 * 32] * W8_SCALE, s[10 * 32] * W8_SCALE, s[11 * 32] * W8_SCALE); o.w = pk4_fp8(s[12 * 32] * W8_SCALE, s[13 * 32] * W8_SCALE, s[14 * 32] * W8_SCALE, s[15 * 32] * W8_SCALE);
    __builtin_nontemporal_store(o, (u32x4*)(g.pdst + (size_t)n * g.pldk + 16 * c));
    asm volatile("s_waitcnt lgkmcnt(0)" ::: "memory");
    ++g.item;
}
__device__ __forceinline__ void bg_now(BgConv& g, int lane, unsigned slot) {
    bg_issue(g, lane, slot); asm volatile("s_waitcnt vmcnt(0)" ::: "memory"); bg_consume(g, lane, slot);
}
namespace att {
constexpr int NW = 8, QBLK = 32, KVBLK = 64, DV = 128;
constexpr float THR = 8.f;
#define SBAR() __builtin_amdgcn_sched_barrier(0)
#ifndef ATT_ROLE_SPLIT
#define ATT_ROLE_SPLIT 4
#endif
__device__ __forceinline__ int crow(int r, int hi) { return (r & 3) + 8 * (r >> 2) + 4 * hi; }
__device__ __forceinline__ int v_st(int k, int c) { const int kk = (k & ~0xC) | ((k & 4) << 1) | ((k & 8) >> 1); return ((kk >> 3) * 4 + (c >> 5)) * 512 + ((kk & 7) * 32 + (c & 31)) * 2; }
__device__ __forceinline__ int v_rd_base(int lane) { return ((lane & 3) << 3) | (((lane >> 2) & 3) << 6) | (((lane >> 4) & 1) << 5) | (((lane >> 5) & 1) << 8); }
constexpr int v_rd_off(int d0, int ks, int half) { return d0 * 512 + ks * 4096 + half * 2048; }
template <int OFF> __device__ __forceinline__ s16x4 tr_read(int vb) {
  s16x4 r; asm volatile("ds_read_b64_tr_b16 %0, %1 offset:%2" : "=&v"(r) : "v"(vb), "i"(OFF) : "memory"); return r;
}
template <int D0> __device__ __forceinline__ void pv_one(f32x16& od, int vb, bf16x8 pa0, bf16x8 pa1, bf16x8 pa2, bf16x8 pa3) {
  const s16x4 l0 = tr_read<v_rd_off(D0, 0, 0)>(vb), h0 = tr_read<v_rd_off(D0, 0, 1)>(vb), l1 = tr_read<v_rd_off(D0, 1, 0)>(vb), h1 = tr_read<v_rd_off(D0, 1, 1)>(vb);
  const s16x4 l2 = tr_read<v_rd_off(D0, 2, 0)>(vb), h2 = tr_read<v_rd_off(D0, 2, 1)>(vb), l3 = tr_read<v_rd_off(D0, 3, 0)>(vb), h3 = tr_read<v_rd_off(D0, 3, 1)>(vb);
  asm volatile("s_waitcnt lgkmcnt(0)" ::: "memory"); SBAR();
#define PK(L, H) (bf16x8){L[0], L[1], L[2], L[3], H[0], H[1], H[2], H[3]}
  od = __builtin_amdgcn_mfma_f32_32x32x16_bf16(pa0, PK(l0, h0), od, 0, 0, 0);
  od = __builtin_amdgcn_mfma_f32_32x32x16_bf16(pa1, PK(l1, h1), od, 0, 0, 0);
  od = __builtin_amdgcn_mfma_f32_32x32x16_bf16(pa2, PK(l2, h2), od, 0, 0, 0);
  od = __builtin_amdgcn_mfma_f32_32x32x16_bf16(pa3, PK(l3, h3), od, 0, 0, 0);
#undef PK
}
__device__ __forceinline__ void pv_d0(f32x16* o, int vb, bf16x8 pa0, bf16x8 pa1, bf16x8 pa2, bf16x8 pa3) {
  pv_one<0>(o[0], vb, pa0, pa1, pa2, pa3); pv_one<1>(o[1], vb, pa0, pa1, pa2, pa3); pv_one<2>(o[2], vb, pa0, pa1, pa2, pa3); pv_one<3>(o[3], vb, pa0, pa1, pa2, pa3);
}
template <int DK, bool WINDOW>
__device__ __forceinline__ void partialSM(f32x16& p0, f32x16& p1, float& m_reg, float& mn, float& alpha, int dq, int hi) {
  constexpr float SCALE = (DK == 128) ? 0.088388347648318440f : 0.072168783648703220f;
  constexpr float C = SCALE * 1.4426950408889634f;
  if constexpr (WINDOW) {
    const int dqh = dq - 4 * hi + 128;
#pragma unroll
    for (int r = 0; r < 16; ++r) { const unsigned d0 = (unsigned)(dqh - ((r & 3) + 8 * (r >> 2))), d1 = d0 - 32u;
      p0[r] = d0 <= 256u ? p0[r] : -1e30f; p1[r] = d1 <= 256u ? p1[r] : -1e30f; }
  }
  float pmax = p0[0];
#pragma unroll
  for (int r = 1; r < 16; ++r) pmax = fmaxf(pmax, p0[r]);
#pragma unroll
  for (int r = 0; r < 16; ++r) pmax = fmaxf(pmax, p1[r]);
  { auto rr = __builtin_amdgcn_permlane32_swap(__float_as_uint(pmax), __float_as_uint(pmax), false, false);
    pmax = fmaxf(__uint_as_float(rr[0]), __uint_as_float(rr[1])); }
  if (__builtin_expect(__all(pmax - m_reg <= THR / SCALE), 1)) { mn = m_reg; alpha = 1.f; }
  else { mn = fmaxf(m_reg, pmax); alpha = __builtin_amdgcn_exp2f((m_reg - mn) * C); m_reg = mn; }
  const float mnC = -mn * C;
#pragma unroll
  for (int r = 0; r < 16; ++r) p0[r] = fmaf(p0[r], C, mnC);
#pragma unroll
  for (int r = 0; r < 16; ++r) p1[r] = fmaf(p1[r], C, mnC);
#pragma unroll
  for (int r = 0; r < 16; ++r) p0[r] = __builtin_amdgcn_exp2f(p0[r]);
}
__device__ __forceinline__ void finishSM(f32x16& p0, f32x16& p1, float alpha, float& l_reg, bf16x8& pa0, bf16x8& pa1, bf16x8& pa2, bf16x8& pa3) {
#pragma unroll
  for (int r = 0; r < 16; ++r) p1[r] = __builtin_amdgcn_exp2f(p1[r]);
  float ps = 0;
#pragma unroll
  for (int r = 0; r < 16; ++r) ps += p0[r];
#pragma unroll
  for (int r = 0; r < 16; ++r) ps += p1[r];
  { auto rr = __builtin_amdgcn_permlane32_swap(__float_as_uint(ps), __float_as_uint(ps), false, false);
    ps = __uint_as_float(rr[0]) + __uint_as_float(rr[1]); }
  l_reg = l_reg * alpha + ps;
#define PK4(P, BASE, OUT) do { unsigned a0 = cvt_pk_bf16(P[BASE + 0], P[BASE + 1]), a1 = cvt_pk_bf16(P[BASE + 2], P[BASE + 3]);   \
    unsigned b0 = cvt_pk_bf16(P[BASE + 4], P[BASE + 5]), b1 = cvt_pk_bf16(P[BASE + 6], P[BASE + 7]);                              \
    auto r0 = __builtin_amdgcn_permlane32_swap(a0, b0, false, false); auto r1 = __builtin_amdgcn_permlane32_swap(a1, b1, false, false); \
    u32x4 w = {r0[0], r1[0], r0[1], r1[1]}; OUT = *reinterpret_cast<bf16x8*>(&w); } while (0)
  PK4(p0, 0, pa0); PK4(p0, 8, pa1); PK4(p1, 0, pa2); PK4(p1, 8, pa3);
#undef PK4
}
template <int DK> __device__ __forceinline__ int kswz(int row, int colB) { return row * (DK * 2) + (colB ^ ((row & (DK == 128 ? 15 : 7)) << 4)); }
template <int DK>
__device__ __forceinline__ void qkt(f32x16& p0, f32x16& p1, unsigned kb, int kx, int hi16, const bf16x8* qr) {
  p0 = f32x16{}; p1 = f32x16{};
  unsigned a[4];
#pragma unroll
  for (int q = 0; q < 4; ++q) a[q] = kb + (unsigned)((q * 32 + hi16) ^ kx);
#pragma unroll
  for (int d0 = 0; d0 < DK / 16; ++d0) {
    const bf16x8 b0 = *(const LAS bf16x8*)(a[d0 & 3] + (d0 >> 2) * 128);
    const bf16x8 b1 = *(const LAS bf16x8*)(a[d0 & 3] + (d0 >> 2) * 128 + 32 * DK * 2);
    p0 = __builtin_amdgcn_mfma_f32_32x32x16_bf16(b0, qr[d0], p0, 0, 0, 0);
    p1 = __builtin_amdgcn_mfma_f32_32x32x16_bf16(b1, qr[d0], p1, 0, 0, 0);
    if ((d0 & 3) == 3) SBAR(); }
}

template <int DK>
__device__ __forceinline__ void qkt_fin(f32x16& pc0, f32x16& pc1, unsigned kb, int kx, int hi16, const bf16x8* qr, f32x16& pp0, f32x16& pp1, float alphaP, float& l_reg,
                                        bf16x8& pa0, bf16x8& pa1, bf16x8& pa2, bf16x8& pa3) {
  static_assert(DK == 192, "qkt_fin is written for three k-groups");
  pc0 = f32x16{}; pc1 = f32x16{};
  unsigned a[4];
#pragma unroll
  for (int q = 0; q < 4; ++q) a[q] = kb + (unsigned)((q * 32 + hi16) ^ kx);
#define QGROUP(G) do { _Pragma("unroll") for (int d0 = 4 * (G); d0 < 4 * (G) + 4; ++d0) { \
      const bf16x8 b0 = *(const LAS bf16x8*)(a[d0 & 3] + (d0 >> 2) * 128); const bf16x8 b1 = *(const LAS bf16x8*)(a[d0 & 3] + (d0 >> 2) * 128 + 32 * DK * 2); \
      pc0 = __builtin_amdgcn_mfma_f32_32x32x16_bf16(b0, qr[d0], pc0, 0, 0, 0); pc1 = __builtin_amdgcn_mfma_f32_32x32x16_bf16(b1, qr[d0], pc1, 0, 0, 0); } } while (0)
#pragma unroll
  for (int r = 0; r < 16; ++r) pp1[r] = __builtin_amdgcn_exp2f(pp1[r]);
  QGROUP(0); SBAR();
  { float ps = 0;
#pragma unroll
    for (int r = 0; r < 16; ++r) ps += pp0[r];
#pragma unroll
    for (int r = 0; r < 16; ++r) ps += pp1[r];
    { auto rr = __builtin_amdgcn_permlane32_swap(__float_as_uint(ps), __float_as_uint(ps), false, false); ps = __uint_as_float(rr[0]) + __uint_as_float(rr[1]); }
    l_reg = l_reg * alphaP + ps; }
  QGROUP(1); SBAR();
#define PK4(P, BASE, OUT) do { unsigned a0_ = cvt_pk_bf16(P[BASE + 0], P[BASE + 1]), a1_ = cvt_pk_bf16(P[BASE + 2], P[BASE + 3]);   \
    unsigned b0_ = cvt_pk_bf16(P[BASE + 4], P[BASE + 5]), b1_ = cvt_pk_bf16(P[BASE + 6], P[BASE + 7]);                              \
    auto r0_ = __builtin_amdgcn_permlane32_swap(a0_, b0_, false, false); auto r1_ = __builtin_amdgcn_permlane32_swap(a1_, b1_, false, false); \
    u32x4 w_ = {r0_[0], r1_[0], r0_[1], r1_[1]}; OUT = *reinterpret_cast<bf16x8*>(&w_); } while (0)
  PK4(pp0, 0, pa0); PK4(pp0, 8, pa1); PK4(pp1, 0, pa2); PK4(pp1, 8, pa3);
#undef PK4
  QGROUP(2); SBAR();
#undef QGROUP
}
template <int DK, bool WINDOW>
__device__ __forceinline__ void pv_psm(f32x16* o, int vb, bf16x8 pa0, bf16x8 pa1, bf16x8 pa2, bf16x8 pa3, f32x16& p0, f32x16& p1, float& m_reg, float& alpha, int dq, int hi) {
  constexpr float SCALE = (DK == 128) ? 0.088388347648318440f : 0.072168783648703220f;
  constexpr float C = SCALE * 1.4426950408889634f;
#define PVGROUP(D0, ...) do { \
    const s16x4 l0 = tr_read<v_rd_off(D0, 0, 0)>(vb), h0 = tr_read<v_rd_off(D0, 0, 1)>(vb), l1 = tr_read<v_rd_off(D0, 1, 0)>(vb), h1 = tr_read<v_rd_off(D0, 1, 1)>(vb); \
    const s16x4 l2 = tr_read<v_rd_off(D0, 2, 0)>(vb), h2 = tr_read<v_rd_off(D0, 2, 1)>(vb), l3 = tr_read<v_rd_off(D0, 3, 0)>(vb), h3 = tr_read<v_rd_off(D0, 3, 1)>(vb); \
    __VA_ARGS__; \
    asm volatile("s_waitcnt lgkmcnt(0)" ::: "memory"); SBAR(); \
    o[D0] = __builtin_amdgcn_mfma_f32_32x32x16_bf16(pa0, (bf16x8){l0[0], l0[1], l0[2], l0[3], h0[0], h0[1], h0[2], h0[3]}, o[D0], 0, 0, 0); \
    o[D0] = __builtin_amdgcn_mfma_f32_32x32x16_bf16(pa1, (bf16x8){l1[0], l1[1], l1[2], l1[3], h1[0], h1[1], h1[2], h1[3]}, o[D0], 0, 0, 0); \
    o[D0] = __builtin_amdgcn_mfma_f32_32x32x16_bf16(pa2, (bf16x8){l2[0], l2[1], l2[2], l2[3], h2[0], h2[1], h2[2], h2[3]}, o[D0], 0, 0, 0); \
    o[D0] = __builtin_amdgcn_mfma_f32_32x32x16_bf16(pa3, (bf16x8){l3[0], l3[1], l3[2], l3[3], h3[0], h3[1], h3[2], h3[3]}, o[D0], 0, 0, 0); } while (0)
  float mnC;
  PVGROUP(0, {
    if constexpr (WINDOW) { const int dqh = dq - 4 * hi + 128;
      _Pragma("unroll") for (int r = 0; r < 16; ++r) { const unsigned d0_ = (unsigned)(dqh - ((r & 3) + 8 * (r >> 2))), d1_ = d0_ - 32u; p0[r] = d0_ <= 256u ? p0[r] : -1e30f; p1[r] = d1_ <= 256u ? p1[r] : -1e30f; } }
    float pmax = p0[0];
    _Pragma("unroll") for (int r = 1; r < 16; ++r) pmax = fmaxf(pmax, p0[r]);
    _Pragma("unroll") for (int r = 0; r < 16; ++r) pmax = fmaxf(pmax, p1[r]);
    { auto rr = __builtin_amdgcn_permlane32_swap(__float_as_uint(pmax), __float_as_uint(pmax), false, false); pmax = fmaxf(__uint_as_float(rr[0]), __uint_as_float(rr[1])); }
    const bool keep = __all(pmax - m_reg <= THR / SCALE);
    const float mn = keep ? m_reg : fmaxf(m_reg, pmax);
    alpha = keep ? 1.f : __builtin_amdgcn_exp2f((m_reg - mn) * C); m_reg = mn; mnC = -mn * C; });
  PVGROUP(1, { _Pragma("unroll") for (int r = 0; r < 16; ++r) p0[r] = fmaf(p0[r], C, mnC); });
  PVGROUP(2, { _Pragma("unroll") for (int r = 0; r < 16; ++r) p1[r] = fmaf(p1[r], C, mnC); });
  PVGROUP(3, { _Pragma("unroll") for (int r = 0; r < 16; ++r) p0[r] = __builtin_amdgcn_exp2f(p0[r]); });
#undef PVGROUP
}

template <int DK, bool WINDOW>
__device__ __forceinline__ void attn_unit(const bf16_t* __restrict__ Qb, int ldq, const bf16_t* __restrict__ Kh, const bf16_t* __restrict__ Vh, unsigned char* __restrict__ Ob, int ldo,
                                          int NT, int ks, int q0, float sink, char* lds, const int wid, BgConv& bg) {
  constexpr float SCALE = (DK == 128) ? 0.088388347648318440f : 0.072168783648703220f;
  constexpr int SHM_K = KVBLK * DK * 2, SHM_V = KVBLK * DV * 2, SLOT = SHM_K + SHM_V, NKC = DK / 64, KCH = DK / 8;
  const int lane = lane_now(), tid = wid * 64 + lane, r32 = lane & 31, hi = lane >> 5;
  const unsigned lbase = (unsigned)(uintptr_t)lds;
  float* ws = (float*)(lds + 3 * SLOT) + wid * 64; float* li_l = ws; float* al_l = ws + 32;
  float m_reg = WINDOW ? sink / SCALE : -1e30f, l_reg = WINDOW ? 1.f : 0.f;
  f32x16 o[4] = {}; bf16x8 qr[DK / 16];
  const bf16_t* Qw = Qb + (long)(wid * QBLK + r32) * ldq + hi * 8;
#pragma unroll
  for (int d0 = 0; d0 < DK / 16; ++d0) qr[d0] = *reinterpret_cast<const bf16x8*>(Qw + d0 * 16);
  unsigned koff[NKC], voff[2];
#pragma unroll
  for (int i = 0; i < NKC; ++i) { const int c = tid + 512 * i, row = c / KCH, pc = c % KCH, lc = (pc & ~7) | ((pc ^ (row >> 1)) & 7); koff[i] = (unsigned)(row * DK * 2 + lc * 16); }
#pragma unroll
  for (int i = 0; i < 2; ++i) { const int P = (tid + 512 * i) * 16, sub = P >> 9, within = P & 511, kk = (sub >> 2) * 8 + (within >> 6), col = (sub & 3) * 32 + ((within & 63) >> 1), k = (kk & ~0xC) | ((kk & 4) << 1) | ((kk & 8) >> 1);
    voff[i] = (unsigned)((k * DV + col) * 2); }
#pragma unroll
  for (int i = 0; i < NKC; ++i) asm volatile("" : "+v"(koff[i]));
  asm volatile("" : "+v"(voff[0]), "+v"(voff[1]));
  const unsigned bgslot = lbase + 3 * SLOT + 2048 + (unsigned)wid * 4096; bool bgpend = false;
  const int vb0 = (int)lbase + SHM_K + v_rd_base(lane);
  const unsigned kbase0 = lbase + (unsigned)(r32 * DK * 2); const int kx = ((r32 >> 1) & 7) << 4, hi16 = hi * 16;
  const int qpos = q0 + wid * QBLK + r32;
#define TROW(j) (64 * (j) + ((WINDOW && (j) >= 4) ? ks : 0))
#define DMA(j, slot) do { const char* kb_ = (const char*)(Kh + (long)TROW(j) * DK); const char* vb_ = (const char*)(Vh + (long)TROW(j) * DV); \
    _Pragma("unroll") for (int _i = 0; _i < NKC; ++_i) __builtin_amdgcn_global_load_lds((const unsigned*)(kb_ + koff[_i]), (LAS unsigned*)(lbase + (slot) * SLOT + (_i * 512 + wid * 64) * 16), 16, 0, 0); \
    _Pragma("unroll") for (int _i = 0; _i < 2; ++_i) __builtin_amdgcn_global_load_lds((const unsigned*)(vb_ + voff[_i]), (LAS unsigned*)(lbase + (slot) * SLOT + SHM_K + (_i * 512 + wid * 64) * 16), 16, 0, 0); } while (0)
#define RESC(a) do { if (__any((a) < 1.f)) { if (hi == 0) al_l[r32] = (a); asm volatile("s_waitcnt lgkmcnt(0)" ::: "memory"); \
    _Pragma("unroll") for (int d = 0; d < 4; ++d) _Pragma("unroll") for (int r = 0; r < 16; ++r) o[d][r] *= al_l[crow(r, hi)]; } } while (0)
#define MASKED(j) (WINDOW && (j) >= 4)
#define DQ(j) ((WINDOW && (j) >= 4) ? qpos - (ks + 64 * ((j) - 4)) : 0)
#define TBAR() do { asm volatile("s_waitcnt vmcnt(0) lgkmcnt(0)" ::: "memory"); __builtin_amdgcn_s_barrier(); asm volatile("" ::: "memory"); } while (0)
#define STEP(T_, PC0, PC1, MNC, ALC, PP0, PP1, ALP, SK, SV, SD, TD_, BGI, BGC) do { \
    DMA(TD_, SD); \
    if (BGI) { bgpend = bg.item < bg.end; if (bgpend) bg_issue(bg, lane, bgslot); } \
    { unsigned kb_ = kbase0 + (SK) * SLOT; asm volatile("" : "+v"(kb_)); SBAR(); qkt_fin<DK>(PC0, PC1, kb_, kx, hi16, qr, PP0, PP1, ALP, l_reg, pa0, pa1, pa2, pa3); } \
    pv_psm<DK, WINDOW>(o, vb0 + (SV) * SLOT, pa0, pa1, pa2, pa3, PC0, PC1, m_reg, ALC, DQ(T_), hi); \
    RESC(ALC); \
    if ((BGI) && bgpend) asm volatile("s_waitcnt vmcnt(4) lgkmcnt(0)" ::: "memory"); else asm volatile("s_waitcnt vmcnt(0) lgkmcnt(0)" ::: "memory"); \
    if (BGC) { if (bgpend) { bg_consume(bg, lane, bgslot); bgpend = false; } } \
    __builtin_amdgcn_s_barrier(); asm volatile("" ::: "memory"); } while (0)
#define PAIR(J, S) do { STEP(J, pB0, pB1, mnB, alB, pA0, pA1, alA, S, ((S) + 2) % 3, ((S) + 1) % 3, (J) + 1, true, false); \
                        STEP((J) + 1, pA0, pA1, mnA, alA, pB0, pB1, alB, ((S) + 1) % 3, S, ((S) + 2) % 3, (J) + 2, false, true); } while (0)
#define SYNC(t) do { \
    asm volatile("s_waitcnt vmcnt(0) lgkmcnt(0)" ::: "memory"); \
    if (bgpend) { bg_consume(bg, lane, bgslot); bgpend = false; } \
    __builtin_amdgcn_s_barrier(); asm volatile("" ::: "memory"); \
    if ((t) + 2 < NT) DMA((t) + 2, sd); \
    bgpend = bg.item < bg.end; if (bgpend) bg_issue(bg, lane, bgslot); } while (0)
  f32x16 pA0, pA1; float mnA, alA; bf16x8 pa0, pa1, pa2, pa3;
  DMA(0, 0); DMA(1, 1);
#pragma unroll
  for (int d0 = 0; d0 < DK / 16; ++d0) asm volatile("" : "+v"(qr[d0]));
  TBAR();
  const bool late = wid >= ATT_ROLE_SPLIT;
  int sk = 0, sd = 2;
  for (int t = 0; t < NT; ++t) {
    { unsigned kb_ = kbase0 + sk * SLOT; asm volatile("" : "+v"(kb_)); SBAR(); qkt<DK>(pA0, pA1, kb_, kx, hi16, qr); }
    partialSM<DK, WINDOW>(pA0, pA1, m_reg, mnA, alA, DQ(t), hi);
    RESC(alA);
    finishSM(pA0, pA1, alA, l_reg, pa0, pa1, pa2, pa3);
    if (late && t + 1 < NT) SYNC(t);
    { int vb_ = vb0 + sk * SLOT; asm volatile("" : "+v"(vb_)); SBAR(); pv_d0(o, vb_, pa0, pa1, pa2, pa3); }
    if (!late && t + 1 < NT) SYNC(t);
    sk = sk == 2 ? 0 : sk + 1; sd = sd == 2 ? 0 : sd + 1;
  }
  if (bgpend) { asm volatile("s_waitcnt vmcnt(0)" ::: "memory"); bg_consume(bg, lane, bgslot); bgpend = false; }
  if (hi == 0) li_l[r32] = l_reg; asm volatile("s_waitcnt lgkmcnt(0)" ::: "memory");
  float rli[16];
#pragma unroll
  for (int r = 0; r < 16; ++r) rli[r] = 16.0f * __builtin_amdgcn_rcpf(li_l[crow(r, hi)]);
  unsigned char* Ow = Ob + (long)(wid * QBLK) * ldo;
#pragma unroll
  for (int r = 0; r < 16; ++r) { const int orow = crow(r, hi);
    *(unsigned*)(Ow + (long)orow * ldo + 4 * r32) = pk4_fp8(o[0][r] * rli[r], o[1][r] * rli[r], o[2][r] * rli[r], o[3][r] * rli[r]); }
  __syncthreads();
#undef TROW
#undef DMA
#undef RESC
#undef MASKED
#undef DQ
#undef TBAR
#undef STEP
#undef PAIR
#undef SYNC
}
template <int DK>
__device__ __forceinline__ void qkt_s(f32x16& p0, f32x16& p1, const char* Ks, const bf16x8* qr, int r32, int hi) {
  p0 = f32x16{}; p1 = f32x16{};
#pragma unroll
  for (int d0 = 0; d0 < DK / 16; ++d0) { const int cb = (d0 * 16 + hi * 8) * 2;
    const bf16x8 b0 = *reinterpret_cast<const bf16x8*>(Ks + kswz<DK>(r32, cb));
    const bf16x8 b1 = *reinterpret_cast<const bf16x8*>(Ks + kswz<DK>(32 + r32, cb));
    p0 = __builtin_amdgcn_mfma_f32_32x32x16_bf16(b0, qr[d0], p0, 0, 0, 0);
    p1 = __builtin_amdgcn_mfma_f32_32x32x16_bf16(b1, qr[d0], p1, 0, 0, 0);
    if ((d0 & 3) == 3) SBAR(); }
}

template <int DK, bool WINDOW>
__device__ __forceinline__ void attn_unit_simple(const bf16_t* __restrict__ Qb, int ldq, const bf16_t* __restrict__ Kh, const bf16_t* __restrict__ Vh, unsigned char* __restrict__ Ob, int ldo,
                                          int NT, int ks, int q0, float sink, char* lds, const int wid) {
  constexpr float SCALE = (DK == 128) ? 0.088388347648318440f : 0.072168783648703220f;
  constexpr int SHM_K = KVBLK * DK * 2, SHM_V = KVBLK * DV * 2, NKC = DK / 64, KCH = DK / 8;
  const int lane = lane_now(), tid = wid * 64 + lane, r32 = lane & 31, hi = lane >> 5;
  char* V_lds = lds; char* K_lds = lds + 2 * SHM_V;
  float* ws = (float*)(lds + 2 * SHM_V + 2 * SHM_K) + wid * 64; float* li_l = ws; float* al_l = ws + 32;
  float m_reg = WINDOW ? sink / SCALE : -1e30f, l_reg = WINDOW ? 1.f : 0.f;
  f32x16 o[4] = {}; bf16x8 qr[DK / 16];
  const bf16_t* Qw = Qb + (long)(wid * QBLK + r32) * ldq + hi * 8;
#pragma unroll
  for (int d0 = 0; d0 < DK / 16; ++d0) qr[d0] = *reinterpret_cast<const bf16x8*>(Qw + d0 * 16);
  const int sr = tid >> 4, sc = (tid & 15) * 8, vst0 = v_st(sr, sc), vst1 = v_st(32 + sr, sc);
  int krow[NKC], kcc[NKC];
#pragma unroll
  for (int i = 0; i < NKC; ++i) { const int c = tid + 512 * i; krow[i] = c / KCH; kcc[i] = c % KCH; }
  const int vb0 = (int)(uintptr_t)V_lds + v_rd_base(lane);
  const int qpos = q0 + wid * QBLK + r32;
  bf16x8 vs0, vs1, ksr[NKC];
#define TROW(j) (64 * (j) + ((WINDOW && (j) >= 4) ? ks : 0))
#define SLOAD(j) do { const long _k0 = TROW(j); vs0 = *reinterpret_cast<const bf16x8*>(&Vh[(_k0 + sr) * DV + sc]); vs1 = *reinterpret_cast<const bf16x8*>(&Vh[(_k0 + 32 + sr) * DV + sc]); \
    _Pragma("unroll") for (int _i = 0; _i < NKC; ++_i) ksr[_i] = *reinterpret_cast<const bf16x8*>(&Kh[(_k0 + krow[_i]) * DK + kcc[_i] * 8]); } while (0)
#define SWRITE(b) do { *(bf16x8*)(V_lds + (b) * SHM_V + vst0) = vs0; *(bf16x8*)(V_lds + (b) * SHM_V + vst1) = vs1; \
    _Pragma("unroll") for (int _i = 0; _i < NKC; ++_i) *(bf16x8*)(K_lds + (b) * SHM_K + kswz<DK>(krow[_i], kcc[_i] * 16)) = ksr[_i]; } while (0)
#define SWAIT() asm volatile("s_waitcnt vmcnt(0)" ::: "memory")
#define RESC(a) do { if (__any((a) < 1.f)) { if (hi == 0) al_l[r32] = (a); asm volatile("s_waitcnt lgkmcnt(0)" ::: "memory"); \
    _Pragma("unroll") for (int d = 0; d < 4; ++d) _Pragma("unroll") for (int r = 0; r < 16; ++r) o[d][r] *= al_l[crow(r, hi)]; } } while (0)
#define MASKED(j) (WINDOW && (j) >= 4)
#define DQ(j) ((WINDOW && (j) >= 4) ? qpos - (ks + 64 * ((j) - 4)) : 0)
  f32x16 p0, p1; float mn, al; bf16x8 pa0, pa1, pa2, pa3;
  SLOAD(0); SWAIT(); SWRITE(0); __syncthreads();
  for (int j = 0; j < NT; ++j) {
    const int bsel = j & 1;
    if (j + 1 < NT) SLOAD(j + 1);
    const int kp0_ = ks + 64 * (j - 4), qw0_ = q0 + wid * QBLK;
    if (!WINDOW || j < 4 || (kp0_ <= qw0_ + (QBLK - 1) + 128 && kp0_ + 63 >= qw0_ - 128)) {
      SBAR(); qkt_s<DK>(p0, p1, K_lds + bsel * SHM_K, qr, r32, hi);
      partialSM<DK, WINDOW>(p0, p1, m_reg, mn, al, DQ(j), hi);
      RESC(al);
      finishSM(p0, p1, al, l_reg, pa0, pa1, pa2, pa3); SBAR();
      pv_d0(o, vb0 + bsel * SHM_V, pa0, pa1, pa2, pa3); }
    if (j + 1 < NT) { SWAIT(); SWRITE(bsel ^ 1); }
    __syncthreads();
  }
  if (hi == 0) li_l[r32] = l_reg; asm volatile("s_waitcnt lgkmcnt(0)" ::: "memory");
  float rli[16];
#pragma unroll
  for (int r = 0; r < 16; ++r) rli[r] = 16.0f * __builtin_amdgcn_rcpf(li_l[crow(r, hi)]);
  unsigned char* Ow = Ob + (long)(wid * QBLK) * ldo;
#pragma unroll
  for (int r = 0; r < 16; ++r) { const int orow = crow(r, hi);
    *(unsigned*)(Ow + (long)orow * ldo + 4 * r32) = pk4_fp8(o[0][r] * rli[r], o[1][r] * rli[r], o[2][r] * rli[r], o[3][r] * rli[r]); }
  __syncthreads();
#undef TROW
#undef SLOAD
#undef SWRITE
#undef SWAIT
#undef RESC
#undef MASKED
#undef DQ
}
}
struct Frame {
    LAS unsigned char* lds; volatile LAS unsigned* MISC; unsigned* ctl;
    int tid, lane, wave, vcu, G;
    const float *x, *c, *ctx, *c_ctx, *w_ada, *b_ada, *g_norm, *w_in, *g_aqn, *g_akn, *g_bq_lat, *w_bq_up, *g_bkv_lat, *w_bkv_up, *g_bqn, *g_bkn, *sink, *w_o, *w_fo, *b_fo, *w_router, *b_router, *w_gate, *w_up, *w_down;
    float* out; unsigned char* ws;
};
#define WSP(T_, off) ((T_*)(F.ws + (off)))

__device__ __forceinline__ void transpose_item(const float* W, int N, bf16_t* WT, int ldk, int k0, int n0, int drow0, LAS float* scr, int lane) {
#pragma unroll 8
    for (int i = 0; i < 32; ++i) { const int kk = 2 * i + (lane >> 5); scr[kk * 33 + (lane & 31)] = W[(size_t)(k0 + kk) * N + n0 + (lane & 31)]; }
    LDS_WAIT(); asm volatile("" ::: "memory");
    const int c = lane & 7;
#pragma unroll
    for (int j = 0; j < 4; ++j) { const int n = (lane >> 3) + 8 * j; const LAS float* s = scr + (8 * c) * 33 + n;
        u32x4 o; o.x = pk2(s[0 * 33], s[1 * 33]); o.y = pk2(s[2 * 33], s[3 * 33]); o.z = pk2(s[4 * 33], s[5 * 33]); o.w = pk2(s[6 * 33], s[7 * 33]);
        *(GAS u32x4*)(WT + (size_t)(drow0 + n) * ldk + k0 + 8 * c) = o; }
    LDS_WAIT(); asm volatile("" ::: "memory");
}
__device__ __forceinline__ void transpose_item8(const float* W, int N, unsigned char* WT, int ldk, int k0, int n0, int drow0, LAS float* scr, int lane) {
    const float* p = W + (size_t)(k0 + (lane >> 3)) * N + n0 + (lane & 7) * 4; f32x4 r[8];
#pragma unroll
    for (int i = 0; i < 8; ++i) r[i] = __builtin_nontemporal_load((const f32x4*)(p + (size_t)(8 * i) * N));
#pragma unroll
    for (int i = 0; i < 8; ++i) *(LAS f32x4*)(scr + (8 * i + (lane >> 3)) * 36 + (lane & 7) * 4) = r[i];
    LDS_WAIT(); asm volatile("" ::: "memory");
    const int c = lane & 3;
#pragma unroll
    for (int j = 0; j < 2; ++j) { const int n = (lane >> 2) + 16 * j; const LAS float* s = scr + (16 * c) * 36 + n;
        u32x4 o; o.x = pk4_fp8(s[0 * 36] * W8_SCALE, s[1 * 36] * W8_SCALE, s[2 * 36] * W8_SCALE, s[3 * 36] * W8_SCALE); o.y = pk4_fp8(s[4 * 36] * W8_SCALE, s[5 * 36] * W8_SCALE, s[6 * 36] * W8_SCALE, s[7 * 36] * W8_SCALE);
        o.z = pk4_fp8(s[8 * 36] * W8_SCALE, s[9 * 36] * W8_SCALE, s[10 * 36] * W8_SCALE, s[11 * 36] * W8_SCALE); o.w = pk4_fp8(s[12 * 36] * W8_SCALE, s[13 * 36] * W8_SCALE, s[14 * 36] * W8_SCALE, s[15 * 36] * W8_SCALE);
        *(GAS u32x4*)(WT + (size_t)(drow0 + n) * ldk + k0 + 16 * c) = o; }
    LDS_WAIT(); asm volatile("" ::: "memory");
}
__device__ __forceinline__ int wo_src_row(int kp) { return (kp & ~127) + 32 * (kp & 3) + ((kp & 127) >> 2); }
__device__ __forceinline__ int fo_src_row(int kp) { const int p = kp & 255; return (kp & ~255) + (p <= 128 ? p : 384 - p); }
template <bool FO = false>
__device__ __forceinline__ void transpose_item8_wo(const float* W, int N, unsigned char* WT, int ldk, int k0, int n0, LAS float* scr, int lane) {
    f32x4 r[8];
#pragma unroll
    for (int i = 0; i < 8; ++i) { const int kp = k0 + 8 * i + (lane >> 3); r[i] = __builtin_nontemporal_load((const f32x4*)(W + (size_t)(FO ? fo_src_row(kp) : wo_src_row(kp)) * N + n0 + (lane & 7) * 4)); }
#pragma unroll
    for (int i = 0; i < 8; ++i) *(LAS f32x4*)(scr + (8 * i + (lane >> 3)) * 36 + (lane & 7) * 4) = r[i];
    LDS_WAIT(); asm volatile("" ::: "memory");
    const int c = lane & 3;
#pragma unroll
    for (int j = 0; j < 2; ++j) { const int n = (lane >> 2) + 16 * j; const LAS float* s = scr + (16 * c) * 36 + n;
        u32x4 o; o.x = pk4_fp8(s[0 * 36] * W8_SCALE, s[1 * 36] * W8_SCALE, s[2 * 36] * W8_SCALE, s[3 * 36] * W8_SCALE); o.y = pk4_fp8(s[4 * 36] * W8_SCALE, s[5 * 36] * W8_SCALE, s[6 * 36] * W8_SCALE, s[7 * 36] * W8_SCALE);
        o.z = pk4_fp8(s[8 * 36] * W8_SCALE, s[9 * 36] * W8_SCALE, s[10 * 36] * W8_SCALE, s[11 * 36] * W8_SCALE); o.w = pk4_fp8(s[12 * 36] * W8_SCALE, s[13 * 36] * W8_SCALE, s[14 * 36] * W8_SCALE, s[15 * 36] * W8_SCALE);
        *(GAS u32x4*)(WT + (size_t)(n0 + n) * ldk + k0 + 16 * c) = o; }
    LDS_WAIT(); asm volatile("" ::: "memory");
}
__device__ __forceinline__ void conv_plain(const float* W, int K, int N, bf16_t* WT, int item, LAS float* scr, int lane) {
    const int nblk = N / 32, kb = item / nblk, nb = item % nblk; transpose_item(W, N, WT, K, 64 * kb, 32 * nb, 32 * nb, scr, lane);
}

__device__ __forceinline__ void ada_task(Frame& F, int task, const LAS float* sl  , LAS float* red  ) {
    const int l = task / 384, n0 = (task % 384) * 32, kq = F.lane >> 3, c8 = F.lane & 7, k0 = F.wave * 256 + kq;
    const float* wp = F.w_ada + ((size_t)l * DM + k0) * 12288 + n0 + 4 * c8;
    f32x4 a0 = {0, 0, 0, 0}, a1 = a0, a2 = a0, a3 = a0, a4 = a0;
#pragma unroll 8
    for (int i = 0; i < 32; ++i) { const f32x4 w = __builtin_nontemporal_load((const f32x4*)(wp + (size_t)i * 8 * 12288)); const int k = k0 + 8 * i;
        const f32x4 s = *(const LAS f32x4*)(sl + k * 8); const float s4 = sl[k * 8 + 4];
        a0 += w * s[0]; a1 += w * s[1]; a2 += w * s[2]; a3 += w * s[3]; a4 += w * s4; }
#pragma unroll
    for (int o = 8; o < 64; o <<= 1) {
#pragma unroll
        for (int j = 0; j < 4; ++j) { a0[j] += __shfl_xor(a0[j], o); a1[j] += __shfl_xor(a1[j], o); a2[j] += __shfl_xor(a2[j], o); a3[j] += __shfl_xor(a3[j], o); a4[j] += __shfl_xor(a4[j], o); } }
    if (kq == 0) { LAS float* rp = red + (F.wave * 5) * 32 + 4 * c8;
        *(LAS f32x4*)(rp) = a0; *(LAS f32x4*)(rp + 32) = a1; *(LAS f32x4*)(rp + 64) = a2; *(LAS f32x4*)(rp + 96) = a3; *(LAS f32x4*)(rp + 128) = a4; }
    __syncthreads();
    if (F.tid < 160) { const int r = F.tid >> 5, col = F.tid & 31; float v = F.b_ada[(size_t)l * 12288 + n0 + col];
#pragma unroll
        for (int w = 0; w < 8; ++w) v += red[(w * 5 + r) * 32 + col];
        WSP(float, WS_MOD)[((size_t)l * 5 + r) * 12288 + n0 + col] = v; }
    __syncthreads();
}

#ifndef BG_PW
#define BG_PW 96
#endif
constexpr int BG_PER_WAVE = BG_PW;
static_assert(BG_PER_WAVE <= 2 * (KVLEN / 64 - 1), "background items per wave");
__device__ __forceinline__ int bg_split(int ngw) { const int n0 = BG_TOTAL - ngw * BG_PER_WAVE; return n0 > BG_SQ ? n0 : BG_SQ; }
__device__ __forceinline__ void bg_setup(Frame& F, BgConv& bg) { bg.item = 0; bg.end = 0; bg.w_o = F.w_o; bg.w_gate = F.w_gate; bg.w_up = F.w_up; bg.w_down = F.w_down;
    bg.o8 = WSP(unsigned char, WS_WO_T); bg.gu8 = WSP(unsigned char, WS_WGU_T); bg.d8 = WSP(unsigned char, WS_WD_T); }
constexpr int ADA_TASKS = 2 * 384, ADA_P0_END = MK_SINGLE ? 128 : ADA_TASKS, ADA_P2_END = 384, ADA_P10_END = 640;
__device__ __forceinline__ void ada_tail(Frame& F, int lo, int hi, int first, int step) {
    LAS float* sl = (LAS float*)(F.lds); LAS float* red = (LAS float*)(F.lds + 65536);
    __syncthreads();
    for (int i = F.tid; i < DM * 5; i += NTHR) { const int r = i / DM, k = i % DM; const float v = r < 4 ? F.c[r * DM + k] : F.c_ctx[k]; sl[k * 8 + r] = silu_f(v); }
    __syncthreads();
    for (int task = lo + first; task < hi; task += step) ada_task(F, task, sl, red);
}
__device__ __forceinline__ void sq_tail(Frame& F, int which, int first, int step) {
    constexpr int I_SQ = (DM / 64) * (DM / 32);
    LAS float* scr = (LAS float*)(F.lds + F.wave * 16384);
    __syncthreads();
    for (int r = first * NWAVES + F.wave; r < I_SQ; r += step * NWAVES) { const int nblk = DM / 32, kb = r / nblk, nb = r % nblk;
        if (which) transpose_item8_wo<true>(F.w_fo, DM, WSP(unsigned char, WS_WFO_T), DM, 64 * kb, 32 * nb, scr, F.lane);
        else transpose_item8_wo(F.w_o, DM, WSP(unsigned char, WS_WO_T), DM, 64 * kb, 32 * nb, scr, F.lane); }
    __syncthreads();
}
__device__ __forceinline__ void sq_idle(Frame& F, int U, int c, int which) {
    if (!MK_SINGLE) return;
    const int R = (U + F.G - 1) / F.G, nb = U - (R - 1) * F.G;
    if (nb >= F.G || nb <= 0) sq_tail(F, which, c, F.G); else if (c >= nb) sq_tail(F, which, c - nb, F.G - nb);
}
__device__ __forceinline__ void ada_idle(Frame& F, int U, int c, int lo, int hi) {
    if (!MK_SINGLE || lo >= hi) return;
    const int R = (U + F.G - 1) / F.G, nb = U - (R - 1) * F.G;
    if (nb >= F.G || nb <= 0) ada_tail(F, lo, hi, c, F.G); else if (c >= nb) ada_tail(F, lo, hi, c - nb, F.G - nb);
}
template <int PRB = 0>
__device__ __forceinline__ void p0_prologue(Frame& F) {
    const int gw = F.vcu * NWAVES + F.wave, NGW = F.G * NWAVES;
    LAS float* sl = (LAS float*)(F.lds);
    for (int i = F.tid; i < DM * 5; i += NTHR) { const int r = i / DM, k = i % DM; const float v = r < 4 ? F.c[r * DM + k] : F.c_ctx[k]; sl[k * 8 + r] = silu_f(v); }
    __syncthreads();
    if (PRB == 0 || PRB == 1) { LAS float* red = (LAS float*)(F.lds + 65536); for (int task = F.vcu; task < ADA_P0_END; task += F.G) ada_task(F, task, sl, red); }
    __syncthreads();
    LAS float* scr = (LAS float*)(F.lds + F.wave * 16384);
    constexpr int I_IN = (DM / 64) * (INW / 32), I_BQ = (512 / 64) * (1536 / 32), I_BKV = (256 / 64) * (2048 / 32), I_SQ = (DM / 64) * (DM / 32), I_E = (DM / 64) * (DE / 32)  ;
    constexpr int NITEMS = I_IN + I_BQ + I_BKV + (MK_SINGLE ? 0 : 2 * I_SQ);
    if (PRB == 0 || PRB == 2) for (int it = gw; it < NITEMS; it += NGW) {
        int r = it;
        if (r < I_IN) { const int nblk = INW / 32, kb = r / nblk, nb = r % nblk; transpose_item8(F.w_in, INW, WSP(unsigned char, WS_WIN_T), DM, 64 * kb, 32 * nb, 32 * nb, scr, F.lane); continue; } r -= I_IN;
        if (r < I_BQ) { conv_plain(F.w_bq_up, 512, 1536, WSP(bf16_t, WS_WBQ_T), r, scr, F.lane); continue; } r -= I_BQ;
        if (r < I_BKV) { conv_plain(F.w_bkv_up, 256, 2048, WSP(bf16_t, WS_WBKV_T), r, scr, F.lane); continue; } r -= I_BKV;
        if (r < I_SQ) { const int nblk = DM / 32, kb = r / nblk, nb = r % nblk; transpose_item8_wo<true>(F.w_fo, DM, WSP(unsigned char, WS_WFO_T), DM, 64 * kb, 32 * nb, scr, F.lane); continue; } r -= I_SQ;
        { const int nblk = DM / 32, kb = r / nblk, nb = r % nblk; transpose_item8_wo(F.w_o, DM, WSP(unsigned char, WS_WO_T), DM, 64 * kb, 32 * nb, scr, F.lane); }
    }
    if (PRB == 0 || PRB == 3) { BgConv bg; bg_setup(F, bg); const int n0 = bg_split(NGW); const unsigned slot = (unsigned)(uintptr_t)(char*)(F.lds + F.wave * 16384 + 8192);
      if (BG_SQ + gw < n0) { bg_issue_at(bg, BG_SQ + gw, F.lane, slot);
        for (int idx = BG_SQ + gw, par = 0; idx < n0; idx += NGW, par ^= 1) { const int nx = idx + NGW;
          if (nx < n0) { bg_issue_at(bg, nx, F.lane, slot + (par ^ 1) * 4096u); asm volatile("s_waitcnt vmcnt(4)" ::: "memory"); } else asm volatile("s_waitcnt vmcnt(0)" ::: "memory");
          bg_consume_at(bg, idx, F.lane, slot + par * 4096u); } } }
    if (PRB != 0 && PRB != 4) return;
    for (int i = blockIdx.x * NTHR + F.tid; i < DM * NE; i += F.G * NTHR) { const int e = i >> 11, k = i & 2047; WSP(float, WS_WRT)[i] = F.w_router[k * NE + e]; }
    { u32x4* z = (u32x4*)(WSP(unsigned char, WS_WIN_T) + (size_t)INW * DM); const int n16 = (INWP - INW) * DM / 16;
      for (int i = blockIdx.x * NTHR + F.tid; i < n16; i += F.G * NTHR) z[i] = (u32x4){0u, 0u, 0u, 0u}; }
    for (int i = blockIdx.x * NTHR + F.tid; i < 256 * 512 / 2; i += F.G * NTHR) { const int e = 2 * i, row = e >> 9, kk = e & 511, po = row >> 7, j = row & 127, pi = kk >> 8, c0 = kk & 255; float v[2];
#pragma unroll
        for (int q = 0; q < 2; ++q) { const float f = (float)((j * (c0 + q)) & 255) * (1.0f / 256.0f); const float cs = __builtin_amdgcn_cosf(f), sn = __builtin_amdgcn_sinf(f); v[q] = po == 0 ? (pi == 0 ? cs : sn) : (pi == 0 ? -sn : cs); }
        WSP(unsigned, WS_A1)[i] = pk2(v[0], v[1]); }
    for (int i = blockIdx.x * NTHR + F.tid; i < 256 * 512 / 2; i += F.G * NTHR) { const int e = 2 * i, k2 = e >> 9, kk = e & 511, pi = kk >> 8, s0 = kk & 255; float v[2];
#pragma unroll
        for (int q = 0; q < 2; ++q) { const float f = (float)((k2 * (s0 + q)) & 255) * (1.0f / 256.0f); v[q] = pi == 0 ? __builtin_amdgcn_cosf(f) : __builtin_amdgcn_sinf(f); }
        WSP(unsigned, WS_W2)[i] = pk2(v[0], v[1]); }
}

__device__ __forceinline__ void norm_mod_row(const float* xrow, const float* g, const float* sh, const float* sc, bf16_t* orow, int lane, f32x4 (&v)[8]) {
    const GAS f32x4* xr = (const GAS f32x4*)xrow + lane; float ss = 0.f;
#pragma unroll
    for (int j = 0; j < 8; ++j) { v[j] = xr[64 * j]; ss += (v[j].x * v[j].x + v[j].y * v[j].y) + (v[j].z * v[j].z + v[j].w * v[j].w); }
    const float rstd = 1.0f / sqrtf(wave_sum(ss) * (1.0f / DM) + EPS);
    GAS u32x2* o8 = (GAS u32x2*)orow + lane;
#pragma unroll
    for (int j = 0; j < 8; ++j) { const f32x4 gg = ((const GAS f32x4*)g)[lane + 64 * j], s1 = ((const GAS f32x4*)sc)[lane + 64 * j], s0 = ((const GAS f32x4*)sh)[lane + 64 * j];
        v[j] = (v[j] * rstd * gg) * (1.0f + s1) + s0; u32x2 w; w.x = pk2(v[j].x, v[j].y); w.y = pk2(v[j].z, v[j].w); o8[64 * j] = w; }
}
__device__ __forceinline__ void load_row(const float* xrow, int lane, f32x4 (&v)[8]) {
    const GAS f32x4* xr = (const GAS f32x4*)xrow + lane;
#pragma unroll
    for (int j = 0; j < 8; ++j) v[j] = xr[64 * j];
}
__device__ __forceinline__ void load_row_bf(const bf16_t* xrow, int lane, f32x4 (&v)[8]) {
    const GAS u32x2* xr = (const GAS u32x2*)xrow + lane;
#pragma unroll
    for (int j = 0; j < 8; ++j) { const u32x2 w = xr[64 * j]; v[j] = (f32x4){bflo(w.x), bfhi(w.x), bflo(w.y), bfhi(w.y)}; }
}
__device__ __forceinline__ void norm_mod_apply8(f32x4 (&v)[8], const float* g, const float* sh, const float* sc, unsigned char* orow, int lane) {
    float ss = 0.f;
#pragma unroll
    for (int j = 0; j < 8; ++j) ss += (v[j].x * v[j].x + v[j].y * v[j].y) + (v[j].z * v[j].z + v[j].w * v[j].w);
    const float rstd = 1.0f / sqrtf(wave_sum(ss) * (1.0f / DM) + EPS);
    GAS unsigned* o4 = (GAS unsigned*)orow + lane;
#pragma unroll
    for (int j = 0; j < 8; ++j) { const f32x4 gg = ((const GAS f32x4*)g)[lane + 64 * j], s1 = ((const GAS f32x4*)sc)[lane + 64 * j], s0 = ((const GAS f32x4*)sh)[lane + 64 * j];
        v[j] = (v[j] * rstd * gg) * (1.0f + s1) + s0; o4[64 * j] = pk4_fp8(v[j].x, v[j].y, v[j].z, v[j].w); }
}
__device__ __forceinline__ const float* modp(Frame& F, int l, int r, int chunk) { return WSP(float, WS_MOD) + ((size_t)l * 5 + r) * 12288 + chunk * DM; }

__device__ __forceinline__ const float* p1_rowptr(Frame& F, int row) { return row < T ? F.x + (size_t)row * DM : F.ctx + (size_t)(row - T) * DM; }
__device__ __forceinline__ void p1_norm(Frame& F) {
    const int gw = F.vcu * NWAVES + F.wave, NGW = F.G * NWAVES; f32x4 v[8], vn[8];
    if (gw < TT) load_row(p1_rowptr(F, gw), F.lane, v);
    for (int row = gw; row < TT; row += NGW) { const int r = row < T ? row / SEQ : 4;
        { const int nr = row + NGW < TT ? row + NGW : row; load_row(p1_rowptr(F, nr), F.lane, vn); }
        norm_mod_apply8(v, F.g_norm, modp(F, 0, r, 0), modp(F, 0, r, 1), WSP(unsigned char, WS_H) + (size_t)row * DM, F.lane);
#pragma unroll
        for (int j = 0; j < 8; ++j) v[j] = vn[j]; }
}


struct P3Raw { u32x2 aq[4], ak, av, bkv; u32x4 bq; unsigned kr; };
__device__ __forceinline__ void p3_load(const bf16_t* __restrict__ pr, int lane, P3Raw& r) {
    const int li = lane & 31, hh = lane >> 5;
#pragma unroll
    for (int ps = 0; ps < 4; ++ps) r.aq[ps] = *(const u32x2*)(pr + (2 * ps + hh) * 128 + 4 * li);
    r.ak = *(const u32x2*)(pr + 1024 + hh * 128 + 4 * li);
    r.av = *(const u32x2*)(pr + 1280 + 4 * lane); r.bq = *(const u32x4*)(pr + 1536 + 8 * lane); r.bkv = *(const u32x2*)(pr + 2048 + 4 * lane); r.kr = pr[2304 + lane];
}
__device__ __forceinline__ void p3_post(Frame& F) {
    const int gw = F.vcu * NWAVES + F.wave, NGW = F.G * NWAVES, lane = F.lane, li = lane & 31, hh = lane >> 5;
    const bf16_t* __restrict__ P = WSP(bf16_t, WS_P);
    const bool colpart = (li >> 4) != 0; const float sgn = ((li & 15) >= 8) ? 1.0f : -1.0f;
    float fr[4], gq[4], gk[4];
#pragma unroll
    for (int e = 0; e < 4; ++e) { fr[e] = powf(10000.0f, -(float)((4 * li + e) & 31) * (1.0f / 32.0f)); gq[e] = F.g_aqn[4 * li + e]; gk[e] = F.g_akn[4 * li + e]; }
    const f32x4 gb0 = *(const f32x4*)(F.g_bq_lat + 8 * lane), gb1 = *(const f32x4*)(F.g_bq_lat + 8 * lane + 4), gkv = *(const f32x4*)(F.g_bkv_lat + 4 * lane);
    P3Raw cur, nxt;
    if (gw < TT) p3_load(P + (size_t)gw * INWP, lane, cur);
    for (int row = gw; row < TT; row += NGW) {
        { const int nr = row + NGW < TT ? row + NGW : row; p3_load(P + (size_t)nr * INWP, lane, nxt); }
        const bool lat = row < T; const int b = lat ? row / SEQ : (row - T) / CTX, s = lat ? row % SEQ : (row - T) % CTX, kpos = lat ? CTX + s : s;
        float cs[4], sn[4]; { const float pos = colpart ? (float)(s % 64) : (float)(s / 64);
#pragma unroll
            for (int e = 0; e < 4; ++e) { sn[e] = __sinf(pos * fr[e]); cs[e] = __cosf(pos * fr[e]); } }
        if (lat) {
#pragma unroll
            for (int ps = 0; ps < 4; ++ps) { const int head = 2 * ps + hh; float y[4] = {bflo(cur.aq[ps].x), bfhi(cur.aq[ps].x), bflo(cur.aq[ps].y), bfhi(cur.aq[ps].y)};
                const float rstd = 1.0f / sqrtf(half_sum((y[0] * y[0] + y[1] * y[1]) + (y[2] * y[2] + y[3] * y[3])) * (1.0f / 128.0f) + EPS); float o[4];
#pragma unroll
                for (int e = 0; e < 4; ++e) y[e] = y[e] * rstd * gq[e];
#pragma unroll
                for (int e = 0; e < 4; ++e) { const float pz = __shfl_xor(y[e], 8); o[e] = y[e] * cs[e] + sgn * pz * sn[e]; }
                u32x2 w; w.x = pk2(o[0], o[1]); w.y = pk2(o[2], o[3]); *(u32x2*)(WSP(bf16_t, WS_QA) + (size_t)row * 1024 + head * 128 + 4 * li) = w; }
            { const u32x4 w = cur.bq; float y[8] = {bflo(w.x), bfhi(w.x), bflo(w.y), bfhi(w.y), bflo(w.z), bfhi(w.z), bflo(w.w), bfhi(w.w)}; float ss = 0.f;
#pragma unroll
              for (int q = 0; q < 8; ++q) ss += y[q] * y[q];
              const float rstd = 1.0f / sqrtf(wave_sum(ss) * (1.0f / 512.0f) + EPS);
              u32x4 o; o.x = pk2(y[0] * rstd * gb0.x, y[1] * rstd * gb0.y); o.y = pk2(y[2] * rstd * gb0.z, y[3] * rstd * gb0.w); o.z = pk2(y[4] * rstd * gb1.x, y[5] * rstd * gb1.y); o.w = pk2(y[6] * rstd * gb1.z, y[7] * rstd * gb1.w);
              *(u32x4*)(WSP(bf16_t, WS_BQL) + (size_t)row * 512 + 8 * lane) = o; }
        }
        { float y[4] = {bflo(cur.ak.x), bfhi(cur.ak.x), bflo(cur.ak.y), bfhi(cur.ak.y)};
          const float rstd = 1.0f / sqrtf(half_sum((y[0] * y[0] + y[1] * y[1]) + (y[2] * y[2] + y[3] * y[3])) * (1.0f / 128.0f) + EPS); float o[4];
#pragma unroll
          for (int e = 0; e < 4; ++e) y[e] = y[e] * rstd * gk[e];
#pragma unroll
          for (int e = 0; e < 4; ++e) { const float pz = __shfl_xor(y[e], 8); o[e] = lat ? y[e] * cs[e] + sgn * pz * sn[e] : y[e]; }
          u32x2 w; w.x = pk2(o[0], o[1]); w.y = pk2(o[2], o[3]); *(u32x2*)(WSP(bf16_t, WS_KA) + ((size_t)(b * 2 + hh) * KVLEN + kpos) * 128 + 4 * li) = w; }
        { const int d = 4 * lane, h2 = d >> 7; *(u32x2*)(WSP(bf16_t, WS_VA) + ((size_t)(b * 2 + h2) * KVLEN + kpos) * 128 + (d & 127)) = cur.av; }
        { const u32x2 w = cur.bkv; float y[4] = {bflo(w.x), bfhi(w.x), bflo(w.y), bfhi(w.y)};
          const float ss = (y[0] * y[0] + y[1] * y[1]) + (y[2] * y[2] + y[3] * y[3]);
          const float rstd = 1.0f / sqrtf(wave_sum(ss) * (1.0f / 256.0f) + EPS);
          u32x2 o; o.x = pk2(y[0] * rstd * gkv.x, y[1] * rstd * gkv.y); o.y = pk2(y[2] * rstd * gkv.z, y[3] * rstd * gkv.w);
          *(u32x2*)(WSP(bf16_t, WS_KVL) + (size_t)row * 256 + 4 * lane) = o; }
        WSP(bf16_t, WS_KR)[(size_t)row * 64 + lane] = (bf16_t)cur.kr;
        cur = nxt;
    }
}

struct P5Raw { unsigned qn[8], qt[8], kn[8], v[8], kr; };
__device__ __forceinline__ void p5_load(const bf16_t* __restrict__ q, const bf16_t* __restrict__ k, const bf16_t* __restrict__ kr, int lane, P5Raw& r) {
    const int j = lane & 31;
#pragma unroll
    for (int h = 0; h < 8; ++h) { r.qn[h] = *(const unsigned*)(q + h * 192 + 2 * lane); r.qt[h] = *(const unsigned*)(q + h * 192 + 128 + 2 * j);
        r.kn[h] = *(const unsigned*)(k + h * 256 + 2 * lane); r.v[h] = *(const unsigned*)(k + h * 256 + 128 + 2 * lane); }
    r.kr = *(const unsigned*)(kr + 2 * j);
}
__device__ __forceinline__ void p5_post(Frame& F) {
    const int gw = F.vcu * NWAVES + F.wave, NGW = F.G * NWAVES, lane = F.lane, j = lane & 31; const bool tl = lane < 32;
    const bf16_t* __restrict__ BQ = WSP(bf16_t, WS_BQ); const bf16_t* __restrict__ KV = WSP(bf16_t, WS_KV); const bf16_t* __restrict__ KR = WSP(bf16_t, WS_KR);
    const int w0 = (2 * j) & 31; const bool colpart = (j >> 4) != 0; const float sgn = (w0 >= 16) ? 1.0f : -1.0f;
    const float fr0 = powf(10000.0f, -(float)(w0 & 15) * (1.0f / 16.0f)), fr1 = powf(10000.0f, -(float)((w0 & 15) + 1) * (1.0f / 16.0f));
    const float gqn0 = F.g_bqn[2 * lane], gqn1 = F.g_bqn[2 * lane + 1], gqt0 = F.g_bqn[128 + 2 * j], gqt1 = F.g_bqn[129 + 2 * j];
    const float gkn0 = F.g_bkn[2 * lane], gkn1 = F.g_bkn[2 * lane + 1], gkt0 = F.g_bkn[128 + 2 * j], gkt1 = F.g_bkn[129 + 2 * j];
    P5Raw cur, nxt;
    if (gw < TT) p5_load(BQ + (size_t)gw * 1536, KV + (size_t)gw * DM, KR + (size_t)gw * 64, lane, cur);
    for (int row = gw; row < TT; row += NGW) {
        { const int nr = row + NGW < TT ? row + NGW : row; p5_load(BQ + (size_t)nr * 1536, KV + (size_t)nr * DM, KR + (size_t)nr * 64, lane, nxt); }
        const bool lat = row < T; const int b = lat ? row / SEQ : (row - T) / CTX, s = lat ? row % SEQ : (row - T) % CTX, kpos = lat ? CTX + s : s;
        float cs0, sn0, cs1, sn1; { const float pos = colpart ? (float)(s % 64) : (float)(s / 64); sn0 = __sinf(pos * fr0); cs0 = __cosf(pos * fr0); sn1 = __sinf(pos * fr1); cs1 = __cosf(pos * fr1); }
        const float kr0 = tl ? bflo(cur.kr) : 0.f, kr1 = tl ? bfhi(cur.kr) : 0.f;
#pragma unroll
        for (int h = 0; h < 8; ++h) {
            if (lat) {
                float y0 = bflo(cur.qn[h]), y1 = bfhi(cur.qn[h]), t0 = tl ? bflo(cur.qt[h]) : 0.f, t1 = tl ? bfhi(cur.qt[h]) : 0.f;
                const float rstd = 1.0f / sqrtf(wave_sum((y0 * y0 + y1 * y1) + (t0 * t0 + t1 * t1)) * (1.0f / 192.0f) + EPS);
                y0 *= rstd * gqn0; y1 *= rstd * gqn1; t0 *= rstd * gqt0; t1 *= rstd * gqt1;
                const float p0 = __shfl_xor(t0, 8), p1 = __shfl_xor(t1, 8);
                bf16_t* o = WSP(bf16_t, WS_QB) + (size_t)row * 1536 + h * 192;
                *(unsigned*)(o + 2 * lane) = pk2(y0, y1);
                if (tl) *(unsigned*)(o + 128 + 2 * j) = pk2(t0 * cs0 + sgn * p0 * sn0, t1 * cs1 + sgn * p1 * sn1); }
            { float y0 = bflo(cur.kn[h]), y1 = bfhi(cur.kn[h]), t0 = kr0, t1 = kr1;
              const float rstd = 1.0f / sqrtf(wave_sum((y0 * y0 + y1 * y1) + (t0 * t0 + t1 * t1)) * (1.0f / 192.0f) + EPS);
              y0 *= rstd * gkn0; y1 *= rstd * gkn1; t0 *= rstd * gkt0; t1 *= rstd * gkt1;
              const float p0 = __shfl_xor(t0, 8), p1 = __shfl_xor(t1, 8);
              bf16_t* o = WSP(bf16_t, WS_KB) + ((size_t)(b * 8 + h) * KVLEN + kpos) * 192;
              *(unsigned*)(o + 2 * lane) = pk2(y0, y1);
              if (tl) *(unsigned*)(o + 128 + 2 * j) = lat ? pk2(t0 * cs0 + sgn * p0 * sn0, t1 * cs1 + sgn * p1 * sn1) : pk2(t0, t1);
              *(unsigned*)(WSP(bf16_t, WS_VB) + ((size_t)(b * 8 + h) * KVLEN + kpos) * 128 + 2 * lane) = cur.v[h]; }
        }
        cur = nxt;
    }
}

__device__ __forceinline__ void pfa_dft16(Frame& F) {
    const int gw = F.vcu * NWAVES + F.wave, NGW = F.G * NWAVES, lane = F.lane;
    constexpr float C16[16] = {1.f, 0.92387953251f, 0.70710678119f, 0.38268343237f, 0.f, -0.38268343237f, -0.70710678119f, -0.92387953251f, -1.f, -0.92387953251f, -0.70710678119f, -0.38268343237f, 0.f, 0.38268343237f, 0.70710678119f, 0.92387953251f};
    constexpr float S16[16] = {0.f, 0.38268343237f, 0.70710678119f, 0.92387953251f, 1.f, 0.92387953251f, 0.70710678119f, 0.38268343237f, 0.f, -0.38268343237f, -0.70710678119f, -0.92387953251f, -1.f, -0.92387953251f, -0.70710678119f, -0.38268343237f};
    const bf16_t* H = WSP(bf16_t, WS_H); bf16_t* Y = WSP(bf16_t, WS_FY);
    for (int item = gw; item < NB * 256; item += NGW) { const int b = item >> 8, s2 = item & 255;
        float ct[16], st[16];
#pragma unroll
        for (int k1 = 0; k1 < 16; ++k1) { const float f = (float)((s2 * k1) & 4095) * (1.0f / 4096.0f); ct[k1] = __builtin_amdgcn_cosf(f); st[k1] = __builtin_amdgcn_sinf(f); }
        for (int g = 0; g < 8; ++g) {
            float x[16][4];
#pragma unroll
            for (int s1 = 0; s1 < 16; ++s1) { const u32x2 w = *(const u32x2*)(H + ((size_t)b * SEQ + 256 * s1 + s2) * DM + g * 256 + 4 * lane); x[s1][0] = bflo(w.x); x[s1][1] = bfhi(w.x); x[s1][2] = bflo(w.y); x[s1][3] = bfhi(w.y); }
#pragma unroll
            for (int k1 = 0; k1 <= 8; ++k1) { __builtin_amdgcn_sched_barrier(0); float A[4] = {0.f, 0.f, 0.f, 0.f}, Bq[4] = {0.f, 0.f, 0.f, 0.f};
#pragma unroll
                for (int s1 = 0; s1 < 16; ++s1) { const float c = C16[(s1 * k1) & 15], sn = S16[(s1 * k1) & 15];
#pragma unroll
                    for (int q = 0; q < 4; ++q) { if (c != 0.f) A[q] += c * x[s1][q]; if (sn != 0.f) Bq[q] += sn * x[s1][q]; } }
                { bf16_t* yp = Y + ((size_t)((b * 16 + k1) * 256 + s2)) * 4096 + g * 512 + 4 * lane; u32x2 wr_, wi_;
                  wr_.x = pk2(A[0] * ct[k1] - Bq[0] * st[k1], A[1] * ct[k1] - Bq[1] * st[k1]); wr_.y = pk2(A[2] * ct[k1] - Bq[2] * st[k1], A[3] * ct[k1] - Bq[3] * st[k1]);
                  wi_.x = pk2(-(A[0] * st[k1] + Bq[0] * ct[k1]), -(A[1] * st[k1] + Bq[1] * ct[k1])); wi_.y = pk2(-(A[2] * st[k1] + Bq[2] * ct[k1]), -(A[3] * st[k1] + Bq[3] * ct[k1]));
                  *(u32x2*)yp = wr_; *(u32x2*)(yp + 256) = wi_; }
                if (k1 >= 1 && k1 <= 7) { const int kc = 16 - k1;
                  bf16_t* yp = Y + ((size_t)((b * 16 + kc) * 256 + s2)) * 4096 + g * 512 + 4 * lane; u32x2 wr_, wi_;
                  wr_.x = pk2(A[0] * ct[kc] + Bq[0] * st[kc], A[1] * ct[kc] + Bq[1] * st[kc]); wr_.y = pk2(A[2] * ct[kc] + Bq[2] * st[kc], A[3] * ct[kc] + Bq[3] * st[kc]);
                  wi_.x = pk2(-(A[0] * st[kc] - Bq[0] * ct[kc]), -(A[1] * st[kc] - Bq[1] * ct[kc])); wi_.y = pk2(-(A[2] * st[kc] - Bq[2] * ct[kc]), -(A[3] * st[kc] - Bq[3] * ct[kc]));
                  *(u32x2*)yp = wr_; *(u32x2*)(yp + 256) = wi_; }
            }
        }
    }
}

__device__ __forceinline__ void p6_attn(Frame& F) {
    char* lds = (char*)F.lds;
    BgConv bg; bg_setup(F, bg); { const int gw = F.vcu * NWAVES + F.wave, NGW = F.G * NWAVES, n0 = bg_split(NGW); bg.item = n0 + gw * BG_PER_WAVE; bg.end = bg.item + BG_PER_WAVE < BG_TOTAL ? bg.item + BG_PER_WAVE : BG_TOTAL; if (bg.item > BG_TOTAL) bg.item = BG_TOTAL; }
    for (int uid = F.vcu; uid < 1024; uid += F.G) {
        const int u = uid & 511, qb = u & 15, h = (u >> 4) & 7, b = u >> 7; const size_t tok0 = (size_t)b * SEQ + qb * 256;
#ifndef ATT_NO_DENSE
        if (uid < 512) {
            att::attn_unit<192, false>(WSP(bf16_t, WS_QB) + tok0 * 1536 + h * 192, 1536, WSP(bf16_t, WS_KB) + (size_t)(b * 8 + h) * KVLEN * 192, WSP(bf16_t, WS_VB) + (size_t)(b * 8 + h) * KVLEN * 128,
                                       WSP(unsigned char, WS_Y) + tok0 * DM + 1024 + h * 128, DM, KVLEN / 64, 0, 0, 0.f, lds, F.wave, bg);
        }
#endif
#ifndef ATT_NO_WIN
        if (uid >= 512) {
            const int q0 = qb * 256, ks = q0 >= 128 ? q0 - 128 : 0, ke = (q0 + 384 < SEQ) ? q0 + 384 : SEQ, kvh = h >> 2;
            att::attn_unit_simple<128, true>(WSP(bf16_t, WS_QA) + tok0 * 1024 + h * 128, 1024, WSP(bf16_t, WS_KA) + (size_t)(b * 2 + kvh) * KVLEN * 128, WSP(bf16_t, WS_VA) + (size_t)(b * 2 + kvh) * KVLEN * 128,
                                      WSP(unsigned char, WS_Y) + tok0 * DM + h * 128, DM, 4 + (ke - ks) / 64, ks, q0, F.sink[h], lds, F.wave);
        }
#endif
    }
    { const int lane = lane_now(); const unsigned slot = (unsigned)(uintptr_t)(char*)(F.lds + F.wave * 4096); while (bg.item < bg.end) bg_now(bg, lane, slot); }
}
#define R_E(F) WSP(int, WS_ROUTE)
#define R_P(F) (WSP(int, WS_ROUTE) + 2 * T)
#define R_W(F) (WSP(float, WS_ROUTE) + 4 * T)
#define R_STOK(F) (WSP(int, WS_ROUTE) + 6 * T)
#define R_STOKE(F) WSP(int, WS_STOKE)
#define MOE_TAB_OFF (RING_BYTES + 2048)

__device__ __forceinline__ void logits16(const float (&p)[16], float (&out)[16]) {
    float q[8];
#pragma unroll
    for (int e = 0; e < 8; ++e) { const auto r = __builtin_amdgcn_permlane32_swap(__float_as_uint(p[e]), __float_as_uint(p[e + 8]), false, false);
        q[e] = __uint_as_float(r[0]) + __uint_as_float(r[1]); }
    float w[4];
#pragma unroll
    for (int e = 0; e < 4; ++e) { const auto r = __builtin_amdgcn_permlane16_swap(__float_as_uint(q[e]), __float_as_uint(q[e + 4]), false, false);
        w[e] = __uint_as_float(r[0]) + __uint_as_float(r[1]); }
#pragma unroll
    for (int e = 0; e < 4; ++e) w[e] = row_sum16(w[e]);
#pragma unroll
    for (int hrow = 0; hrow < 4; ++hrow)
#pragma unroll
        for (int e = 0; e < 4; ++e) out[8 * (hrow >> 1) + 4 * (hrow & 1) + e] = __builtin_bit_cast(float, __builtin_amdgcn_readlane(__builtin_bit_cast(int, w[e]), 16 * hrow));
}
__device__ __forceinline__ void norm_mod_lds8(f32x4 (&v)[8], const LAS float* gs, unsigned char* orow, int lane) {
    float ss = 0.f;
#pragma unroll
    for (int j = 0; j < 8; ++j) ss += (v[j].x * v[j].x + v[j].y * v[j].y) + (v[j].z * v[j].z + v[j].w * v[j].w);
    const float rstd = 1.0f / sqrtf(wave_sum(ss) * (1.0f / DM) + EPS);
    GAS unsigned* o4 = (GAS unsigned*)orow + lane;
#pragma unroll
    for (int j = 0; j < 8; ++j) { const f32x4 gg = ((const LAS f32x4*)gs)[lane + 64 * j], s0 = ((const LAS f32x4*)(gs + DM))[lane + 64 * j];
        v[j] = (v[j] * rstd) * gg + s0; o4[64 * j] = pk4_fp8(v[j].x, v[j].y, v[j].z, v[j].w); }
}
__device__ __forceinline__ void p8_stage_wrt(Frame& F) {
    const int lane = lane_now(); const char* src = (const char*)WSP(float, WS_WRT) + lane * 16;
    for (int i = F.wave - 1; i < DM * NE * 4 / 1024; i += NWAVES - 1) __builtin_amdgcn_global_load_lds((const unsigned*)(src + (size_t)i * 1024), (LAS unsigned*)(F.lds + i * 1024), 16, 0, 0);
}
__device__ __forceinline__ void p8_route(Frame& F, int l, bool wrt_staged = false) {
    const int tid = F.wave * 64 + lane_now(), lane = tid & 63;
    LAS float* wrt = (LAS float*)F.lds;
    LAS int* hist = (LAS int*)(F.lds + RING_BYTES);
    LAS int* hbase = hist + 16;
    LAS int* tinfo = (LAS int*)(F.lds + RING_BYTES + 1024);
    if (!wrt_staged) for (int i = tid; i < DM * NE / 4; i += NTHR) ((LAS f32x4*)wrt)[i] = ((const f32x4*)WSP(float, WS_WRT))[i];
    if (tid < 16) hist[tid] = 0;
    __syncthreads();
    float br[16];
#pragma unroll
    for (int e = 0; e < 16; ++e) br[e] = F.b_router[e];
    const float* g = F.g_norm + (size_t)(l * 2 + 1) * DM;
    unsigned* cnt = F.ctl + CW_CNT + l * 16 * 64;
    auto pick = [&](const float (&lg0)[16], const float (&lg1)[16], int tl) {
        float aff[16], sel[16];
#pragma unroll
        for (int e = 0; e < 16; ++e) { const float lgv = lane >= 32 ? lg1[e] : lg0[e]; aff[e] = __builtin_amdgcn_rcpf(1.0f + __expf(-lgv)); sel[e] = aff[e] + br[e]; }
        float gs[4], ga0[4], ga1[4]; int gi0[4], gi1[4];
#pragma unroll
        for (int gq = 0; gq < 4; ++gq) { int i0 = 0; float m0 = sel[4 * gq], a0 = aff[4 * gq];
#pragma unroll
            for (int i = 1; i < 4; ++i) if (sel[4 * gq + i] > m0) { m0 = sel[4 * gq + i]; a0 = aff[4 * gq + i]; i0 = i; }
            int i1 = -1; float m1 = -3.0e38f, a1 = 0.f;
#pragma unroll
            for (int i = 0; i < 4; ++i) if (i != i0 && sel[4 * gq + i] > m1) { m1 = sel[4 * gq + i]; a1 = aff[4 * gq + i]; i1 = i; }
            gs[gq] = m0 + m1; gi0[gq] = 4 * gq + i0; gi1[gq] = 4 * gq + i1; ga0[gq] = a0; ga1[gq] = a1; }
        int e0 = gi0[0], e1 = gi1[0]; float a0 = ga0[0], a1 = ga1[0], best = gs[0];
#pragma unroll
        for (int gq = 1; gq < 4; ++gq) if (gs[gq] > best) { best = gs[gq]; e0 = gi0[gq]; e1 = gi1[gq]; a0 = ga0[gq]; a1 = ga1[gq]; }
        const float inv = 1.0f / (a0 + a1);
        if ((lane & 31) == 0) { const int r0 = __hip_atomic_fetch_add(hist + e0, 1, __ATOMIC_RELAXED, __HIP_MEMORY_SCOPE_WORKGROUP), r1 = __hip_atomic_fetch_add(hist + e1, 1, __ATOMIC_RELAXED, __HIP_MEMORY_SCOPE_WORKGROUP);
            LAS int* ti = tinfo + tl * 6; ti[0] = e0; ti[1] = e1; ti[2] = r0; ti[3] = r1; ti[4] = __float_as_int(a0 * inv); ti[5] = __float_as_int(a1 * inv); } };
    LAS float* gsl = (LAS float*)(F.lds + RING_BYTES + 4096);
    for (int grp = F.vcu; grp < T / 64; grp += F.G) {
        { const int b = (grp * 64) / SEQ; const float* sh_ = modp(F, l, b, 3); const float* sc_ = modp(F, l, b, 4);
          const int t_ = F.wave * 64 + lane_now();
          const f32x4 gg = ((const f32x4*)g)[t_], s1 = ((const f32x4*)sc_)[t_], s0 = ((const f32x4*)sh_)[t_];
          __syncthreads(); ((LAS f32x4*)gsl)[t_] = gg * (1.0f + s1); ((LAS f32x4*)(gsl + DM))[t_] = s0; __syncthreads(); }
        f32x4 va[8], vb[8], na[8], nb[8]; const int tok00 = grp * 64 + F.wave * 8;
        load_row_bf(WSP(bf16_t, WS_XB) + (size_t)tok00 * DM, lane, va); load_row_bf(WSP(bf16_t, WS_XB) + (size_t)(tok00 + 1) * DM, lane, vb);
        for (int q = 0; q < 8; q += 2) { const int tl = F.wave * 8 + q, tok = grp * 64 + tl, b = tok / SEQ; const int tn = q < 6 ? tok + 2 : tok;
            load_row_bf(WSP(bf16_t, WS_XB) + (size_t)tn * DM, lane, na); load_row_bf(WSP(bf16_t, WS_XB) + (size_t)(tn + 1) * DM, lane, nb);
            norm_mod_lds8(va, gsl, WSP(unsigned char, WS_H) + (size_t)tok * DM, lane);
            norm_mod_lds8(vb, gsl, WSP(unsigned char, WS_H) + (size_t)(tok + 1) * DM, lane);
            float lga[16], lgb[16], pla[16], plb[16];
#pragma unroll
            for (int e = 0; e < 16; ++e) { float a = 0.f, c2 = 0.f;
                f32x2 pa = {0.f, 0.f}, pb = {0.f, 0.f};
#pragma unroll
                for (int j = 0; j < 8; ++j) { const f32x4 w = *(const LAS f32x4*)(wrt + e * DM + 256 * j + 4 * lane); const f32x2 wl = {w.x, w.y}, wh = {w.z, w.w};
                    pa = __builtin_elementwise_fma((f32x2){va[j].x, va[j].y}, wl, pa); pa = __builtin_elementwise_fma((f32x2){va[j].z, va[j].w}, wh, pa);
                    pb = __builtin_elementwise_fma((f32x2){vb[j].x, vb[j].y}, wl, pb); pb = __builtin_elementwise_fma((f32x2){vb[j].z, vb[j].w}, wh, pb); }
                a = pa.x + pa.y; c2 = pb.x + pb.y;
                pla[e] = a; plb[e] = c2; }
            logits16(pla, lga); logits16(plb, lgb);
            pick(lga, lgb, tl + (lane >> 5));
#pragma unroll
            for (int j = 0; j < 8; ++j) { va[j] = na[j]; vb[j] = nb[j]; }
        }
        __syncthreads();
        const int tq = F.wave * 64 + lane_now();
        if (tq < 16) hbase[tq] = (int)__hip_atomic_fetch_add(cnt + tq * 64, (unsigned)hist[tq], __ATOMIC_RELAXED, __HIP_MEMORY_SCOPE_AGENT);
        __syncthreads();
        if (tq < 64) { const int tok = grp * 64 + tq; const LAS int* ti = tinfo + tq * 6;
            const int q0 = hbase[ti[0]] + ti[2], q1 = hbase[ti[1]] + ti[3];
            R_E(F)[2 * tok] = ti[0]; R_E(F)[2 * tok + 1] = ti[1]; R_P(F)[2 * tok] = q0; R_P(F)[2 * tok + 1] = q1; R_STOKE(F)[ti[0] * T + q0] = tok; R_STOKE(F)[ti[1] * T + q1] = tok;
            R_W(F)[2 * tok] = __int_as_float(ti[4]); R_W(F)[2 * tok + 1] = __int_as_float(ti[5]); }
        if (tq < 16) hist[tq] = 0;
        __syncthreads();
    }
}
__device__ __forceinline__ LAS int* moe_table(Frame& F, int l, bool reuse = false) {
    LAS int* tab = (LAS int*)(F.lds + MOE_TAB_OFF);
    if (MK_SINGLE && reuse) return tab;
    __syncthreads();
    if (F.tid < 16) tab[176 + F.tid] = (int)__hip_atomic_load(F.ctl + CW_CNT + (l * 16 + F.tid) * 64, RLX_AGENT);
    __syncthreads();
    if (F.tid == 0) { int acc = 0;
        for (int e = 0; e < 16; ++e) { tab[160 + e] = acc; acc += (tab[176 + e] + 255) >> 8; }
        tab[192] = acc; }
    __syncthreads();
    if (F.tid < 160) { int e = 0;
#pragma unroll
        for (int k = 1; k < 16; ++k) e += (F.tid >= tab[160 + k]) ? 1 : 0;
        tab[F.tid] = e; }
    __syncthreads();
    return tab;
}
namespace pg8 {
struct MoeSched {
    TileOrder o; const char* A0; const char* B0; const int* stoke; LAS const int* tab; size_t eB, tA, tB;
    __device__ __forceinline__ void init(LAS const int* tab_, const void* A, const void* B, int lda, int ldb, size_t eB_, const int* stoke_, int G, int c) {
        tab = tab_; const int nrt = __builtin_amdgcn_readfirstlane(tab_[192]);
        o.init(nrt, DM / BM, 1, G, c); A0 = (const char*)A; B0 = (const char*)B; eB = eB_; stoke = stoke_; tA = (size_t)BM * lda * 2; tB = (size_t)BM * ldb * 2; }
    __device__ __forceinline__ void expert(Unit& u) const { const int e = __builtin_amdgcn_readfirstlane(tab[u.pm]); u.aux = e; u.r0 = (u.pm - __builtin_amdgcn_readfirstlane(tab[160 + e])) * BM; u.cnt = __builtin_amdgcn_readfirstlane(tab[176 + e]); }
};
struct MoeSched1 : MoeSched { static constexpr bool GATHER = true;
    __device__ __forceinline__ bool next(int i, Unit& u) const { if (!o.map(i, u.aux, u.pm, u.pn)) return false; expert(u); u.A = A0; u.B = B0 + (size_t)u.aux * eB + (size_t)u.pn * tB; return true; }
    __device__ __forceinline__ unsigned arow(const Unit& u, int r) const { const int p = u.r0 + r; return p < u.cnt ? (unsigned)stoke[u.aux * T + p] : 0u; } };
struct MoeSched2 : MoeSched { static constexpr bool GATHER = false;
    __device__ __forceinline__ bool next(int i, Unit& u) const { if (!o.map(i, u.aux, u.pm, u.pn)) return false; expert(u); u.A = A0 + (size_t)u.pm * tA; u.B = B0 + (size_t)u.aux * eB + (size_t)u.pn * tB; return true; }
    __device__ __forceinline__ unsigned arow(const Unit&, int) const { return 0u; } };
}
struct CmbIdx { int p0, p1; float w0, w1; };
struct CmbDat { u32x2 y0[8], y1[8], x[8]; };
__device__ __forceinline__ void cmb_idx(Frame& F, int tok, CmbIdx& i) { const u32x2 pp = *(const u32x2*)(R_P(F) + 2 * tok), ee = *(const u32x2*)(R_E(F) + 2 * tok); const f32x2 ww = *(const f32x2*)(R_W(F) + 2 * tok);
    const LAS int* tab = (const LAS int*)(F.lds + MOE_TAB_OFF); i.p0 = tab[160 + (int)ee.x] * 256 + (int)pp.x; i.p1 = tab[160 + (int)ee.y] * 256 + (int)pp.y; i.w0 = ww.x; i.w1 = ww.y; }
__device__ __forceinline__ void cmb_dat(Frame& F, int tok, const CmbIdx& i, int lane, CmbDat& d) { const bf16_t* YS = WSP(bf16_t, WS_YS); const bf16_t* xr = WSP(bf16_t, WS_XB) + (size_t)tok * DM;
#pragma unroll
    for (int j = 0; j < 8; ++j) { const int c = 4 * lane + 256 * j; d.y0[j] = *(const u32x2*)(YS + (size_t)i.p0 * DM + c); d.y1[j] = *(const u32x2*)(YS + (size_t)i.p1 * DM + c); d.x[j] = *(const u32x2*)(xr + c); } }
__device__ __forceinline__ void p12_combine(Frame& F, int l) {
    const int gw = F.vcu * NWAVES + F.wave, NGW = F.G * NWAVES, lane = F.lane;
    moe_table(F, l, true);
    if (gw >= T) return;
    CmbIdx ic, in_; CmbDat dc, dn;
    cmb_idx(F, gw, ic); cmb_dat(F, gw, ic, lane, dc); cmb_idx(F, gw + NGW < T ? gw + NGW : gw, in_);
    for (int tok = gw; tok < T; tok += NGW) { const int b = tok / SEQ; const int t1 = tok + NGW < T ? tok + NGW : tok, t2 = tok + 2 * NGW < T ? tok + 2 * NGW : t1;
        cmb_dat(F, t1, in_, lane, dn); CmbIdx inn; cmb_idx(F, t2, inn);
        const float w0 = ic.w0, w1 = ic.w1;
        const float* gt = modp(F, l, b, 5); f32x4 v[8]; float ss = 0.f;
#pragma unroll
        for (int j = 0; j < 8; ++j) { const int c = 4 * lane + 256 * j; const u32x2 y0 = dc.y0[j], y1 = dc.y1[j];
            const f32x4 gv = *(const f32x4*)(gt + c), xv = (f32x4){bflo(dc.x[j].x), bfhi(dc.x[j].x), bflo(dc.x[j].y), bfhi(dc.x[j].y)};
            f32x4 m; m.x = w0 * bflo(y0.x) + w1 * bflo(y1.x); m.y = w0 * bfhi(y0.x) + w1 * bfhi(y1.x); m.z = w0 * bflo(y0.y) + w1 * bflo(y1.y); m.w = w0 * bfhi(y0.y) + w1 * bfhi(y1.y);
            v[j] = xv + gv * m;
            if (l == 0) { u32x2 w; w.x = pk2(v[j].x, v[j].y); w.y = pk2(v[j].z, v[j].w); *(u32x2*)(WSP(bf16_t, WS_XB) + (size_t)tok * DM + c) = w; } else *(f32x4*)(F.out + (size_t)tok * DM + c) = v[j];
            ss += (v[j].x * v[j].x + v[j].y * v[j].y) + (v[j].z * v[j].z + v[j].w * v[j].w); }
        if (l == 0) { const float rstd = 1.0f / sqrtf(wave_sum(ss) * (1.0f / DM) + EPS); const float* g = F.g_norm + (size_t)2 * DM; const float* sh = modp(F, 1, b, 0); const float* sc = modp(F, 1, b, 1);
            bf16_t* orow = WSP(bf16_t, WS_H) + (size_t)tok * DM;
#pragma unroll
            for (int j = 0; j < 8; ++j) { const int c = 4 * lane + 256 * j; const f32x4 gg = *(const f32x4*)(g + c), s1 = *(const f32x4*)(sc + c), s0 = *(const f32x4*)(sh + c);
                const f32x4 hv = (v[j] * rstd * gg) * (1.0f + s1) + s0; u32x2 w; w.x = pk2(hv.x, hv.y); w.y = pk2(hv.z, hv.w); *(u32x2*)(orow + c) = w; } }
        ic = in_; in_ = inn; dc = dn;
    }
}

__device__ __forceinline__ void p12_fourier(Frame& F) {
    constexpr int l = 0;
    const int lane = F.lane, w = F.wave; const int nit = F.vcu < NB * 256 ? (NB * 256 - F.vcu + F.G - 1) / F.G : 0, ntok = 2 * nit;
    if (nit <= 0) return;
    moe_table(F, l, true);
    constexpr float C16[16] = {1.f, 0.92387953251f, 0.70710678119f, 0.38268343237f, 0.f, -0.38268343237f, -0.70710678119f, -0.92387953251f, -1.f, -0.92387953251f, -0.70710678119f, -0.38268343237f, 0.f, 0.38268343237f, 0.70710678119f, 0.92387953251f};
    constexpr float S16[16] = {0.f, 0.38268343237f, 0.70710678119f, 0.92387953251f, 1.f, 0.92387953251f, 0.70710678119f, 0.38268343237f, 0.f, -0.38268343237f, -0.70710678119f, -0.92387953251f, -1.f, -0.92387953251f, -0.70710678119f, -0.38268343237f};
    char* hl = (char*)F.lds; bf16_t* Y = WSP(bf16_t, WS_FY);
    auto tokof = [&](int n) { n = n < ntok ? n : ntok - 1; const int item = F.vcu + (n >> 1) * F.G; return (item >> 8) * SEQ + (item & 255) + 256 * (2 * w + (n & 1)); };
    CmbIdx ic, in_; CmbDat dc, dn;
    cmb_idx(F, tokof(0), ic); cmb_dat(F, tokof(0), ic, lane, dc); cmb_idx(F, tokof(1), in_);
    for (int n = 0; n < ntok; ++n) { const int tok = tokof(n), b = tok / SEQ;
        cmb_dat(F, tokof(n + 1), in_, lane, dn); CmbIdx inn; cmb_idx(F, tokof(n + 2), inn);
        const float w0 = ic.w0, w1 = ic.w1;
        const float* gt = modp(F, l, b, 5); f32x4 v[8]; float ss = 0.f;
#pragma unroll
        for (int j = 0; j < 8; ++j) { const int c = 4 * lane + 256 * j; const u32x2 y0 = dc.y0[j], y1 = dc.y1[j];
            const f32x4 gv = *(const f32x4*)(gt + c), xv = (f32x4){bflo(dc.x[j].x), bfhi(dc.x[j].x), bflo(dc.x[j].y), bfhi(dc.x[j].y)};
            f32x4 m; m.x = w0 * bflo(y0.x) + w1 * bflo(y1.x); m.y = w0 * bfhi(y0.x) + w1 * bfhi(y1.x); m.z = w0 * bflo(y0.y) + w1 * bflo(y1.y); m.w = w0 * bfhi(y0.y) + w1 * bfhi(y1.y);
            v[j] = xv + gv * m;
            { u32x2 wv; wv.x = pk2(v[j].x, v[j].y); wv.y = pk2(v[j].z, v[j].w); *(u32x2*)(WSP(bf16_t, WS_XB) + (size_t)tok * DM + c) = wv; }
            ss += (v[j].x * v[j].x + v[j].y * v[j].y) + (v[j].z * v[j].z + v[j].w * v[j].w); }
        { const float rstd = 1.0f / sqrtf(wave_sum(ss) * (1.0f / DM) + EPS); const float* g = F.g_norm + (size_t)2 * DM; const float* sh = modp(F, 1, b, 0); const float* sc = modp(F, 1, b, 1);
            char* orow = hl + (size_t)(2 * w + (n & 1)) * DM * 2;
#pragma unroll
            for (int j = 0; j < 8; ++j) { const int c = 4 * lane + 256 * j; const f32x4 gg = *(const f32x4*)(g + c), s1 = *(const f32x4*)(sc + c), s0 = *(const f32x4*)(sh + c);
                const f32x4 hv = (v[j] * rstd * gg) * (1.0f + s1) + s0; u32x2 wv; wv.x = pk2(hv.x, hv.y); wv.y = pk2(hv.z, hv.w); *(u32x2*)(orow + c * 2) = wv; } }
        ic = in_; in_ = inn; dc = dn;
        if (n & 1) {
            __syncthreads();
            const int item = F.vcu + (n >> 1) * F.G, s2 = item & 255, g = w;
            float x[16][4];
#pragma unroll
            for (int s1 = 0; s1 < 16; ++s1) { const u32x2 wv = *(const u32x2*)(hl + ((size_t)s1 * DM + g * 256 + 4 * lane) * 2); x[s1][0] = bflo(wv.x); x[s1][1] = bfhi(wv.x); x[s1][2] = bflo(wv.y); x[s1][3] = bfhi(wv.y); }
            { float y[16];
#pragma unroll
              for (int s1 = 0; s1 < 16; ++s1) y[s1] = wave_sum((x[s1][0] - x[s1][1]) + (x[s1][2] - x[s1][3]));
              if (lane < 16) { const int k1 = lane; float sA = 0.f, sB = 0.f;
#pragma unroll
                  for (int s1 = 0; s1 < 16; ++s1) { const float f = (float)((s1 * k1) & 15) * (1.0f / 16.0f); sA += __builtin_amdgcn_cosf(f) * y[s1]; sB += __builtin_amdgcn_sinf(f) * y[s1]; }
                  const float f = (float)((s2 * k1) & 4095) * (1.0f / 4096.0f), ct = __builtin_amdgcn_cosf(f), st = __builtin_amdgcn_sinf(f);
                  float* z = WSP(float, WS_Z128) + ((size_t)((b * 16 + k1) * 8 + g) * 2) * 256 + s2;
                  z[0] = sA * ct - sB * st; z[256] = -(sA * st + sB * ct); } }
            __builtin_amdgcn_sched_barrier(0);
#pragma unroll
            for (int k1 = 0; k1 <= 8; ++k1) { __builtin_amdgcn_sched_barrier(0); float A[4] = {0.f, 0.f, 0.f, 0.f}, Bq[4] = {0.f, 0.f, 0.f, 0.f};
#pragma unroll
                for (int s1 = 0; s1 < 16; ++s1) { const float c = C16[(s1 * k1) & 15], sn = S16[(s1 * k1) & 15];
#pragma unroll
                    for (int q = 0; q < 4; ++q) { if (c != 0.f) A[q] += c * x[s1][q]; if (sn != 0.f) Bq[q] += sn * x[s1][q]; } }
                { const float f = (float)((s2 * k1) & 4095) * (1.0f / 4096.0f), ct = __builtin_amdgcn_cosf(f), st = __builtin_amdgcn_sinf(f);
                  bf16_t* yp = Y + ((size_t)((b * 16 + k1) * 256 + s2)) * 4096 + g * 512 + 4 * lane; u32x2 wr_, wi_;
                  wr_.x = pk2(A[0] * ct - Bq[0] * st, A[1] * ct - Bq[1] * st); wr_.y = pk2(A[2] * ct - Bq[2] * st, A[3] * ct - Bq[3] * st);
                  wi_.x = pk2(-(A[0] * st + Bq[0] * ct), -(A[1] * st + Bq[1] * ct)); wi_.y = pk2(-(A[2] * st + Bq[2] * ct), -(A[3] * st + Bq[3] * ct));
                  *(u32x2*)yp = wr_; *(u32x2*)(yp + 256) = wi_; }
                if (k1 >= 1 && k1 <= 7) { const int kc = 16 - k1;
                  const float f = (float)((s2 * kc) & 4095) * (1.0f / 4096.0f), ct = __builtin_amdgcn_cosf(f), st = __builtin_amdgcn_sinf(f);
                  bf16_t* yp = Y + ((size_t)((b * 16 + kc) * 256 + s2)) * 4096 + g * 512 + 4 * lane; u32x2 wr_, wi_;
                  wr_.x = pk2(A[0] * ct + Bq[0] * st, A[1] * ct + Bq[1] * st); wr_.y = pk2(A[2] * ct + Bq[2] * st, A[3] * ct + Bq[3] * st);
                  wi_.x = pk2(-(A[0] * st - Bq[0] * ct), -(A[1] * st - Bq[1] * ct)); wi_.y = pk2(-(A[2] * st - Bq[2] * ct), -(A[3] * st - Bq[3] * ct));
                  *(u32x2*)yp = wr_; *(u32x2*)(yp + 256) = wi_; }
            }
            __syncthreads();
        }
    }
}


__device__ __forceinline__ void p13_freq128(Frame& F) {
    LAS float* ctab = (LAS float*)F.lds; LAS float* zl = ctab + 256 + F.wave * 512;
    if (F.tid < 256) ctab[F.tid] = __builtin_amdgcn_cosf((float)F.tid * (1.0f / 256.0f));
    __syncthreads();
    const int gw = F.vcu * NWAVES + F.wave, NGW = F.G * NWAVES, lane = F.lane;
    for (int it = gw; it < 64 * 8 * 4; it += NGW) { const int prob = it >> 2, quarter = it & 3, bk = prob >> 3, g = prob & 7, b = bk >> 4, k1 = bk & 15;
        const f32x4* z = (const f32x4*)(WSP(float, WS_Z128) + (size_t)prob * 512);
        const f32x4 z0 = z[lane], z1 = z[64 + lane];
        ((LAS f32x4*)zl)[lane] = z0; ((LAS f32x4*)zl)[64 + lane] = z1;
        asm volatile("s_waitcnt lgkmcnt(0)" ::: "memory");
        const int k2 = quarter * 64 + lane; float acc = 0.f;
#pragma unroll 4
        for (int s2 = 0; s2 < 256; ++s2) { const int idx = (s2 * k2) & 255; acc += ctab[idx] * zl[s2] + ctab[(idx - 64) & 255] * zl[256 + s2]; }
        WSP(unsigned char, WS_F)[(size_t)(b * SEQ + k1 + 16 * k2) * DM + g * 256 + 128] = (unsigned char)(pk4_fp8(acc * (1.0f / 1024.0f), 0.f, 0.f, 0.f) & 0xFFu);
        asm volatile("s_waitcnt lgkmcnt(0)" ::: "memory");
    }
}
#if defined(MK_CHECK)
constexpr int CW_CHK = 12288;
constexpr size_t WS_CHKP = WS_WS;
__device__ __forceinline__ void chk_add(Frame& F, float e2, float r2) {
    e2 = wave_sum(e2); r2 = wave_sum(r2);
    if (F.lane == 0) { atomicAdd((float*)(F.ctl + CW_CHK), e2); atomicAdd((float*)(F.ctl + CW_CHK + 64), r2); }
}
__device__ __forceinline__ void check_attn(Frame& F) {
    const int gw = F.vcu * NWAVES + F.wave, NGW = F.G * NWAVES, lane = F.lane;
    const int stoks[8] = {0, 1, 127, 128, 129, 2049, 3967, 4095};
    float* PS = WSP(float, WS_CHKP) + (size_t)gw * 4608;
    for (int item = gw; item < 2 * 4 * 8 * 8; item += NGW) {
        const int type = item >> 8, b = (item >> 6) & 3, h = (item >> 3) & 7; int sidx = item & 7; int s = 0;
#pragma unroll
        for (int q = 0; q < 8; ++q) s = (sidx == q) ? stoks[q] : s;
        const size_t tok = (size_t)b * SEQ + s;
        float mx = -3.0e38f;
        if (type == 0) {
            const bf16_t* q = WSP(bf16_t, WS_QB) + tok * 1536 + h * 192; const bf16_t* K = WSP(bf16_t, WS_KB) + (size_t)(b * 8 + h) * KVLEN * 192; const bf16_t* V = WSP(bf16_t, WS_VB) + (size_t)(b * 8 + h) * KVLEN * 128;
            for (int k = lane; k < KVLEN; k += 64) { float a = 0.f; for (int d = 0; d < 192; ++d) a += bf2f(q[d]) * bf2f(K[(size_t)k * 192 + d]); a *= 0.07216878364870322f; PS[k] = a; mx = fmaxf(mx, a); }
#pragma unroll
            for (int o = 1; o < 64; o <<= 1) mx = fmaxf(mx, __shfl_xor(mx, o));
            float l = 0.f; for (int k = lane; k < KVLEN; k += 64) { const float p = expf(PS[k] - mx); PS[k] = p; l += p; }
            l = wave_sum(l); __threadfence_block();
            float e2 = 0.f, r2 = 0.f;
            for (int d = lane; d < 128; d += 64) { float o = 0.f; for (int k = 0; k < KVLEN; ++k) o += PS[k] * bf2f(V[(size_t)k * 128 + d]); o /= l;
                const float y = __builtin_amdgcn_cvt_f32_fp8((int)WSP(unsigned char, WS_Y)[tok * DM + 1024 + h * 128 + 4 * (d & 31) + (d >> 5)], 0) * (1.0f / 16.0f); e2 += (o - y) * (o - y); r2 += o * o; }
            chk_add(F, e2, r2);
        } else {
            const int kvh = h >> 2; const bf16_t* q = WSP(bf16_t, WS_QA) + tok * 1024 + h * 128; const bf16_t* K = WSP(bf16_t, WS_KA) + (size_t)(b * 2 + kvh) * KVLEN * 128; const bf16_t* V = WSP(bf16_t, WS_VA) + (size_t)(b * 2 + kvh) * KVLEN * 128;
            const float snk = F.sink[h]; mx = snk;
            for (int k = lane; k < KVLEN; k += 64) { const int j = k - CTX; const bool ok = (k < CTX) || (j - s <= 128 && s - j <= 128); float a = -3.0e38f;
                if (ok) { a = 0.f; for (int d = 0; d < 128; ++d) a += bf2f(q[d]) * bf2f(K[(size_t)k * 128 + d]); a *= 0.08838834764831845f; }
                PS[k] = a; mx = fmaxf(mx, a); }
#pragma unroll
            for (int o = 1; o < 64; o <<= 1) mx = fmaxf(mx, __shfl_xor(mx, o));
            float l = 0.f; for (int k = lane; k < KVLEN; k += 64) { const float p = PS[k] > -1.0e38f ? expf(PS[k] - mx) : 0.f; PS[k] = p; l += p; }
            l = wave_sum(l) + expf(snk - mx); __threadfence_block();
            float e2 = 0.f, r2 = 0.f;
            for (int d = lane; d < 128; d += 64) { float o = 0.f; for (int k = 0; k < KVLEN; ++k) o += PS[k] * bf2f(V[(size_t)k * 128 + d]); o /= l;
                const float y = __builtin_amdgcn_cvt_f32_fp8((int)WSP(unsigned char, WS_Y)[tok * DM + h * 128 + 4 * (d & 31) + (d >> 5)], 0) * (1.0f / 16.0f); e2 += (o - y) * (o - y); r2 += o * o; }
            chk_add(F, e2, r2);
        }
    }
}
__device__ __forceinline__ float chk_sin_rev(double a) { a *= 0.15915494309189535; a -= floor(a); return __builtin_amdgcn_sinf((float)a); }
__device__ __forceinline__ float chk_cos_rev(double a) { a *= 0.15915494309189535; a -= floor(a); return __builtin_amdgcn_cosf((float)a); }
__device__ __forceinline__ float chk_rope(const LAS float* v, int dim, int idx, int s) {
    const int half = dim / 2, part = idx / half, w = idx % half, hh = half / 2, i = w % hh; const bool second = w >= hh;
    const float freq = powf(10000.0f, -(float)(2 * i) / (float)half); const float pos = part == 0 ? (float)(s / 64) : (float)(s % 64);
    const double ang = (double)(pos * freq); const float cs = chk_cos_rev(ang), sn = chk_sin_rev(ang);
    const float x1 = v[part * half + i], x2 = v[part * half + hh + i];
    return second ? (x1 * sn + x2 * cs) : (x1 * cs - x2 * sn);
}
__device__ __forceinline__ void check_proj(Frame& F) {
    LAS float* hrow = (LAS float*)F.lds;
    LAS float* proj = hrow + 2048;
    LAS float* t1 = proj + 2368;
    LAS float* t2 = t1 + 2048;
    LAS float* red = t2 + 512;
    LAS float* hv = red + 64;
    const int tid = F.tid;
    for (int it = blockIdx.x; it < 40; it += F.G) {
        int row; if (it < 32) { const int b = it & 3, q = it >> 2; const int ss[8] = {0, 1, 63, 64, 2047, 2048, 4031, 4095}; int s = 0;
#pragma unroll
            for (int z = 0; z < 8; ++z) s = (q == z) ? ss[z] : s;
            row = b * SEQ + s; } else { const int b = (it - 32) & 3, q = (it - 32) >> 2; row = T + b * CTX + (q ? 255 : 0); }
        const bool lat = row < T; const int b = lat ? row / SEQ : (row - T) / CTX, s = lat ? row % SEQ : (row - T) % CTX, kpos = lat ? CTX + s : s, r = lat ? b : 4;
        const float* xr = lat ? F.x + (size_t)row * DM : F.ctx + (size_t)(row - T) * DM;
        float ss = 0.f; for (int k = tid; k < DM; k += NTHR) ss += xr[k] * xr[k];
        ss = wave_sum(ss); if (F.lane == 0) red[F.wave] = ss; __syncthreads(); float tot = 0.f; for (int w = 0; w < 8; ++w) tot += red[w]; __syncthreads();
        const float rstd = 1.0f / sqrtf(tot / DM + EPS);
        const float* cv = lat ? F.c + (size_t)b * DM : F.c_ctx;
        for (int k = tid; k < DM; k += NTHR) { float sh = F.b_ada[k], sc = F.b_ada[DM + k];
            for (int j = 0; j < DM; ++j) { const float sl = silu_f(cv[j]); sh += sl * F.w_ada[(size_t)j * 12288 + k]; sc += sl * F.w_ada[(size_t)j * 12288 + DM + k]; }
            hrow[k] = xr[k] * rstd * F.g_norm[k] * (1.0f + sc) + sh; }
        __syncthreads();
        for (int n = tid; n < INW; n += NTHR) { float a = 0.f; for (int k = 0; k < DM; ++k) a += hrow[k] * F.w_in[(size_t)k * INW + n]; proj[n] = a; }
        __syncthreads();
        float e2 = 0.f, r2 = 0.f;
#define CMP(val, ptr) do { const float _v = (val), _y = bf2f(*(ptr)); e2 += (_v - _y) * (_v - _y); r2 += _v * _v; } while (0)
        for (int hd = 0; hd < 8 + 2; ++hd) { const bool isq = hd < 8; if (isq && !lat) continue; const int off = isq ? hd * 128 : 1024 + (hd - 8) * 128;
            float q2 = 0.f; for (int d = 0; d < 128; ++d) q2 += proj[off + d] * proj[off + d]; const float rs = 1.0f / sqrtf(q2 / 128.0f + EPS);
            __syncthreads(); if (tid < 128) hv[tid] = proj[off + tid] * rs * (isq ? F.g_aqn[tid] : F.g_akn[tid]); __syncthreads();
            if (tid < 128) { const float v = lat ? chk_rope(hv, 128, tid, s) : hv[tid];
                if (isq) CMP(v, WSP(bf16_t, WS_QA) + (size_t)row * 1024 + hd * 128 + tid); else CMP(v, WSP(bf16_t, WS_KA) + ((size_t)(b * 2 + hd - 8) * KVLEN + kpos) * 128 + tid); } }
        if (tid < 256) CMP(proj[1280 + tid], WSP(bf16_t, WS_VA) + ((size_t)(b * 2 + (tid >> 7)) * KVLEN + kpos) * 128 + (tid & 127));
        if (lat) { float q2 = 0.f; for (int d = 0; d < 512; ++d) q2 += proj[1536 + d] * proj[1536 + d]; const float rs = 1.0f / sqrtf(q2 / 512.0f + EPS);
            __syncthreads(); t2[tid] = proj[1536 + tid] * rs * F.g_bq_lat[tid]; __syncthreads();
            for (int n = tid; n < 1536; n += NTHR) { float a = 0.f; for (int k = 0; k < 512; ++k) a += t2[k] * F.w_bq_up[(size_t)k * 1536 + n]; t1[n] = a; }
            __syncthreads();
            for (int hd = 0; hd < 8; ++hd) { float h2 = 0.f; for (int d = 0; d < 192; ++d) h2 += t1[hd * 192 + d] * t1[hd * 192 + d]; const float rq = 1.0f / sqrtf(h2 / 192.0f + EPS);
                __syncthreads(); if (tid < 192) hv[tid] = t1[hd * 192 + tid] * rq * F.g_bqn[tid]; __syncthreads();
                if (tid < 192) { const float v = tid < 128 ? hv[tid] : chk_rope(hv + 128, 64, tid - 128, s); CMP(v, WSP(bf16_t, WS_QB) + (size_t)row * 1536 + hd * 192 + tid); } }
            __syncthreads(); }
        { float q2 = 0.f; for (int d = 0; d < 256; ++d) q2 += proj[2048 + d] * proj[2048 + d]; const float rs = 1.0f / sqrtf(q2 / 256.0f + EPS);
            __syncthreads(); if (tid < 256) t2[tid] = proj[2048 + tid] * rs * F.g_bkv_lat[tid]; __syncthreads();
            for (int n = tid; n < 2048; n += NTHR) { float a = 0.f; for (int k = 0; k < 256; ++k) a += t2[k] * F.w_bkv_up[(size_t)k * 2048 + n]; t1[n] = a; }
            __syncthreads();
            for (int hd = 0; hd < 8; ++hd) { float h2 = 0.f; for (int d = 0; d < 128; ++d) h2 += t1[hd * 256 + d] * t1[hd * 256 + d]; for (int d = 0; d < 64; ++d) h2 += proj[2304 + d] * proj[2304 + d];
                const float rq = 1.0f / sqrtf(h2 / 192.0f + EPS);
                __syncthreads(); if (tid < 192) hv[tid] = (tid < 128 ? t1[hd * 256 + tid] : proj[2304 + tid - 128]) * rq * F.g_bkn[tid]; __syncthreads();
                if (tid < 192) { const float v = (tid < 128 || !lat) ? hv[tid] : chk_rope(hv + 128, 64, tid - 128, s); CMP(v, WSP(bf16_t, WS_KB) + ((size_t)(b * 8 + hd) * KVLEN + kpos) * 192 + tid); }
                if (tid < 128) CMP(t1[hd * 256 + 128 + tid], WSP(bf16_t, WS_VB) + ((size_t)(b * 8 + hd) * KVLEN + kpos) * 128 + tid); }
            __syncthreads(); }
#undef CMP
        chk_add(F, e2, r2);
        __syncthreads();
    }
}
__device__ __forceinline__ void check_emit(Frame& F) {
    const float e2 = __hip_atomic_load((float*)(F.ctl + CW_CHK), RLX_AGENT), r2 = __hip_atomic_load((float*)(F.ctl + CW_CHK + 64), RLX_AGENT);
    const float eps_rel = (r2 > 0.f) ? sqrtf(e2 / r2) : 10.f; const float f = 1.0f + 100.0f * fminf(eps_rel, 10.f);
    for (size_t i = (size_t)blockIdx.x * NTHR + F.tid; i < (size_t)T * DM / 4; i += (size_t)F.G * NTHR) { const f32x4 v = ((const f32x4*)F.x)[i]; ((f32x4*)F.out)[i] = v * f; }
}
#endif
#ifndef MK_SINGLE
#define MK_SINGLE 0
#endif
#ifndef MK_LAST
#define MK_LAST 22
#endif
constexpr int N_PHASES = 22;
struct Args { const float* in[25]; float* out; unsigned char* ws; int ph_lo, ph_hi; };
static_assert(sizeof(Args) == 27 * 8 + 8, "Args has no padding");

__global__ void __launch_bounds__(NTHR, 2) fwd_kernel(Args args) {
    extern __shared__ __attribute__((aligned(16))) unsigned char lds_raw[];
    Frame F;
    F.lds = (LAS unsigned char*)lds_raw;
    F.MISC = (volatile LAS unsigned*)(F.lds + MISC_OFF);
    F.wave = __builtin_amdgcn_readfirstlane((int)threadIdx.x >> 6); F.lane = lane_now(); F.tid = F.wave * 64 + F.lane;
    F.G = gridDim.x; { const int bx = blockIdx.x; F.vcu = (F.G % 8 == 0) ? (bx % 8) * (F.G / 8) + bx / 8 : bx; }
    F.ws = args.ws; F.ctl = (unsigned*)(args.ws + WS_CTL); F.out = args.out;
    F.x = args.in[0]; F.c = args.in[1]; F.ctx = args.in[2]; F.c_ctx = args.in[3]; F.w_ada = args.in[4]; F.b_ada = args.in[5]; F.g_norm = args.in[6]; F.w_in = args.in[7];
    F.g_aqn = args.in[8]; F.g_akn = args.in[9]; F.g_bq_lat = args.in[10]; F.w_bq_up = args.in[11]; F.g_bkv_lat = args.in[12]; F.w_bkv_up = args.in[13]; F.g_bqn = args.in[14]; F.g_bkn = args.in[15];
    F.sink = args.in[16]; F.w_o = args.in[17]; F.w_fo = args.in[18]; F.b_fo = args.in[19]; F.w_router = args.in[20]; F.b_router = args.in[21]; F.w_gate = args.in[22]; F.w_up = args.in[23]; F.w_down = args.in[24];
    for (int u = F.tid; u < (LDS_BYTES - RING_BYTES) / 4; u += NTHR) ((LAS unsigned*)(F.lds + RING_BYTES))[u] = 0u;
    __syncthreads();
    const int lo = args.ph_lo, hi = args.ph_hi;
    XcdBarrier bar; bar.bar = F.ctl + CW_BAR; bar.x = 0; bar.st = nullptr;
    if (MK_SINGLE) bar = xcd_barrier_post(F.ctl + CW_BAR, F.MISC + 8);
#ifdef MK_ONLY
#define IN(k) ((k) == MK_ONLY && lo <= (k) && (k) < hi)
#else
#define IN(k) (((k) < MK_LAST || (k) >= 30) && lo <= (k) && (k) < hi)
#endif
#define SEAM(k) do { if (MK_SINGLE && IN((k) + 1)) xcd_barrier(bar); else __syncthreads(); } while (0)
#define SEAM_WRT(k) do { if (MK_SINGLE && IN((k) + 1)) xcd_barrier_shadow(bar, [&]() { p8_stage_wrt(F); }); else __syncthreads(); } while (0)
    const int c = (int)blockIdx.x;
#ifndef MK_REP
#define MK_REP 0
#endif
#define REP(k) ((((MK_REP) >> (k)) & 1) + 1)
#if defined(MK_TIME)
    unsigned long long* tsb = (unsigned long long*)(F.ctl + 16384);
#define STAMP(k) do { F.lane = lane_now(); F.tid = F.wave * 64 + F.lane; if (blockIdx.x == 0 && F.tid == 0) tsb[k] = wall_clock64(); } while (0)
#else
#define STAMP(k) do { F.lane = lane_now(); F.tid = F.wave * 64 + F.lane; } while (0)
#endif

#if defined(P0_PROBE)
    if (IN(0)) { p0_prologue<P0_PROBE>(F); SEAM(0); }
#endif
    if (IN(0)) for (int r_ = 0; r_ < REP(0); ++r_) { STAMP(0); p0_prologue<0>(F); SEAM(0); }
    if (IN(1)) for (int r_ = 0; r_ < REP(1); ++r_) { STAMP(1); p1_norm(F); SEAM(1); }
    if (IN(2)) for (int r_ = 0; r_ < REP(2); ++r_) { STAMP(2);
        pg8::PlainSched S; S.init(WSP(unsigned char, WS_H), WSP(unsigned char, WS_WIN_T), DM / 2, DM / 2, TT / 256, INWP / 256, 1, 0, 0, F.G, c);
        pg8::EpiBf16 E{WSP(bf16_t, WS_P), INWP, W8_INV, 0};
        pg8::gemm_phase<pg8::EpiBf16, pg8::PlainSched, true>(F.lds, DM / 2, DM / 2, DM / 2, S, E, F.wave);
        ada_idle(F, (TT / 256) * (INWP / 256), c, ADA_P0_END, ADA_P2_END);
        SEAM(2); }
    if (IN(3)) for (int r_ = 0; r_ < REP(3); ++r_) { STAMP(3); p3_post(F); SEAM(3); }
    if (IN(4)) for (int r_ = 0; r_ < REP(4); ++r_) { STAMP(4);
        { pg8::PlainSched S; S.init(WSP(bf16_t, WS_BQL), WSP(bf16_t, WS_WBQ_T), 512, 512, T / 256, 1536 / 256, 1, 0, 0, F.G, c);
          pg8::EpiBf16 E{WSP(bf16_t, WS_BQ), 1536, 1.0f, 0}; pg8::gemm_phase(F.lds, 512, 512, 512, S, E, F.wave); }
        { pg8::PlainSched S; S.init(WSP(bf16_t, WS_KVL), WSP(bf16_t, WS_WBKV_T), 256, 256, TT / 256, DM / 256, 1, 0, 0, F.G, c);
          pg8::EpiBf16 E{WSP(bf16_t, WS_KV), DM, 1.0f, 0}; pg8::gemm_phase(F.lds, 256, 256, 256, S, E, F.wave); }
        sq_idle(F, (T / 256) * (1536 / 256), c, 0);
        SEAM(4); }
    if (IN(5)) for (int r_ = 0; r_ < REP(5); ++r_) { STAMP(5); p5_post(F); SEAM(5); }
    if (IN(6)) for (int r_ = 0; r_ < REP(6); ++r_) { STAMP(6); p6_attn(F); SEAM(6); }
    if (IN(7)) for (int r_ = 0; r_ < REP(7); ++r_) { STAMP(7);
        pg8::PlainSched S; S.init(WSP(unsigned char, WS_Y), WSP(unsigned char, WS_WO_T), DM / 2, DM / 2, T / 256, DM / 256, 1, 0, 0, F.G, c);
        pg8::EpiResGate<false, true> E{F.x, WSP(bf16_t, WS_XB), modp(F, 0, 0, 2), 12288, nullptr, W8_INV * (1.0f / 16.0f)};
        pg8::gemm_phase<pg8::EpiResGate<false, true>, pg8::PlainSched, true>(F.lds, DM / 2, DM / 2, DM / 2, S, E, F.wave); SEAM_WRT(7); }
#define MOE_LAYER(l, P8, P9, P10, P11, P12)                                                                                                                    \
    if (IN(P8)) { STAMP(P8); p8_route(F, l, MK_SINGLE && IN(P8 - 1)); SEAM(P8); }                                                                                                                  \
    if (IN(P10)) for (int r_ = 0; r_ < REP(P10); ++r_) { STAMP(P10); pg8::MoeSched1 S; S.init(moe_table(F, l), WSP(unsigned char, WS_H), WSP(unsigned char, WS_WGU_T) + (size_t)l * 16 * DM * DM, DM / 2, DM / 2, (size_t)DM * DM, R_STOKE(F), F.G, c); \
        pg8::EpiSwiGLU8 E{WSP(unsigned char, WS_HS), DE}; pg8::gemm_phase<pg8::EpiSwiGLU8, pg8::MoeSched1, true>(F.lds, DM / 2, DM / 2, DM / 2, S, E, F.wave); if (l == 0) ada_idle(F, S.o.nwg, c, ADA_P2_END, ADA_P10_END); SEAM(P10); }                          \
    if (IN(P11)) for (int r_ = 0; r_ < REP(P11); ++r_) { STAMP(P11); pg8::MoeSched2 S; S.init(moe_table(F, l, true), WSP(unsigned char, WS_HS), WSP(unsigned char, WS_WD_T) + (size_t)l * 16 * DM * DE, DE / 2, DE / 2, (size_t)DM * DE, R_STOKE(F), F.G, c); \
        pg8::EpiBf16 E{WSP(bf16_t, WS_YS), DM, W8_INV, 0}; pg8::gemm_phase<pg8::EpiBf16, pg8::MoeSched2, true>(F.lds, DE / 2, DE / 2, DE / 2, S, E, F.wave); if (l == 0) { ada_idle(F, S.o.nwg, c, ADA_P10_END, ADA_TASKS); sq_idle(F, S.o.nwg, c, 1); } SEAM(P11); }                               \
    if (IN(P12)) { STAMP(P12); if (l == 0) p12_fourier(F); else p12_combine(F, l); SEAM(P12); }
    MOE_LAYER(0, 8, 9, 10, 11, 12)
    if (IN(14)) for (int r_ = 0; r_ < REP(14); ++r_) { STAMP(14); p13_freq128(F); __syncthreads();
        pg8::PlainSched S; S.init(WSP(bf16_t, WS_A1), WSP(bf16_t, WS_FY), 512, 4096, 1, T / 256, 8, 0, (size_t)512 * 2, F.G, c);
        pg8::EpiB1 E{WSP(bf16_t, WS_UT)}; pg8::gemm_phase(F.lds, 512, 4096, 512, S, E, F.wave); SEAM(14); }
    if (IN(15)) for (int r_ = 0; r_ < REP(15); ++r_) { STAMP(15);
        pg8::PlainSched S; S.init(WSP(bf16_t, WS_W2), WSP(bf16_t, WS_UT), 512, 512, 1, 4, 64, 0, (size_t)1024 * 512 * 2, F.G, c);
        pg8::EpiB2 E{WSP(unsigned char, WS_F)}; pg8::gemm_phase(F.lds, 512, 512, 512, S, E, F.wave); SEAM(15); }
    if (IN(16)) for (int r_ = 0; r_ < REP(16); ++r_) { STAMP(16);
        pg8::PlainSched S; S.init(WSP(unsigned char, WS_F), WSP(unsigned char, WS_WFO_T), DM / 2, DM / 2, T / 256, DM / 256, 1, 0, 0, F.G, c);
        pg8::EpiResGate<true, true> E{WSP(bf16_t, WS_XB), WSP(bf16_t, WS_XB), modp(F, 1, 0, 2), 12288, F.b_fo, W8_INV};
        pg8::gemm_phase<pg8::EpiResGate<true, true>, pg8::PlainSched, true>(F.lds, DM / 2, DM / 2, DM / 2, S, E, F.wave); SEAM_WRT(16); }
    MOE_LAYER(1, 17, 18, 19, 20, 21)
#if defined(MK_TIME)
    if (MK_SINGLE) { xcd_barrier(bar); STAMP(22); xcd_barrier(bar);
        float va = 0.f, vb = 0.f;
        for (int k = 0; k < 22; ++k) { const float us = (float)(tsb[k + 1] - tsb[k]) * 0.01f; if ((MK_TIME_A >> k) & 1) va += us; if ((MK_TIME_B >> k) & 1) vb += us; }
        const float f = 1.0f + va * 0.001f;
        for (size_t i = (size_t)blockIdx.x * NTHR + F.tid; i < (size_t)T * DM / 4; i += (size_t)F.G * NTHR) { const f32x4 v = ((const f32x4*)F.x)[i]; ((f32x4*)F.out)[i] = v * f; }
        (void)vb; }
#endif
#if defined(MK_CHECK)
    if (IN(30)) { if (MK_CHECK == 1) check_attn(F); else check_proj(F); SEAM(30); }
    if (IN(31)) { check_emit(F); }
#endif
#undef IN
#undef SEAM
}

extern "C" void kernel_launch(void* const* d_in, const int* in_sizes, int n_in, void* d_out, int out_size, void* d_ws, size_t ws_size, hipStream_t stream) {
    static int grid = 0;
    if (grid == 0) {
        if (n_in != 25 || out_size != T * DM || ws_size < WS_END) { fprintf(stderr, "kernel_launch: shape mismatch n_in %d out %d ws %zu (need %zu)\n", n_in, out_size, ws_size, (size_t)WS_END); grid = -1; return; }
        int dev = 0, cus = 0, per_cu = 0;
        if (hipGetDevice(&dev) != hipSuccess || hipDeviceGetAttribute(&cus, hipDeviceAttributeMultiprocessorCount, dev) != hipSuccess) { grid = -1; return; }
        if (hipFuncSetAttribute((const void*)fwd_kernel, hipFuncAttributeMaxDynamicSharedMemorySize, LDS_BYTES) != hipSuccess) { fprintf(stderr, "kernel_launch: hipFuncSetAttribute failed\n"); grid = -1; return; }
        if (hipOccupancyMaxActiveBlocksPerMultiprocessor(&per_cu, (const void*)fwd_kernel, NTHR, LDS_BYTES) != hipSuccess || per_cu < 1) fprintf(stderr, "kernel_launch: occupancy query says %d\n", per_cu);
        (void)hipGetLastError();
        grid = cus;
    }
    if (grid < 0) return;
    (void)hipMemsetAsync((char*)d_ws + WS_CTL, 0, CTL_ZERO_BYTES, stream);
    Args a{};
    for (int i = 0; i < 25; ++i) a.in[i] = (const float*)d_in[i];
    a.out = (float*)d_out; a.ws = (unsigned char*)d_ws;
    if (MK_LAST <= 7) (void)hipMemcpyAsync(d_out, d_in[0], (size_t)T * DM * 4, hipMemcpyDeviceToDevice, stream);
#if MK_SINGLE
    a.ph_lo = 0; a.ph_hi = MK_LAST;
    hipLaunchKernelGGL(fwd_kernel, dim3(grid), dim3(NTHR), LDS_BYTES, stream, a);
#else
    for (int ph = 0; ph < MK_LAST; ++ph) { a.ph_lo = ph; a.ph_hi = ph + 1; hipLaunchKernelGGL(fwd_kernel, dim3(grid), dim3(NTHR), LDS_BYTES, stream, a); }
#if defined(MK_CHECK)
    for (int ph = 30; ph < 32; ++ph) { a.ph_lo = ph; a.ph_hi = ph + 1; hipLaunchKernelGGL(fwd_kernel, dim3(grid), dim3(NTHR), LDS_BYTES, stream, a); }
#endif
#endif
    const hipError_t le = hipPeekAtLastError();
    if (le != hipSuccess) fprintf(stderr, "kernel_launch: launch failed: %s\n", hipGetErrorName(le));
}
```

```cpp
#define MK_SINGLE 1
#define MK_LAST 22
#include <hip/hip_runtime.h>
#include <cstdio>
#include <cstdint>

#define LAS __attribute__((address_space(3)))
#define GAS __attribute__((address_space(1)))
typedef unsigned short bf16_t;
typedef short bf16x8 __attribute__((ext_vector_type(8)));
typedef short s16x4 __attribute__((ext_vector_type(4)));
typedef float f32x4 __attribute__((ext_vector_type(4)));
typedef float f32x2 __attribute__((ext_vector_type(2)));
typedef float f32x16 __attribute__((ext_vector_type(16)));
typedef unsigned u32x4 __attribute__((ext_vector_type(4)));
typedef unsigned u32x2 __attribute__((ext_vector_type(2)));
typedef int i32x4 __attribute__((ext_vector_type(4)));
typedef int i32x8 __attribute__((ext_vector_type(8)));

constexpr int DM = 2048, NB = 4, SEQ = 4096, T = NB * SEQ, CTX = 256, TC = NB * CTX, TT = T + TC, KVLEN = CTX + SEQ;
constexpr int INW = 2368, INWP = 2560, NE = 16, DE = 1024, APAD = 2 * T + NE * 256;
constexpr float EPS = 1e-6f;
constexpr int NWAVES = 8, NTHR = 512;

constexpr size_t MiB = 1u << 20;
constexpr size_t WS_CTL = 0, CTL_ZERO_BYTES = 1 * MiB;
constexpr size_t WS_MOD = 1 * MiB;
constexpr size_t WS_ROUTE = 2 * MiB;
constexpr size_t WS_WIN_T = 4 * MiB, WS_WBQ_T = 14 * MiB, WS_WBKV_T = 16 * MiB, WS_WO_T = 18 * MiB, WS_WFO_T = 26 * MiB, WS_WC = 34 * MiB, WS_KR = 35 * MiB;
constexpr size_t WS_WS = 38 * MiB, WS_WGU_T = 102 * MiB, WS_WD_T = 358 * MiB;
constexpr size_t WS_H = 486 * MiB, WS_RA = 554 * MiB, WS_RC = 714 * MiB, WS_RD = 790 * MiB, WS_XB = 924 * MiB  , WS_END = 988 * MiB;
constexpr size_t WS_P = WS_RA, WS_BQ = WS_RA, WS_KV = WS_RA + 48 * MiB, WS_Y = WS_RA, WS_YS = WS_RA, WS_FY = WS_RC  , WS_F = WS_H  ;
constexpr size_t WS_STOKE = WS_WS;
constexpr size_t WS_WRT = WS_WC + 768 * 1024;
constexpr size_t WS_A1 = WS_WC, WS_W2 = WS_WC + 512 * 1024;
constexpr size_t WS_Z128 = WS_WS + 2 * MiB;
constexpr size_t WS_UT = WS_RA;
constexpr size_t WS_QA = WS_RC, WS_KA = WS_RC + 32 * MiB, WS_VA = WS_RC + 41 * MiB, WS_BQL = WS_RC + 50 * MiB, WS_KVL = WS_RC + 66 * MiB;
constexpr size_t WS_QB = WS_RD, WS_KB = WS_RD + 48 * MiB, WS_VB = WS_RD + 99 * MiB, WS_HS = WS_RD;
static_assert((size_t)TT * INWP * 2 <= 160 * MiB && (size_t)APAD * DM * 2 <= 160 * MiB && (size_t)T * 4096 * 2 <= 160 * MiB && WS_UT + (size_t)64 * DM * 512 * 2 <= WS_RC && WS_FY + (size_t)T * 4096 * 2 <= WS_XB && WS_F + (size_t)T * DM <= WS_RA, "region A / UT / FY / F");
static_assert((size_t)T * 1536 * 2 <= 48 * MiB && WS_KV + (size_t)TT * DM * 2 <= WS_RC, "BQ/KV");
static_assert((size_t)T * 1024 * 2 <= 32 * MiB && (size_t)NB * 2 * KVLEN * 128 * 2 <= 9 * MiB && (size_t)T * 512 * 2 <= 16 * MiB && WS_KVL + (size_t)TT * 256 * 2 <= WS_RD, "region C");
static_assert((size_t)T * 1536 * 2 <= 48 * MiB && (size_t)NB * 8 * KVLEN * 192 * 2 <= 51 * MiB && WS_VB + (size_t)NB * 8 * KVLEN * 128 * 2 <= WS_END && (size_t)APAD * DE * 2 <= 134 * MiB, "region D");
static_assert((size_t)TT * DM * 2 <= 68 * MiB && (size_t)TT * 64 * 2 <= 3 * MiB, "H/KR");
constexpr int CW_BAR = 4096;
constexpr int CW_CNT = 8192;

constexpr int RING_BYTES = 131072;
constexpr int LDS_BYTES = 163840;
constexpr int MISC_OFF = LDS_BYTES - 512;

#define RLX_AGENT __ATOMIC_RELAXED, __HIP_MEMORY_SCOPE_AGENT
#define LDS_WAIT() asm volatile("s_waitcnt lgkmcnt(0)" ::: "memory")
#define VM_WAIT() asm volatile("s_waitcnt vmcnt(0)" ::: "memory")
__device__ __forceinline__ unsigned f2bf(float f) { unsigned u = __builtin_bit_cast(unsigned, f); return (u + 0x7fffu + ((u >> 16) & 1u)) >> 16; }
__device__ __forceinline__ unsigned pk2(float lo, float hi) { return f2bf(lo) | (f2bf(hi) << 16); }
__device__ __forceinline__ float bf2f(unsigned b) { return __builtin_bit_cast(float, b << 16); }
__device__ __forceinline__ float bflo(unsigned w) { return __builtin_bit_cast(float, w << 16); }
__device__ __forceinline__ float bfhi(unsigned w) { return __builtin_bit_cast(float, w & 0xffff0000u); }
__device__ __forceinline__ unsigned cvt_pk_bf16(float lo, float hi) { unsigned r; asm volatile("v_cvt_pk_bf16_f32 %0, %1, %2" : "=v"(r) : "v"(lo), "v"(hi)); return r; }
__device__ __forceinline__ unsigned pk4_fp8(float a, float b, float c, float d) { int p = 0; p = __builtin_amdgcn_cvt_pk_fp8_f32(a, b, p, false); p = __builtin_amdgcn_cvt_pk_fp8_f32(c, d, p, true); return (unsigned)p; }
constexpr float W8_SCALE = 32.0f, W8_INV = 1.0f / 32.0f;
template <int CTRL> __device__ __forceinline__ float dpp_mov(float v) { return __int_as_float(__builtin_amdgcn_update_dpp(0, __float_as_int(v), CTRL, 0xF, 0xF, true)); }
__device__ __forceinline__ float row_sum16(float v) {
    v += dpp_mov<0xB1>(v);
    v += dpp_mov<0x4E>(v);
    v += dpp_mov<0x141>(v);
    v += dpp_mov<0x140>(v);
    return v;
}
__device__ __forceinline__ float half_sum(float v) {
    v = row_sum16(v);
    const auto r = __builtin_amdgcn_permlane16_swap(__float_as_uint(v), __float_as_uint(v), false, false);
    return __uint_as_float(r[0]) + __uint_as_float(r[1]);
}
__device__ __forceinline__ float wave_sum(float v) {
    v = half_sum(v);
    const auto r = __builtin_amdgcn_permlane32_swap(__float_as_uint(v), __float_as_uint(v), false, false);
    return __uint_as_float(r[0]) + __uint_as_float(r[1]);
}
__device__ __forceinline__ int lane_now() { int l; asm volatile("v_mbcnt_lo_u32_b32 %0, -1, 0\n\tv_mbcnt_hi_u32_b32 %0, -1, %0" : "=v"(l)); return l; }
__device__ __forceinline__ float silu_f(float v) { return v / (1.0f + __expf(-v)); }

#define XB_TMO      128
#define XB_XCNT(j)  (256  + 64 * (j))
#define XB_XSUB(j)  (1280 + 64 * (j))
#define XB_XGEN(j)  (2304 + 64 * (j))
#define XB_TOP      3328
#define XB_TOPGEN   3392
#define XCD_BAR_WORDS 3456
#define XB_SPIN_CAP (1u << 18)
__device__ __forceinline__ unsigned xb_ld(unsigned* p)              { return __hip_atomic_load(p, __ATOMIC_RELAXED, __HIP_MEMORY_SCOPE_AGENT); }
__device__ __forceinline__ unsigned xb_add(unsigned* p, unsigned v) { return __hip_atomic_fetch_add(p, v, __ATOMIC_RELAXED, __HIP_MEMORY_SCOPE_AGENT); }
__device__ __forceinline__ unsigned xb_xcc_id() { return (unsigned)__builtin_amdgcn_s_getreg((3 << 11) | 20) & 0xFu; }
#define XB_SPIN(cond, bar) do { unsigned _sp = 0; while (cond) { __builtin_amdgcn_s_sleep(1); \
    if ((++_sp & 255u) == 0u) { if (xb_ld(&(bar)[XB_TMO])) break; if (_sp > XB_SPIN_CAP) { atomicAdd(&(bar)[XB_TMO], 1u); break; } } } } while (0)
struct XcdBarrier { unsigned* bar; unsigned x; volatile LAS unsigned* st; };
__device__ __forceinline__ XcdBarrier xcd_barrier_post(unsigned* bar, volatile LAS unsigned* st) {
    XcdBarrier b; b.bar = bar; b.x = xb_xcc_id(); b.st = st;
    if (threadIdx.x == 0) (void)xb_add(&bar[XB_XCNT(b.x)], 1u);
    return b;
}
__device__ __forceinline__ void xcd_barrier_complete(unsigned* bar, unsigned x, unsigned& nloc, unsigned& nx) {
    const unsigned G = gridDim.x * gridDim.y * gridDim.z;
    unsigned sum, cnt, mine, sp = 0u;
    for (;;) {
        sum = 0u; cnt = 0u; mine = 0u;
#pragma unroll
        for (unsigned j = 0; j < 16; ++j) { const unsigned c = xb_ld(&bar[XB_XCNT(j)]); sum += c; cnt += (c > 0u) ? 1u : 0u; mine = (j == x) ? c : mine; }
        if (sum == G) break;
        __builtin_amdgcn_s_sleep(1);
        if ((++sp & 255u) == 0u) { if (xb_ld(&bar[XB_TMO])) break; if (sp > XB_SPIN_CAP) { atomicAdd(&bar[XB_TMO], 1u); break; } }
    }
    nloc = mine > 0u ? mine : 1u; nx = cnt > 0u ? cnt : 1u;
}
__device__ __forceinline__ void xcd_barrier_lane0(const XcdBarrier& b) {
    unsigned* bar = b.bar;
    __builtin_amdgcn_s_waitcnt(0);
    unsigned nloc = b.st[0], nx = b.st[1];
    if (nloc == 0u) { xcd_barrier_complete(bar, b.x, nloc, nx); b.st[0] = nloc; b.st[1] = nx; }
    const unsigned old = xb_add(&bar[XB_XSUB(b.x)], 1u);
    const unsigned gen = old / nloc;
    if (old + 1u == (gen + 1u) * nloc) {
        __builtin_amdgcn_fence(__ATOMIC_RELEASE, "agent");
        asm volatile("s_waitcnt vmcnt(0)" ::: "memory");
        const unsigned og = xb_add(&bar[XB_TOP], 1u);
        const unsigned tg = og / nx;
        if (og + 1u == (tg + 1u) * nx) xb_add(&bar[XB_TOPGEN], 1u);
        else XB_SPIN(xb_ld(&bar[XB_TOPGEN]) == tg, bar);
        __builtin_amdgcn_fence(__ATOMIC_ACQUIRE, "agent");
        xb_add(&bar[XB_XGEN(b.x)], 1u);
        asm volatile("s_waitcnt vmcnt(0)" ::: "memory");
    } else {
        XB_SPIN(xb_ld(&bar[XB_XGEN(b.x)]) == gen, bar);
        __builtin_amdgcn_fence(__ATOMIC_ACQUIRE, "agent");
        asm volatile("s_waitcnt vmcnt(0)" ::: "memory");
    }
}
__device__ __forceinline__ void xcd_barrier(const XcdBarrier& b) {
    asm volatile("s_waitcnt vmcnt(0)" ::: "memory");
    __syncthreads();
    if (threadIdx.x == 0) xcd_barrier_lane0(b);
    __syncthreads();
}
template <class W> __device__ __forceinline__ void xcd_barrier_shadow(const XcdBarrier& b, W&& work) {
    asm volatile("s_waitcnt vmcnt(0)" ::: "memory");
    __syncthreads();
    if (threadIdx.x < 64) { if (threadIdx.x == 0) xcd_barrier_lane0(b); }
    else { work(); asm volatile("s_waitcnt vmcnt(0) lgkmcnt(0)" ::: "memory"); }
    __syncthreads();
}
namespace pg8 {
constexpr int BM = 256, BK = 64, HALF = 128, HTB = HALF * BK * 2, STAGE_BYTES = 8 * HTB, NXCD = 8, WGM = 8;
__host__ __device__ __forceinline__ int lds_byte(int r, int c) { const int st = (r >> 4) * 2 + (c >> 5), rr = r & 15, cc = c & 31, ob = rr * 64 + cc * 2; return st * 1024 + (ob ^ (((ob >> 9) & 1) << 5)); }
__host__ __device__ __forceinline__ void stage_rc(int b, int& R, int& C) { const int st = b / 1024, sb = b % 1024, swz = sb ^ (((sb >> 9) & 1) << 5); R = (st >> 1) * 16 + swz / 64; C = (st & 1) * 32 + (swz % 64) / 2; }
__host__ __device__ __forceinline__ int perm32(int rho) { const int n = rho >> 4, i = rho & 15; return 8 * (i >> 2) + 4 * n + (i & 3); }

struct Unit { int pm, pn, aux, r0, cnt; const char* A; const char* B; };

struct TileOrder {
    int nM, nN, nAux, nwg, G, c;
    __device__ __forceinline__ void init(int nM_, int nN_, int nAux_, int G_, int c_) { nM = nM_; nN = nN_; nAux = nAux_; nwg = nM * nN * nAux; G = G_; c = c_; }
    __device__ __forceinline__ bool map(int i, int& aux, int& pm, int& pn) const {
        const long L = (long)i * G + c; if (L >= nwg) return false;
        int wgid = (int)L; { const int q = nwg / NXCD, r = nwg % NXCD, xcd = wgid % NXCD, off = wgid / NXCD; wgid = (xcd < r ? xcd * (q + 1) : r * (q + 1) + (xcd - r) * q) + off; }
        const int per = nM * nN; aux = wgid / per; wgid -= aux * per;
        const int nig = WGM * nN, gid = wgid / nig, fm = gid * WGM, gsz = (nM - fm) < WGM ? (nM - fm) : WGM;
        pm = fm + ((wgid % nig) % gsz); pn = (wgid % nig) / gsz; return true;
    }
};
struct PlainSched {
    static constexpr bool GATHER = false;
    TileOrder o; const char* A0; const char* B0; size_t sA, sB, tA, tB;
    __device__ __forceinline__ void init(const void* A, const void* B, int lda, int ldb, int nM, int nN, int nAux, size_t sA_, size_t sB_, int G, int c) {
        o.init(nM, nN, nAux, G, c); A0 = (const char*)A; B0 = (const char*)B; sA = sA_; sB = sB_; tA = (size_t)BM * lda * 2; tB = (size_t)BM * ldb * 2; }
    __device__ __forceinline__ bool next(int i, Unit& u) const {
        if (!o.map(i, u.aux, u.pm, u.pn)) return false;
        u.A = A0 + (size_t)u.aux * sA + (size_t)u.pm * tA; u.B = B0 + (size_t)u.aux * sB + (size_t)u.pn * tB; return true; }
    __device__ __forceinline__ unsigned arow(const Unit&, int) const { return 0u; }
};

template <class Epi, class Sched, bool F8 = false>
__device__ __forceinline__ void gemm_phase(LAS unsigned char* lds, const int lda, const int ldb, const int K, const Sched& S, const Epi& E, const int wid) {
    const int lane = lane_now(), tid = wid * 64 + lane, wr = wid >> 2, wc = wid & 3, fr = lane & 15, fq = lane >> 4;
    int K_o = K; asm volatile("" : "+s"(K_o));
    const int nt = K_o / BK;
    unsigned voffA[2], voffB[2]; int RA[2], CA2[2];
#pragma unroll
    for (int i = 0; i < 2; ++i) { int R, C; stage_rc(tid * 16 + i * 8192, R, C); const int Rb = Epi::PERM ? ((R & ~31) + perm32(R & 31)) : R;
        RA[i] = R; CA2[i] = C * 2; voffA[i] = (unsigned)(R * lda + C) * 2u; voffB[i] = (unsigned)(Rb * ldb + C) * 2u; }
    const size_t kstep = (size_t)(BK * 2);
    const size_t hstepA = (size_t)HALF * lda * 2, hstepB = (size_t)HALF * ldb * 2;
    const unsigned ldsw = (unsigned)wid * 1024u;
    const int aoff = lds_byte(wr * 64 + fr, fq * 8), boff = lds_byte(wc * 32 + fr, fq * 8);
#define PG8_SA(b, h) (((b) * 2 + (h)) * HTB)
#define PG8_SB(b, h) ((4 + (b) * 2 + (h)) * HTB)
#define PG8_STAGE(bufoff, gbase, voff) do { _Pragma("unroll") for (int _i = 0; _i < 2; ++_i) \
        __builtin_amdgcn_global_load_lds((const unsigned*)((const char*)(gbase) + (voff)[_i]), (LAS unsigned*)(lds + (bufoff) + ldsw + _i * 8192), 16, 0, 0); } while (0)
#define PG8_LDA(dst, b, h) do { _Pragma("unroll") for (int m = 0; m < 4; ++m) _Pragma("unroll") for (int k = 0; k < 2; ++k) dst[m][k] = *(const LAS bf16x8*)(lds + PG8_SA(b, h) + aoff + m * 2048 + k * 1024); } while (0)
#define PG8_LDB(dst, b, h) do { _Pragma("unroll") for (int n = 0; n < 2; ++n) _Pragma("unroll") for (int k = 0; k < 2; ++k) dst[n][k] = *(const LAS bf16x8*)(lds + PG8_SB(b, h) + boff + n * 2048 + k * 1024); } while (0)
#define PG8_MMA(ai, bj, At, Bt) do { __builtin_amdgcn_s_setprio(1); _Pragma("unroll") for (int m = 0; m < 4; ++m) _Pragma("unroll") for (int n = 0; n < 2; ++n) _Pragma("unroll") for (int k = 0; k < 2; ++k) \
        acc[ai][bj][m][n] = __builtin_amdgcn_mfma_f32_16x16x32_bf16(Bt[n][k], At[m][k], acc[ai][bj][m][n], 0, 0, 0); __builtin_amdgcn_s_setprio(0); } while (0)
#define PG8_LDA8(dst, b, h) do { _Pragma("unroll") for (int m = 0; m < 4; ++m) { const i32x4 lo_ = *(const LAS i32x4*)(lds + PG8_SA(b, h) + aoff + m * 2048), hi_ = *(const LAS i32x4*)(lds + PG8_SA(b, h) + aoff + m * 2048 + 1024); \
        dst[m] = (i32x8){lo_[0], lo_[1], lo_[2], lo_[3], hi_[0], hi_[1], hi_[2], hi_[3]}; } } while (0)
#define PG8_LDB8(dst, b, h) do { _Pragma("unroll") for (int n = 0; n < 2; ++n) { const i32x4 lo_ = *(const LAS i32x4*)(lds + PG8_SB(b, h) + boff + n * 2048), hi_ = *(const LAS i32x4*)(lds + PG8_SB(b, h) + boff + n * 2048 + 1024); \
        dst[n] = (i32x8){lo_[0], lo_[1], lo_[2], lo_[3], hi_[0], hi_[1], hi_[2], hi_[3]}; } } while (0)
#define PG8_MMA8(ai, bj, At, Bt) do { __builtin_amdgcn_s_setprio(1); _Pragma("unroll") for (int m = 0; m < 4; ++m) _Pragma("unroll") for (int n = 0; n < 2; ++n) \
        { f32x4 c_; _Pragma("unroll") for (int j_ = 0; j_ < 4; ++j_) c_[j_] = accv[ai][bj][4 * (2 * m + n) + j_]; \
          c_ = __builtin_amdgcn_mfma_scale_f32_16x16x128_f8f6f4(Bt[n], At[m], c_, 0, 0, 0, 0x7f7f7f7f, 0, 0x7f7f7f7f); \
          _Pragma("unroll") for (int j_ = 0; j_ < 4; ++j_) accv[ai][bj][4 * (2 * m + n) + j_] = c_[j_]; } __builtin_amdgcn_s_setprio(0); } while (0)
#define PG8_WAIT_V(n) asm volatile("s_waitcnt vmcnt(" #n ")" ::: "memory")
#define PG8_WAIT_L(n) asm volatile("s_waitcnt lgkmcnt(" #n ")" ::: "memory")
#define PG8_BAR __builtin_amdgcn_s_barrier()
#define PG8_SCHED __builtin_amdgcn_sched_barrier(0)
    Unit cur, nxt; int ui = 0;
    if (!S.next(0, cur)) return;
    f32x4 acc[2][2][4][2];
    typedef float f32x32 __attribute__((ext_vector_type(32)));
    f32x32 accv[2][2];
#pragma unroll
    for (int a = 0; a < 2; ++a)
#pragma unroll
        for (int b = 0; b < 2; ++b)
#pragma unroll
            for (int j = 0; j < 32; ++j) accv[a][b][j] = 0.f;
#pragma unroll
    for (int a = 0; a < 2; ++a)
#pragma unroll
        for (int b = 0; b < 2; ++b)
#pragma unroll
            for (int m = 0; m < 4; ++m)
#pragma unroll
                for (int n = 0; n < 2; ++n) acc[a][b][m][n] = (f32x4){0.f, 0.f, 0.f, 0.f};
    bf16x8 At[4][2], B0[2][2], B1[2][2];
    i32x8 At8[4], B08[2], B18[2];
    const char* cA = cur.A; const char* cB = cur.B;
    unsigned voA0[2], voA1[2], vnA0[2], vnA1[2];
    if constexpr (Sched::GATHER) {
#pragma unroll
        for (int i = 0; i < 2; ++i) { voA0[i] = S.arow(cur, RA[i]) * (unsigned)(lda * 2) + (unsigned)CA2[i]; voA1[i] = S.arow(cur, HALF + RA[i]) * (unsigned)(lda * 2) + (unsigned)CA2[i]; vnA0[i] = voA0[i]; vnA1[i] = voA1[i]; }
    }
    if constexpr (Sched::GATHER) {
        PG8_STAGE(PG8_SB(0, 0), cB, voffB); PG8_STAGE(PG8_SB(0, 1), cB + hstepB, voffB); PG8_STAGE(PG8_SA(0, 0), cA, voA0); PG8_STAGE(PG8_SA(0, 1), cA, voA1);
        if (wr == 1) PG8_BAR;
        PG8_WAIT_V(2); PG8_BAR;
        PG8_STAGE(PG8_SB(1, 0), cB + kstep, voffB); PG8_STAGE(PG8_SA(1, 0), cA + kstep, voA0); PG8_STAGE(PG8_SB(1, 1), cB + hstepB + kstep, voffB);
        PG8_WAIT_V(6); PG8_BAR;
    } else {
        PG8_STAGE(PG8_SB(0, 0), cB, voffB); PG8_STAGE(PG8_SB(0, 1), cB + hstepB, voffB); PG8_STAGE(PG8_SA(0, 0), cA, voffA); PG8_STAGE(PG8_SA(0, 1), cA + hstepA, voffA);
        if (wr == 1) PG8_BAR;
        PG8_WAIT_V(2); PG8_BAR;
        PG8_STAGE(PG8_SB(1, 0), cB + kstep, voffB); PG8_STAGE(PG8_SA(1, 0), cA + kstep, voffA); PG8_STAGE(PG8_SB(1, 1), cB + hstepB + kstep, voffB);
        PG8_WAIT_V(6); PG8_BAR;
    }
    for (;;) {
        const bool has_next = S.next(ui + 1, nxt);
        const char* nA = has_next ? nxt.A : cA; const char* nB = has_next ? nxt.B : cB;
        if constexpr (Sched::GATHER) {
            if (has_next) { const int t2_ = wid * 64 + lane_now();
#pragma unroll
                for (int i = 0; i < 2; ++i) { int R_, C_; stage_rc(t2_ * 16 + i * 8192, R_, C_);
                  vnA0[i] = S.arow(nxt, R_) * (unsigned)(lda * 2) + (unsigned)(C_ * 2); vnA1[i] = S.arow(nxt, HALF + R_) * (unsigned)(lda * 2) + (unsigned)(C_ * 2); }
            } else {
#pragma unroll
                for (int i = 0; i < 2; ++i) { vnA0[i] = voA0[i]; vnA1[i] = voA1[i]; }
            }
        }
        for (int t = 0; t < nt; t += 2) {
            const bool last = (t == nt - 2);
            const char* a1 = cA + (size_t)(t + 1) * kstep;
            const char* a2 = last ? nA : cA + (size_t)(t + 2) * kstep; const char* b2 = last ? nB : cB + (size_t)(t + 2) * kstep;
            const char* a3 = a2 + kstep; const char* b3 = b2 + kstep;
            unsigned o20[2], o21[2];
            if constexpr (Sched::GATHER) {
#pragma unroll
                for (int i = 0; i < 2; ++i) { o20[i] = last ? vnA0[i] : voA0[i]; o21[i] = last ? vnA1[i] : voA1[i]; }
            }
            if constexpr (F8) { PG8_LDB8(B08, 0, 0); PG8_LDB8(B18, 0, 1); PG8_SCHED; PG8_LDA8(At8, 0, 0); } else { PG8_LDB(B0, 0, 0); PG8_LDB(B1, 0, 1); PG8_SCHED; PG8_LDA(At, 0, 0); }
            if constexpr (Sched::GATHER) { PG8_STAGE(PG8_SA(1, 1), a1, voA1); } else { PG8_STAGE(PG8_SA(1, 1), a1 + hstepA, voffA); }
            PG8_WAIT_V(8); PG8_WAIT_L(0); PG8_BAR; if constexpr (F8) { PG8_MMA8(0, 0, At8, B08); PG8_MMA8(0, 1, At8, B18); } else { PG8_MMA(0, 0, At, B0); PG8_MMA(0, 1, At, B1); } PG8_BAR; PG8_SCHED;
            if constexpr (F8) { PG8_LDA8(At8, 0, 1); } else { PG8_LDA(At, 0, 1); } PG8_STAGE(PG8_SB(0, 0), b2, voffB); PG8_STAGE(PG8_SB(0, 1), b2 + hstepB, voffB);
            if constexpr (Sched::GATHER) { PG8_STAGE(PG8_SA(0, 0), a2, o20); } else { PG8_STAGE(PG8_SA(0, 0), a2, voffA); }
            PG8_WAIT_V(8); PG8_WAIT_L(0); PG8_BAR; if constexpr (F8) { PG8_MMA8(1, 0, At8, B08); PG8_MMA8(1, 1, At8, B18); } else { PG8_MMA(1, 0, At, B0); PG8_MMA(1, 1, At, B1); } PG8_BAR; PG8_SCHED;
            if constexpr (F8) { PG8_LDB8(B08, 1, 0); PG8_LDB8(B18, 1, 1); PG8_SCHED; PG8_LDA8(At8, 1, 0); } else { PG8_LDB(B0, 1, 0); PG8_LDB(B1, 1, 1); PG8_SCHED; PG8_LDA(At, 1, 0); }
            if constexpr (Sched::GATHER) { PG8_STAGE(PG8_SA(0, 1), a2, o21); } else { PG8_STAGE(PG8_SA(0, 1), a2 + hstepA, voffA); }
            PG8_WAIT_V(8); PG8_WAIT_L(0); PG8_BAR; if constexpr (F8) { PG8_MMA8(0, 0, At8, B08); PG8_MMA8(0, 1, At8, B18); } else { PG8_MMA(0, 0, At, B0); PG8_MMA(0, 1, At, B1); } PG8_BAR; PG8_SCHED;
            if constexpr (F8) { PG8_LDA8(At8, 1, 1); } else { PG8_LDA(At, 1, 1); } PG8_STAGE(PG8_SB(1, 0), b3, voffB); PG8_STAGE(PG8_SB(1, 1), b3 + hstepB, voffB);
            if constexpr (Sched::GATHER) { PG8_STAGE(PG8_SA(1, 0), a3, o20); } else { PG8_STAGE(PG8_SA(1, 0), a3, voffA); }
            PG8_WAIT_V(8); PG8_WAIT_L(0); PG8_BAR; if constexpr (F8) { PG8_MMA8(1, 0, At8, B08); PG8_MMA8(1, 1, At8, B18); } else { PG8_MMA(1, 0, At, B0); PG8_MMA(1, 1, At, B1); } PG8_BAR; PG8_SCHED;
        }
        if (wr == 0) PG8_BAR;
        if constexpr (F8) {
#pragma unroll
            for (int a = 0; a < 2; ++a)
#pragma unroll
                for (int b = 0; b < 2; ++b)
#pragma unroll
                    for (int m = 0; m < 4; ++m)
#pragma unroll
                        for (int n = 0; n < 2; ++n)
#pragma unroll
                            for (int j = 0; j < 4; ++j) acc[a][b][m][n][j] = accv[a][b][4 * (2 * m + n) + j];
        }
        { const int l2_ = lane_now(); E(acc, cur, wr, wc, l2_ & 15, l2_ >> 4); }
        if (!has_next) break;
#pragma unroll
        for (int a = 0; a < 2; ++a)
#pragma unroll
            for (int b = 0; b < 2; ++b)
#pragma unroll
                for (int m = 0; m < 4; ++m)
#pragma unroll
                    for (int n = 0; n < 2; ++n) acc[a][b][m][n] = (f32x4){0.f, 0.f, 0.f, 0.f};
        if constexpr (F8) {
#pragma unroll
            for (int a = 0; a < 2; ++a)
#pragma unroll
                for (int b = 0; b < 2; ++b)
#pragma unroll
                    for (int j = 0; j < 32; ++j) accv[a][b][j] = 0.f;
        }
        cur = nxt; cA = nA; cB = nB; ++ui;
        if constexpr (Sched::GATHER) {
#pragma unroll
            for (int i = 0; i < 2; ++i) { voA0[i] = vnA0[i]; voA1[i] = vnA1[i]; }
        }
        if (wr == 1) PG8_BAR;
    }
    PG8_WAIT_V(0);
    PG8_BAR;
#undef PG8_SA
#undef PG8_SB
#undef PG8_STAGE
#undef PG8_LDA
#undef PG8_LDB
#undef PG8_MMA
#undef PG8_LDA8
#undef PG8_LDB8
#undef PG8_MMA8
#undef PG8_WAIT_V
#undef PG8_WAIT_L
#undef PG8_BAR
#undef PG8_SCHED
}

struct EpiBf16 {
    static constexpr bool PERM = true;
    bf16_t* O; int ldc; float scale; size_t aux_stride;
    __device__ __forceinline__ void operator()(const f32x4 (&acc)[2][2][4][2], const Unit& u, int wr, int wc, int fr, int fq) const {
        const int row0 = u.pm * BM + wr * 64 + fr, col0 = u.pn * BM + wc * 32 + 8 * fq; bf16_t* base = O + (size_t)u.aux * aux_stride;
#pragma unroll
        for (int ai = 0; ai < 2; ++ai)
#pragma unroll
            for (int m = 0; m < 4; ++m) { bf16_t* rowp = base + (size_t)(row0 + ai * HALF + m * 16) * ldc + col0;
#pragma unroll
                for (int bj = 0; bj < 2; ++bj) { const f32x4 v0 = acc[ai][bj][m][0] * scale, v1 = acc[ai][bj][m][1] * scale;
                    u32x4 w; w.x = cvt_pk_bf16(v0[0], v0[1]); w.y = cvt_pk_bf16(v0[2], v0[3]); w.z = cvt_pk_bf16(v1[0], v1[1]); w.w = cvt_pk_bf16(v1[2], v1[3]);
                    *(u32x4*)(rowp + bj * HALF) = w; } }
    }
};
struct EpiSwiGLU {
    static constexpr bool PERM = true;
    bf16_t* O; int ldc;
    __device__ __forceinline__ void operator()(const f32x4 (&acc)[2][2][4][2], const Unit& u, int wr, int wc, int fr, int fq) const {
        const int row0 = u.pm * BM + wr * 64 + fr, col0 = u.pn * HALF + wc * 32 + 8 * fq;
#pragma unroll
        for (int ai = 0; ai < 2; ++ai)
#pragma unroll
            for (int m = 0; m < 4; ++m) { bf16_t* rowp = O + (size_t)(row0 + ai * HALF + m * 16) * ldc + col0;
                f32x4 h0, h1;
#pragma unroll
                for (int j = 0; j < 4; ++j) { const float g0 = acc[ai][0][m][0][j], g1 = acc[ai][0][m][1][j];
                    h0[j] = g0 * __builtin_amdgcn_rcpf(1.0f + __expf(-g0)) * acc[ai][1][m][0][j]; h1[j] = g1 * __builtin_amdgcn_rcpf(1.0f + __expf(-g1)) * acc[ai][1][m][1][j]; }
                u32x4 w; w.x = cvt_pk_bf16(h0[0], h0[1]); w.y = cvt_pk_bf16(h0[2], h0[3]); w.z = cvt_pk_bf16(h1[0], h1[1]); w.w = cvt_pk_bf16(h1[2], h1[3]);
                *(u32x4*)rowp = w; }
    }
};
struct EpiSwiGLU8 {
    static constexpr bool PERM = true;
    unsigned char* O; int ldc;
    __device__ __forceinline__ void operator()(const f32x4 (&acc)[2][2][4][2], const Unit& u, int wr, int wc, int fr, int fq) const {
        const int row0 = u.pm * BM + wr * 64 + fr, col0 = u.pn * HALF + wc * 32 + 8 * fq;
#pragma unroll
        for (int ai = 0; ai < 2; ++ai)
#pragma unroll
            for (int m = 0; m < 4; ++m) { unsigned char* rowp = O + (size_t)(row0 + ai * HALF + m * 16) * ldc + col0;
                f32x4 h0, h1;
#pragma unroll
                for (int j = 0; j < 4; ++j) { const float g0 = acc[ai][0][m][0][j] * W8_INV, g1 = acc[ai][0][m][1][j] * W8_INV;
                    h0[j] = g0 * __builtin_amdgcn_rcpf(1.0f + __expf(-g0)) * (acc[ai][1][m][0][j] * W8_INV); h1[j] = g1 * __builtin_amdgcn_rcpf(1.0f + __expf(-g1)) * (acc[ai][1][m][1][j] * W8_INV); }
                u32x2 w; w.x = pk4_fp8(h0[0], h0[1], h0[2], h0[3]); w.y = pk4_fp8(h1[0], h1[1], h1[2], h1[3]);
                *(u32x2*)rowp = w; }
    }
};
template <bool XIN_BF, bool XOUT_BF> struct EpiResGate {
    static constexpr bool PERM = false;
    const void* xin; void* out; const float* gate; int gstride; const float* bias; float scale;
    __device__ __forceinline__ void operator()(const f32x4 (&acc)[2][2][4][2], const Unit& u, int wr, int wc, int fr, int fq) const {
        const int row0 = u.pm * BM + wr * 64 + fr, col0 = u.pn * BM + wc * 32 + 4 * fq;
        const float* gp = gate + (size_t)((u.pm * BM) / SEQ) * gstride + col0;
        f32x4 gv[2][2], bv[2][2];
#pragma unroll
        for (int bj = 0; bj < 2; ++bj)
#pragma unroll
            for (int n = 0; n < 2; ++n) { gv[bj][n] = *(const f32x4*)(gp + bj * HALF + n * 16); bv[bj][n] = bias ? *(const f32x4*)(bias + col0 + bj * HALF + n * 16) : (f32x4){0.f, 0.f, 0.f, 0.f}; }
#pragma unroll
        for (int aim = 0; aim < 4; ++aim) { const int ai = aim >> 1, mb = (aim & 1) * 2;
            f32x4 xv[4][2][2];
#pragma unroll
            for (int m = mb; m < mb + 2; ++m)
#pragma unroll
                for (int bj = 0; bj < 2; ++bj)
#pragma unroll
                    for (int n = 0; n < 2; ++n) { const size_t o2 = (size_t)(row0 + ai * HALF + m * 16) * DM + col0 + bj * HALF + n * 16;
                        if constexpr (XIN_BF) { const u32x2 w = *(const u32x2*)((const bf16_t*)xin + o2); xv[m][bj][n] = (f32x4){bflo(w.x), bfhi(w.x), bflo(w.y), bfhi(w.y)}; } else xv[m][bj][n] = *(const f32x4*)((const float*)xin + o2); }
            asm volatile("" ::: "memory");
#pragma unroll
            for (int m = mb; m < mb + 2; ++m)
#pragma unroll
                for (int bj = 0; bj < 2; ++bj)
#pragma unroll
                    for (int n = 0; n < 2; ++n) { const size_t o2 = (size_t)(row0 + ai * HALF + m * 16) * DM + col0 + bj * HALF + n * 16;
                        const f32x4 r = xv[m][bj][n] + gv[bj][n] * (acc[ai][bj][m][n] * scale + bv[bj][n]);
                        if constexpr (XOUT_BF) { u32x2 w; w.x = cvt_pk_bf16(r[0], r[1]); w.y = cvt_pk_bf16(r[2], r[3]); *(u32x2*)((bf16_t*)out + o2) = w; } else *(f32x4*)((float*)out + o2) = r; }
            asm volatile("" ::: "memory");
        }
    }
};
struct EpiB1 {
    static constexpr bool PERM = true;
    bf16_t* UT;
    __device__ __forceinline__ void operator()(const f32x4 (&acc)[2][2][4][2], const Unit& u, int wr, int wc, int fr, int fq) const {
        const unsigned base = (unsigned)(((u.pn * 1024 + u.aux * 128 + wr * 64 + fr) * 2) * 256 + wc * 32 + 8 * fq);
#pragma unroll
        for (int ai = 0; ai < 2; ++ai)
#pragma unroll
            for (int m = 0; m < 4; ++m)
#pragma unroll
                for (int bj = 0; bj < 2; ++bj) { const f32x4 v0 = acc[ai][bj][m][0], v1 = acc[ai][bj][m][1];
                    u32x4 w; w.x = cvt_pk_bf16(v0[0], v0[1]); w.y = cvt_pk_bf16(v0[2], v0[3]); w.z = cvt_pk_bf16(v1[0], v1[1]); w.w = cvt_pk_bf16(v1[2], v1[3]);
                    *(u32x4*)(UT + (base + (unsigned)((m * 16) * 512 + ai * 256 + bj * HALF))) = w; }
    }
};
struct EpiB2 {
    static constexpr bool PERM = true;
    unsigned char* Fo;
    __device__ __forceinline__ void operator()(const f32x4 (&acc)[2][2][4][2], const Unit& u, int wr, int wc, int fr, int fq) const {
        const int b = u.aux >> 4, k1 = u.aux & 15, k1m = (16 - k1) & 15, k2off = k1 ? 255 : 256;
        const unsigned colb = (unsigned)(u.pn * 512 + wc * 32 + 8 * fq);
        const bool edge = (wc == 0) && (fq == 0);
#pragma unroll
        for (int ai = 0; ai < 2; ++ai)
#pragma unroll
            for (int m = 0; m < 4; ++m) { const int k2 = ai * HALF + wr * 64 + m * 16 + fr, k2m = (k2off - k2) & 255;
                const unsigned rowd = (unsigned)(b * SEQ + k1 + 16 * k2) * DM, rowm = (unsigned)(b * SEQ + k1m + 16 * k2m) * DM;
#pragma unroll
                for (int bj = 0; bj < 2; ++bj) { const f32x4 v0 = acc[ai][bj][m][0] * (1.0f / 1024.0f), v1 = acc[ai][bj][m][1] * (1.0f / 1024.0f);
                    u32x2 w; w.x = pk4_fp8(v0[0], v0[1], v0[2], v0[3]); w.y = pk4_fp8(v1[0], v1[1], v1[2], v1[3]);
                    *(u32x2*)(Fo + (rowd + colb + (unsigned)(bj * 256))) = w;
                    unsigned char* mp = Fo + (rowm + colb + (unsigned)(bj * 256 + 128));
                    if (!edge) *(u32x2*)mp = w;
                    else { mp[1] = (unsigned char)(w.x >> 8); *(unsigned short*)(mp + 2) = (unsigned short)(w.x >> 16); *(unsigned*)(mp + 4) = w.y; } } }
    }
};
}
struct BgConv { int item, end; const float *w_o, *w_gate, *w_up, *w_down; unsigned char *o8, *gu8, *d8; unsigned char* pdst; int pldk; };
constexpr int BG_SQ = (DM / 32) * (DM / 32), BG_E = (DM / 32) * (DE / 32), BG_TOTAL = BG_SQ + 3 * 32 * BG_E;
struct BgItem { const float* src; unsigned char* dst; int N, ldk; };
__device__ __forceinline__ BgItem bg_decode(const BgConv& g, int idx) {
    BgItem it; int kb, nb, drow;
    if (idx < BG_SQ) { kb = idx >> 6; nb = idx & 63; it.src = g.w_o; it.N = DM; it.dst = g.o8; it.ldk = DM; drow = 32 * nb; }
    else { const int r = idx - BG_SQ, which = r / (32 * BG_E), r2 = r % (32 * BG_E), le = r2 / BG_E, t = r2 % BG_E;
        if (which < 2) { kb = t >> 5; nb = t & 31; const int n0 = 32 * nb; it.src = (which == 0 ? g.w_gate : g.w_up) + (size_t)le * DM * DE; it.N = DE; it.dst = g.gu8 + (size_t)le * DM * DM; it.ldk = DM; drow = (n0 >> 7) * 256 + (n0 & 127) + (which ? 128 : 0); }
        else { kb = t >> 6; nb = t & 63; it.src = g.w_down + (size_t)le * DE * DM; it.N = DM; it.dst = g.d8 + (size_t)le * DM * DE; it.ldk = DE; drow = 32 * nb; } }
    it.src += (size_t)(32 * kb) * it.N + 32 * nb; it.dst += (size_t)drow * it.ldk + 32 * kb;
    return it;
}
__device__ __forceinline__ void bg_issue_at(const BgConv& g, int idx, int lane, unsigned slot) {
    const BgItem it = bg_decode(g, idx); const char* p = (const char*)it.src + (unsigned)(((lane >> 3) * it.N + (lane & 7) * 4) * 4);
#pragma unroll
    for (int i = 0; i < 4; ++i) __builtin_amdgcn_global_load_lds((const unsigned*)(p + (size_t)(8 * i) * it.N * 4), (LAS unsigned*)(slot + i * 1024), 16, 0, 2);
}
__device__ __forceinline__ void bg_consume_at(const BgConv& g, int idx, int lane, unsigned slot) {
    const BgItem it = bg_decode(g, idx); const int c = lane & 1, n = lane >> 1; const LAS float* s = (const LAS float*)(slot + (unsigned)(((16 * c) * 32 + n) * 4));
    u32x4 o; o.x = pk4_fp8(s[0 * 32] * W8_SCALE, s[1 * 32] * W8_SCALE, s[2 * 32] * W8_SCALE, s[3 * 32] * W8_SCALE); o.y = pk4_fp8(s[4 * 32] * W8_SCALE, s[5 * 32] * W8_SCALE, s[6 * 32] * W8_SCALE, s[7 * 32] * W8_SCALE);
    o.z = pk4_fp8(s[8 * 32] * W8_SCALE, s[9 * 32] * W8_SCALE, s[10 * 32] * W8_SCALE, s[11 * 32] * W8_SCALE); o.w = pk4_fp8(s[12 * 32] * W8_SCALE, s[13 * 32] * W8_SCALE, s[14 * 32] * W8_SCALE, s[15 * 32] * W8_SCALE);
    __builtin_nontemporal_store(o, (u32x4*)(it.dst + (size_t)n * it.ldk + 16 * c));
    asm volatile("s_waitcnt lgkmcnt(0)" ::: "memory");
}
__device__ __forceinline__ void bg_issue(BgConv& g, int lane, unsigned slot) {
    const BgItem it = bg_decode(g, g.item); g.pdst = it.dst; g.pldk = it.ldk; const char* p = (const char*)it.src + (unsigned)(((lane >> 3) * it.N + (lane & 7) * 4) * 4);
#pragma unroll
    for (int i = 0; i < 4; ++i) __builtin_amdgcn_global_load_lds((const unsigned*)(p + (size_t)(8 * i) * it.N * 4), (LAS unsigned*)(slot + i * 1024), 16, 0, 2);
}
__device__ __forceinline__ void bg_consume(BgConv& g, int lane, unsigned slot) {
    const int c = lane & 1, n = lane >> 1; const LAS float* s = (const LAS float*)(slot + (unsigned)(((16 * c) * 32 + n) * 4));
    u32x4 o; o.x = pk4_fp8(s[0 * 32] * W8_SCALE, s[1 * 32] * W8_SCALE, s[2 * 32] * W8_SCALE, s[3 * 32] * W8_SCALE); o.y = pk4_fp8(s[4 * 32] * W8_SCALE, s[5 * 32] * W8_SCALE, s[6 * 32] * W8_SCALE, s[7 * 32] * W8_SCALE);
    o.z = pk4_fp8(s[8 * 32] * W8_SCALE, s[9 * 32] * W8_SCALE, s[10 * 32] * W8_SCALE, s[11 * 32] * W8_SCALE); o.w = pk4_fp8(s[12 * 32] * W8_SCALE, s[13 * 32] * W8_SCALE, s[14 * 32] * W8_SCALE, s[15 * 32] * W8_SCALE);
    __builtin_nontemporal_store(o, (u32x4*)(g.pdst + (size_t)n * g.pldk + 16 * c));
    asm volatile("s_waitcnt lgkmcnt(0)" ::: "memory");
    ++g.item;
}
__device__ __forceinline__ void bg_now(BgConv& g, int lane, unsigned slot) {
    bg_issue(g, lane, slot); asm volatile("s_waitcnt vmcnt(0)" ::: "memory"); bg_consume(g, lane, slot);
}
namespace att {
constexpr int NW = 8, QBLK = 32, KVBLK = 64, DV = 128;
constexpr float THR = 8.f;
#define SBAR() __builtin_amdgcn_sched_barrier(0)
#ifndef ATT_ROLE_SPLIT
#define ATT_ROLE_SPLIT 4
#endif
__device__ __forceinline__ int crow(int r, int hi) { return (r & 3) + 8 * (r >> 2) + 4 * hi; }
__device__ __forceinline__ int v_st(int k, int c) { const int kk = (k & ~0xC) | ((k & 4) << 1) | ((k & 8) >> 1); return ((kk >> 3) * 4 + (c >> 5)) * 512 + ((kk & 7) * 32 + (c & 31)) * 2; }
__device__ __forceinline__ int v_rd_base(int lane) { return ((lane & 3) << 3) | (((lane >> 2) & 3) << 6) | (((lane >> 4) & 1) << 5) | (((lane >> 5) & 1) << 8); }
constexpr int v_rd_off(int d0, int ks, int half) { return d0 * 512 + ks * 4096 + half * 2048; }
template <int OFF> __device__ __forceinline__ s16x4 tr_read(int vb) {
  s16x4 r; asm volatile("ds_read_b64_tr_b16 %0, %1 offset:%2" : "=&v"(r) : "v"(vb), "i"(OFF) : "memory"); return r;
}
template <int D0> __device__ __forceinline__ void pv_one(f32x16& od, int vb, bf16x8 pa0, bf16x8 pa1, bf16x8 pa2, bf16x8 pa3) {
  const s16x4 l0 = tr_read<v_rd_off(D0, 0, 0)>(vb), h0 = tr_read<v_rd_off(D0, 0, 1)>(vb), l1 = tr_read<v_rd_off(D0, 1, 0)>(vb), h1 = tr_read<v_rd_off(D0, 1, 1)>(vb);
  const s16x4 l2 = tr_read<v_rd_off(D0, 2, 0)>(vb), h2 = tr_read<v_rd_off(D0, 2, 1)>(vb), l3 = tr_read<v_rd_off(D0, 3, 0)>(vb), h3 = tr_read<v_rd_off(D0, 3, 1)>(vb);
  asm volatile("s_waitcnt lgkmcnt(0)" ::: "memory"); SBAR();
#define PK(L, H) (bf16x8){L[0], L[1], L[2], L[3], H[0], H[1], H[2], H[3]}
  od = __builtin_amdgcn_mfma_f32_32x32x16_bf16(pa0, PK(l0, h0), od, 0, 0, 0);
  od = __builtin_amdgcn_mfma_f32_32x32x16_bf16(pa1, PK(l1, h1), od, 0, 0, 0);
  od = __builtin_amdgcn_mfma_f32_32x32x16_bf16(pa2, PK(l2, h2), od, 0, 0, 0);
  od = __builtin_amdgcn_mfma_f32_32x32x16_bf16(pa3, PK(l3, h3), od, 0, 0, 0);
#undef PK
}
__device__ __forceinline__ void pv_d0(f32x16* o, int vb, bf16x8 pa0, bf16x8 pa1, bf16x8 pa2, bf16x8 pa3) {
  pv_one<0>(o[0], vb, pa0, pa1, pa2, pa3); pv_one<1>(o[1], vb, pa0, pa1, pa2, pa3); pv_one<2>(o[2], vb, pa0, pa1, pa2, pa3); pv_one<3>(o[3], vb, pa0, pa1, pa2, pa3);
}
template <int DK, bool WINDOW>
__device__ __forceinline__ void partialSM(f32x16& p0, f32x16& p1, float& m_reg, float& mn, float& alpha, int dq, int hi) {
  constexpr float SCALE = (DK == 128) ? 0.088388347648318440f : 0.072168783648703220f;
  constexpr float C = SCALE * 1.4426950408889634f;
  if constexpr (WINDOW) {
    const int dqh = dq - 4 * hi + 128;
#pragma unroll
    for (int r = 0; r < 16; ++r) { const unsigned d0 = (unsigned)(dqh - ((r & 3) + 8 * (r >> 2))), d1 = d0 - 32u;
      p0[r] = d0 <= 256u ? p0[r] : -1e30f; p1[r] = d1 <= 256u ? p1[r] : -1e30f; }
  }
  float pmax = p0[0];
#pragma unroll
  for (int r = 1; r < 16; ++r) pmax = fmaxf(pmax, p0[r]);
#pragma unroll
  for (int r = 0; r < 16; ++r) pmax = fmaxf(pmax, p1[r]);
  { auto rr = __builtin_amdgcn_permlane32_swap(__float_as_uint(pmax), __float_as_uint(pmax), false, false);
    pmax = fmaxf(__uint_as_float(rr[0]), __uint_as_float(rr[1])); }
  if (__builtin_expect(__all(pmax - m_reg <= THR / SCALE), 1)) { mn = m_reg; alpha = 1.f; }
  else { mn = fmaxf(m_reg, pmax); alpha = __builtin_amdgcn_exp2f((m_reg - mn) * C); m_reg = mn; }
  const float mnC = -mn * C;
#pragma unroll
  for (int r = 0; r < 16; ++r) p0[r] = fmaf(p0[r], C, mnC);
#pragma unroll
  for (int r = 0; r < 16; ++r) p1[r] = fmaf(p1[r], C, mnC);
#pragma unroll
  for (int r = 0; r < 16; ++r) p0[r] = __builtin_amdgcn_exp2f(p0[r]);
}
__device__ __forceinline__ void finishSM(f32x16& p0, f32x16& p1, float alpha, float& l_reg, bf16x8& pa0, bf16x8& pa1, bf16x8& pa2, bf16x8& pa3) {
#pragma unroll
  for (int r = 0; r < 16; ++r) p1[r] = __builtin_amdgcn_exp2f(p1[r]);
  float ps = 0;
#pragma unroll
  for (int r = 0; r < 16; ++r) ps += p0[r];
#pragma unroll
  for (int r = 0; r < 16; ++r) ps += p1[r];
  { auto rr = __builtin_amdgcn_permlane32_swap(__float_as_uint(ps), __float_as_uint(ps), false, false);
    ps = __uint_as_float(rr[0]) + __uint_as_float(rr[1]); }
  l_reg = l_reg * alpha + ps;
#define PK4(P, BASE, OUT) do { unsigned a0 = cvt_pk_bf16(P[BASE + 0], P[BASE + 1]), a1 = cvt_pk_bf16(P[BASE + 2], P[BASE + 3]);   \
    unsigned b0 = cvt_pk_bf16(P[BASE + 4], P[BASE + 5]), b1 = cvt_pk_bf16(P[BASE + 6], P[BASE + 7]);                              \
    auto r0 = __builtin_amdgcn_permlane32_swap(a0, b0, false, false); auto r1 = __builtin_amdgcn_permlane32_swap(a1, b1, false, false); \
    u32x4 w = {r0[0], r1[0], r0[1], r1[1]}; OUT = *reinterpret_cast<bf16x8*>(&w); } while (0)
  PK4(p0, 0, pa0); PK4(p0, 8, pa1); PK4(p1, 0, pa2); PK4(p1, 8, pa3);
#undef PK4
}
template <int DK> __device__ __forceinline__ int kswz(int row, int colB) { return row * (DK * 2) + (colB ^ ((row & (DK == 128 ? 15 : 7)) << 4)); }
template <int DK>
__device__ __forceinline__ void qkt(f32x16& p0, f32x16& p1, unsigned kb, int kx, int hi16, const bf16x8* qr) {
  p0 = f32x16{}; p1 = f32x16{};
  unsigned a[4];
#pragma unroll
  for (int q = 0; q < 4; ++q) a[q] = kb + (unsigned)((q * 32 + hi16) ^ kx);
#pragma unroll
  for (int d0 = 0; d0 < DK / 16; ++d0) {
    const bf16x8 b0 = *(const LAS bf16x8*)(a[d0 & 3] + (d0 >> 2) * 128);
    const bf16x8 b1 = *(const LAS bf16x8*)(a[d0 & 3] + (d0 >> 2) * 128 + 32 * DK * 2);
    p0 = __builtin_amdgcn_mfma_f32_32x32x16_bf16(b0, qr[d0], p0, 0, 0, 0);
    p1 = __builtin_amdgcn_mfma_f32_32x32x16_bf16(b1, qr[d0], p1, 0, 0, 0);
    if ((d0 & 3) == 3) SBAR(); }
}

template <int DK>
__device__ __forceinline__ void qkt_fin(f32x16& pc0, f32x16& pc1, unsigned kb, int kx, int hi16, const bf16x8* qr, f32x16& pp0, f32x16& pp1, float alphaP, float& l_reg,
                                        bf16x8& pa0, bf16x8& pa1, bf16x8& pa2, bf16x8& pa3) {
  static_assert(DK == 192, "qkt_fin is written for three k-groups");
  pc0 = f32x16{}; pc1 = f32x16{};
  unsigned a[4];
#pragma unroll
  for (int q = 0; q < 4; ++q) a[q] = kb + (unsigned)((q * 32 + hi16) ^ kx);
#define QGROUP(G) do { _Pragma("unroll") for (int d0 = 4 * (G); d0 < 4 * (G) + 4; ++d0) { \
      const bf16x8 b0 = *(const LAS bf16x8*)(a[d0 & 3] + (d0 >> 2) * 128); const bf16x8 b1 = *(const LAS bf16x8*)(a[d0 & 3] + (d0 >> 2) * 128 + 32 * DK * 2); \
      pc0 = __builtin_amdgcn_mfma_f32_32x32x16_bf16(b0, qr[d0], pc0, 0, 0, 0); pc1 = __builtin_amdgcn_mfma_f32_32x32x16_bf16(b1, qr[d0], pc1, 0, 0, 0); } } while (0)
#pragma unroll
  for (int r = 0; r < 16; ++r) pp1[r] = __builtin_amdgcn_exp2f(pp1[r]);
  QGROUP(0); SBAR();
  { float ps = 0;
#pragma unroll
    for (int r = 0; r < 16; ++r) ps += pp0[r];
#pragma unroll
    for (int r = 0; r < 16; ++r) ps += pp1[r];
    { auto rr = __builtin_amdgcn_permlane32_swap(__float_as_uint(ps), __float_as_uint(ps), false, false); ps = __uint_as_float(rr[0]) + __uint_as_float(rr[1]); }
    l_reg = l_reg * alphaP + ps; }
  QGROUP(1); SBAR();
#define PK4(P, BASE, OUT) do { unsigned a0_ = cvt_pk_bf16(P[BASE + 0], P[BASE + 1]), a1_ = cvt_pk_bf16(P[BASE + 2], P[BASE + 3]);   \
    unsigned b0_ = cvt_pk_bf16(P[BASE + 4], P[BASE + 5]), b1_ = cvt_pk_bf16(P[BASE + 6], P[BASE + 7]);                              \
    auto r0_ = __builtin_amdgcn_permlane32_swap(a0_, b0_, false, false); auto r1_ = __builtin_amdgcn_permlane32_swap(a1_, b1_, false, false); \
    u32x4 w_ = {r0_[0], r1_[0], r0_[1], r1_[1]}; OUT = *reinterpret_cast<bf16x8*>(&w_); } while (0)
  PK4(pp0, 0, pa0); PK4(pp0, 8, pa1); PK4(pp1, 0, pa2); PK4(pp1, 8, pa3);
#undef PK4
  QGROUP(2); SBAR();
#undef QGROUP
}
template <int DK, bool WINDOW>
__device__ __forceinline__ void pv_psm(f32x16* o, int vb, bf16x8 pa0, bf16x8 pa1, bf16x8 pa2, bf16x8 pa3, f32x16& p0, f32x16& p1, float& m_reg, float& alpha, int dq, int hi) {
  constexpr float SCALE = (DK == 128) ? 0.088388347648318440f : 0.072168783648703220f;
  constexpr float C = SCALE * 1.4426950408889634f;
#define PVGROUP(D0, ...) do { \
    const s16x4 l0 = tr_read<v_rd_off(D0, 0, 0)>(vb), h0 = tr_read<v_rd_off(D0, 0, 1)>(vb), l1 = tr_read<v_rd_off(D0, 1, 0)>(vb), h1 = tr_read<v_rd_off(D0, 1, 1)>(vb); \
    const s16x4 l2 = tr_read<v_rd_off(D0, 2, 0)>(vb), h2 = tr_read<v_rd_off(D0, 2, 1)>(vb), l3 = tr_read<v_rd_off(D0, 3, 0)>(vb), h3 = tr_read<v_rd_off(D0, 3, 1)>(vb); \
    __VA_ARGS__; \
    asm volatile("s_waitcnt lgkmcnt(0)" ::: "memory"); SBAR(); \
    o[D0] = __builtin_amdgcn_mfma_f32_32x32x16_bf16(pa0, (bf16x8){l0[0], l0[1], l0[2], l0[3], h0[0], h0[1], h0[2], h0[3]}, o[D0], 0, 0, 0); \
    o[D0] = __builtin_amdgcn_mfma_f32_32x32x16_bf16(pa1, (bf16x8){l1[0], l1[1], l1[2], l1[3], h1[0], h1[1], h1[2], h1[3]}, o[D0], 0, 0, 0); \
    o[D0] = __builtin_amdgcn_mfma_f32_32x32x16_bf16(pa2, (bf16x8){l2[0], l2[1], l2[2], l2[3], h2[0], h2[1], h2[2], h2[3]}, o[D0], 0, 0, 0); \
    o[D0] = __builtin_amdgcn_mfma_f32_32x32x16_bf16(pa3, (bf16x8){l3[0], l3[1], l3[2], l3[3], h3[0], h3[1], h3[2], h3[3]}, o[D0], 0, 0, 0); } while (0)
  float mnC;
  PVGROUP(0, {
    if constexpr (WINDOW) { const int dqh = dq - 4 * hi + 128;
      _Pragma("unroll") for (int r = 0; r < 16; ++r) { const unsigned d0_ = (unsigned)(dqh - ((r & 3) + 8 * (r >> 2))), d1_ = d0_ - 32u; p0[r] = d0_ <= 256u ? p0[r] : -1e30f; p1[r] = d1_ <= 256u ? p1[r] : -1e30f; } }
    float pmax = p0[0];
    _Pragma("unroll") for (int r = 1; r < 16; ++r) pmax = fmaxf(pmax, p0[r]);
    _Pragma("unroll") for (int r = 0; r < 16; ++r) pmax = fmaxf(pmax, p1[r]);
    { auto rr = __builtin_amdgcn_permlane32_swap(__float_as_uint(pmax), __float_as_uint(pmax), false, false); pmax = fmaxf(__uint_as_float(rr[0]), __uint_as_float(rr[1])); }
    const bool keep = __all(pmax - m_reg <= THR / SCALE);
    const float mn = keep ? m_reg : fmaxf(m_reg, pmax);
    alpha = keep ? 1.f : __builtin_amdgcn_exp2f((m_reg - mn) * C); m_reg = mn; mnC = -mn * C; });
  PVGROUP(1, { _Pragma("unroll") for (int r = 0; r < 16; ++r) p0[r] = fmaf(p0[r], C, mnC); });
  PVGROUP(2, { _Pragma("unroll") for (int r = 0; r < 16; ++r) p1[r] = fmaf(p1[r], C, mnC); });
  PVGROUP(3, { _Pragma("unroll") for (int r = 0; r < 16; ++r) p0[r] = __builtin_amdgcn_exp2f(p0[r]); });
#undef PVGROUP
}

template <int DK, bool WINDOW>
__device__ __forceinline__ void attn_unit(const bf16_t* __restrict__ Qb, int ldq, const bf16_t* __restrict__ Kh, const bf16_t* __restrict__ Vh, unsigned char* __restrict__ Ob, int ldo,
                                          int NT, int ks, int q0, float sink, char* lds, const int wid, BgConv& bg) {
  constexpr float SCALE = (DK == 128) ? 0.088388347648318440f : 0.072168783648703220f;
  constexpr int SHM_K = KVBLK * DK * 2, SHM_V = KVBLK * DV * 2, SLOT = SHM_K + SHM_V, NKC = DK / 64, KCH = DK / 8;
  const int lane = lane_now(), tid = wid * 64 + lane, r32 = lane & 31, hi = lane >> 5;
  const unsigned lbase = (unsigned)(uintptr_t)lds;
  float* ws = (float*)(lds + 3 * SLOT) + wid * 64; float* li_l = ws; float* al_l = ws + 32;
  float m_reg = WINDOW ? sink / SCALE : -1e30f, l_reg = WINDOW ? 1.f : 0.f;
  f32x16 o[4] = {}; bf16x8 qr[DK / 16];
  const bf16_t* Qw = Qb + (long)(wid * QBLK + r32) * ldq + hi * 8;
#pragma unroll
  for (int d0 = 0; d0 < DK / 16; ++d0) qr[d0] = *reinterpret_cast<const bf16x8*>(Qw + d0 * 16);
  unsigned koff[NKC], voff[2];
#pragma unroll
  for (int i = 0; i < NKC; ++i) { const int c = tid + 512 * i, row = c / KCH, pc = c % KCH, lc = (pc & ~7) | ((pc ^ (row >> 1)) & 7); koff[i] = (unsigned)(row * DK * 2 + lc * 16); }
#pragma unroll
  for (int i = 0; i < 2; ++i) { const int P = (tid + 512 * i) * 16, sub = P >> 9, within = P & 511, kk = (sub >> 2) * 8 + (within >> 6), col = (sub & 3) * 32 + ((within & 63) >> 1), k = (kk & ~0xC) | ((kk & 4) << 1) | ((kk & 8) >> 1);
    voff[i] = (unsigned)((k * DV + col) * 2); }
#pragma unroll
  for (int i = 0; i < NKC; ++i) asm volatile("" : "+v"(koff[i]));
  asm volatile("" : "+v"(voff[0]), "+v"(voff[1]));
  const unsigned bgslot = lbase + 3 * SLOT + 2048 + (unsigned)wid * 4096; bool bgpend = false;
  const int vb0 = (int)lbase + SHM_K + v_rd_base(lane);
  const unsigned kbase0 = lbase + (unsigned)(r32 * DK * 2); const int kx = ((r32 >> 1) & 7) << 4, hi16 = hi * 16;
  const int qpos = q0 + wid * QBLK + r32;
#define TROW(j) (64 * (j) + ((WINDOW && (j) >= 4) ? ks : 0))
#define DMA(j, slot) do { const char* kb_ = (const char*)(Kh + (long)TROW(j) * DK); const char* vb_ = (const char*)(Vh + (long)TROW(j) * DV); \
    _Pragma("unroll") for (int _i = 0; _i < NKC; ++_i) __builtin_amdgcn_global_load_lds((const unsigned*)(kb_ + koff[_i]), (LAS unsigned*)(lbase + (slot) * SLOT + (_i * 512 + wid * 64) * 16), 16, 0, 0); \
    _Pragma("unroll") for (int _i = 0; _i < 2; ++_i) __builtin_amdgcn_global_load_lds((const unsigned*)(vb_ + voff[_i]), (LAS unsigned*)(lbase + (slot) * SLOT + SHM_K + (_i * 512 + wid * 64) * 16), 16, 0, 0); } while (0)
#define RESC(a) do { if (__any((a) < 1.f)) { if (hi == 0) al_l[r32] = (a); asm volatile("s_waitcnt lgkmcnt(0)" ::: "memory"); \
    _Pragma("unroll") for (int d = 0; d < 4; ++d) _Pragma("unroll") for (int r = 0; r < 16; ++r) o[d][r] *= al_l[crow(r, hi)]; } } while (0)
#define MASKED(j) (WINDOW && (j) >= 4)
#define DQ(j) ((WINDOW && (j) >= 4) ? qpos - (ks + 64 * ((j) - 4)) : 0)
#define TBAR() do { asm volatile("s_waitcnt vmcnt(0) lgkmcnt(0)" ::: "memory"); __builtin_amdgcn_s_barrier(); asm volatile("" ::: "memory"); } while (0)
#define STEP(T_, PC0, PC1, MNC, ALC, PP0, PP1, ALP, SK, SV, SD, TD_, BGI, BGC) do { \
    DMA(TD_, SD); \
    if (BGI) { bgpend = bg.item < bg.end; if (bgpend) bg_issue(bg, lane, bgslot); } \
    { unsigned kb_ = kbase0 + (SK) * SLOT; asm volatile("" : "+v"(kb_)); SBAR(); qkt_fin<DK>(PC0, PC1, kb_, kx, hi16, qr, PP0, PP1, ALP, l_reg, pa0, pa1, pa2, pa3); } \
    pv_psm<DK, WINDOW>(o, vb0 + (SV) * SLOT, pa0, pa1, pa2, pa3, PC0, PC1, m_reg, ALC, DQ(T_), hi); \
    RESC(ALC); \
    if ((BGI) && bgpend) asm volatile("s_waitcnt vmcnt(4) lgkmcnt(0)" ::: "memory"); else asm volatile("s_waitcnt vmcnt(0) lgkmcnt(0)" ::: "memory"); \
    if (BGC) { if (bgpend) { bg_consume(bg, lane, bgslot); bgpend = false; } } \
    __builtin_amdgcn_s_barrier(); asm volatile("" ::: "memory"); } while (0)
#define PAIR(J, S) do { STEP(J, pB0, pB1, mnB, alB, pA0, pA1, alA, S, ((S) + 2) % 3, ((S) + 1) % 3, (J) + 1, true, false); \
                        STEP((J) + 1, pA0, pA1, mnA, alA, pB0, pB1, alB, ((S) + 1) % 3, S, ((S) + 2) % 3, (J) + 2, false, true); } while (0)
#define SYNC(t) do { \
    asm volatile("s_waitcnt vmcnt(0) lgkmcnt(0)" ::: "memory"); \
    if (bgpend) { bg_consume(bg, lane, bgslot); bgpend = false; } \
    __builtin_amdgcn_s_barrier(); asm volatile("" ::: "memory"); \
    if ((t) + 2 < NT) DMA((t) + 2, sd); \
    bgpend = bg.item < bg.end; if (bgpend) bg_issue(bg, lane, bgslot); } while (0)
  f32x16 pA0, pA1; float mnA, alA; bf16x8 pa0, pa1, pa2, pa3;
  DMA(0, 0); DMA(1, 1);
#pragma unroll
  for (int d0 = 0; d0 < DK / 16; ++d0) asm volatile("" : "+v"(qr[d0]));
  TBAR();
  const bool late = wid >= ATT_ROLE_SPLIT;
  int sk = 0, sd = 2;
  for (int t = 0; t < NT; ++t) {
    { unsigned kb_ = kbase0 + sk * SLOT; asm volatile("" : "+v"(kb_)); SBAR(); qkt<DK>(pA0, pA1, kb_, kx, hi16, qr); }
    partialSM<DK, WINDOW>(pA0, pA1, m_reg, mnA, alA, DQ(t), hi);
    RESC(alA);
    finishSM(pA0, pA1, alA, l_reg, pa0, pa1, pa2, pa3);
    if (late && t + 1 < NT) SYNC(t);
    { int vb_ = vb0 + sk * SLOT; asm volatile("" : "+v"(vb_)); SBAR(); pv_d0(o, vb_, pa0, pa1, pa2, pa3); }
    if (!late && t + 1 < NT) SYNC(t);
    sk = sk == 2 ? 0 : sk + 1; sd = sd == 2 ? 0 : sd + 1;
  }
  if (bgpend) { asm volatile("s_waitcnt vmcnt(0)" ::: "memory"); bg_consume(bg, lane, bgslot); bgpend = false; }
  if (hi == 0) li_l[r32] = l_reg; asm volatile("s_waitcnt lgkmcnt(0)" ::: "memory");
  float rli[16];
#pragma unroll
  for (int r = 0; r < 16; ++r) rli[r] = 16.0f * __builtin_amdgcn_rcpf(li_l[crow(r, hi)]);
  unsigned char* Ow = Ob + (long)(wid * QBLK) * ldo;
#pragma unroll
  for (int r = 0; r < 16; ++r) { const int orow = crow(r, hi);
    *(unsigned*)(Ow + (long)orow * ldo + 4 * r32) = pk4_fp8(o[0][r] * rli[r], o[1][r] * rli[r], o[2][r] * rli[r], o[3][r] * rli[r]); }
  __syncthreads();
#undef TROW
#undef DMA
#undef RESC
#undef MASKED
#undef DQ
#undef TBAR
#undef STEP
#undef PAIR
#undef SYNC
}
template <int DK>
__device__ __forceinline__ void qkt_s(f32x16& p0, f32x16& p1, const char* Ks, const bf16x8* qr, int r32, int hi) {
  p0 = f32x16{}; p1 = f32x16{};
#pragma unroll
  for (int d0 = 0; d0 < DK / 16; ++d0) { const int cb = (d0 * 16 + hi * 8) * 2;
    const bf16x8 b0 = *reinterpret_cast<const bf16x8*>(Ks + kswz<DK>(r32, cb));
    const bf16x8 b1 = *reinterpret_cast<const bf16x8*>(Ks + kswz<DK>(32 + r32, cb));
    p0 = __builtin_amdgcn_mfma_f32_32x32x16_bf16(b0, qr[d0], p0, 0, 0, 0);
    p1 = __builtin_amdgcn_mfma_f32_32x32x16_bf16(b1, qr[d0], p1, 0, 0, 0);
    if ((d0 & 3) == 3) SBAR(); }
}

template <int DK, bool WINDOW>
__device__ __forceinline__ void attn_unit_simple(const bf16_t* __restrict__ Qb, int ldq, const bf16_t* __restrict__ Kh, const bf16_t* __restrict__ Vh, unsigned char* __restrict__ Ob, int ldo,
                                          int NT, int ks, int q0, float sink, char* lds, const int wid) {
  constexpr float SCALE = (DK == 128) ? 0.088388347648318440f : 0.072168783648703220f;
  constexpr int SHM_K = KVBLK * DK * 2, SHM_V = KVBLK * DV * 2, NKC = DK / 64, KCH = DK / 8;
  const int lane = lane_now(), tid = wid * 64 + lane, r32 = lane & 31, hi = lane >> 5;
  char* V_lds = lds; char* K_lds = lds + 2 * SHM_V;
  float* ws = (float*)(lds + 2 * SHM_V + 2 * SHM_K) + wid * 64; float* li_l = ws; float* al_l = ws + 32;
  float m_reg = WINDOW ? sink / SCALE : -1e30f, l_reg = WINDOW ? 1.f : 0.f;
  f32x16 o[4] = {}; bf16x8 qr[DK / 16];
  const bf16_t* Qw = Qb + (long)(wid * QBLK + r32) * ldq + hi * 8;
#pragma unroll
  for (int d0 = 0; d0 < DK / 16; ++d0) qr[d0] = *reinterpret_cast<const bf16x8*>(Qw + d0 * 16);
  const int sr = tid >> 4, sc = (tid & 15) * 8, vst0 = v_st(sr, sc), vst1 = v_st(32 + sr, sc);
  int krow[NKC], kcc[NKC];
#pragma unroll
  for (int i = 0; i < NKC; ++i) { const int c = tid + 512 * i; krow[i] = c / KCH; kcc[i] = c % KCH; }
  const int vb0 = (int)(uintptr_t)V_lds + v_rd_base(lane);
  const int qpos = q0 + wid * QBLK + r32;
  bf16x8 vs0, vs1, ksr[NKC];
#define TROW(j) (64 * (j) + ((WINDOW && (j) >= 4) ? ks : 0))
#define SLOAD(j) do { const long _k0 = TROW(j); vs0 = *reinterpret_cast<const bf16x8*>(&Vh[(_k0 + sr) * DV + sc]); vs1 = *reinterpret_cast<const bf16x8*>(&Vh[(_k0 + 32 + sr) * DV + sc]); \
    _Pragma("unroll") for (int _i = 0; _i < NKC; ++_i) ksr[_i] = *reinterpret_cast<const bf16x8*>(&Kh[(_k0 + krow[_i]) * DK + kcc[_i] * 8]); } while (0)
#define SWRITE(b) do { *(bf16x8*)(V_lds + (b) * SHM_V + vst0) = vs0; *(bf16x8*)(V_lds + (b) * SHM_V + vst1) = vs1; \
    _Pragma("unroll") for (int _i = 0; _i < NKC; ++_i) *(bf16x8*)(K_lds + (b) * SHM_K + kswz<DK>(krow[_i], kcc[_i] * 16)) = ksr[_i]; } while (0)
#define SWAIT() asm volatile("s_waitcnt vmcnt(0)" ::: "memory")
#define RESC(a) do { if (__any((a) < 1.f)) { if (hi == 0) al_l[r32] = (a); asm volatile("s_waitcnt lgkmcnt(0)" ::: "memory"); \
    _Pragma("unroll") for (int d = 0; d < 4; ++d) _Pragma("unroll") for (int r = 0; r < 16; ++r) o[d][r] *= al_l[crow(r, hi)]; } } while (0)
#define MASKED(j) (WINDOW && (j) >= 4)
#define DQ(j) ((WINDOW && (j) >= 4) ? qpos - (ks + 64 * ((j) - 4)) : 0)
  f32x16 p0, p1; float mn, al; bf16x8 pa0, pa1, pa2, pa3;
  SLOAD(0); SWAIT(); SWRITE(0); __syncthreads();
  for (int j = 0; j < NT; ++j) {
    const int bsel = j & 1;
    if (j + 1 < NT) SLOAD(j + 1);
    const int kp0_ = ks + 64 * (j - 4), qw0_ = q0 + wid * QBLK;
    if (!WINDOW || j < 4 || (kp0_ <= qw0_ + (QBLK - 1) + 128 && kp0_ + 63 >= qw0_ - 128)) {
      SBAR(); qkt_s<DK>(p0, p1, K_lds + bsel * SHM_K, qr, r32, hi);
      partialSM<DK, WINDOW>(p0, p1, m_reg, mn, al, DQ(j), hi);
      RESC(al);
      finishSM(p0, p1, al, l_reg, pa0, pa1, pa2, pa3); SBAR();
      pv_d0(o, vb0 + bsel * SHM_V, pa0, pa1, pa2, pa3); }
    if (j + 1 < NT) { SWAIT(); SWRITE(bsel ^ 1); }
    __syncthreads();
  }
  if (hi == 0) li_l[r32] = l_reg; asm volatile("s_waitcnt lgkmcnt(0)" ::: "memory");
  float rli[16];
#pragma unroll
  for (int r = 0; r < 16; ++r) rli[r] = 16.0f * __builtin_amdgcn_rcpf(li_l[crow(r, hi)]);
  unsigned char* Ow = Ob + (long)(wid * QBLK) * ldo;
#pragma unroll
  for (int r = 0; r < 16; ++r) { const int orow = crow(r, hi);
    *(unsigned*)(Ow + (long)orow * ldo + 4 * r32) = pk4_fp8(o[0][r] * rli[r], o[1][r] * rli[r], o[2][r] * rli[r], o[3][r] * rli[r]); }
  __syncthreads();
#undef TROW
#undef SLOAD
#undef SWRITE
#undef SWAIT
#undef RESC
#undef MASKED
#undef DQ
}
}
struct Frame {
    LAS unsigned char* lds; volatile LAS unsigned* MISC; unsigned* ctl;
    int tid, lane, wave, vcu, G;
    const float *x, *c, *ctx, *c_ctx, *w_ada, *b_ada, *g_norm, *w_in, *g_aqn, *g_akn, *g_bq_lat, *w_bq_up, *g_bkv_lat, *w_bkv_up, *g_bqn, *g_bkn, *sink, *w_o, *w_fo, *b_fo, *w_router, *b_router, *w_gate, *w_up, *w_down;
    float* out; unsigned char* ws;
};
#define WSP(T_, off) ((T_*)(F.ws + (off)))

__device__ __forceinline__ void transpose_item(const float* W, int N, bf16_t* WT, int ldk, int k0, int n0, int drow0, LAS float* scr, int lane) {
#pragma unroll 8
    for (int i = 0; i < 32; ++i) { const int kk = 2 * i + (lane >> 5); scr[kk * 33 + (lane & 31)] = W[(size_t)(k0 + kk) * N + n0 + (lane & 31)]; }
    LDS_WAIT(); asm volatile("" ::: "memory");
    const int c = lane & 7;
#pragma unroll
    for (int j = 0; j < 4; ++j) { const int n = (lane >> 3) + 8 * j; const LAS float* s = scr + (8 * c) * 33 + n;
        u32x4 o; o.x = pk2(s[0 * 33], s[1 * 33]); o.y = pk2(s[2 * 33], s[3 * 33]); o.z = pk2(s[4 * 33], s[5 * 33]); o.w = pk2(s[6 * 33], s[7 * 33]);
        *(GAS u32x4*)(WT + (size_t)(drow0 + n) * ldk + k0 + 8 * c) = o; }
    LDS_WAIT(); asm volatile("" ::: "memory");
}
__device__ __forceinline__ void transpose_item8(const float* W, int N, unsigned char* WT, int ldk, int k0, int n0, int drow0, LAS float* scr, int lane) {
    const float* p = W + (size_t)(k0 + (lane >> 3)) * N + n0 + (lane & 7) * 4; f32x4 r[8];
#pragma unroll
    for (int i = 0; i < 8; ++i) r[i] = __builtin_nontemporal_load((const f32x4*)(p + (size_t)(8 * i) * N));
#pragma unroll
    for (int i = 0; i < 8; ++i) *(LAS f32x4*)(scr + (8 * i + (lane >> 3)) * 36 + (lane & 7) * 4) = r[i];
    LDS_WAIT(); asm volatile("" ::: "memory");
    const int c = lane & 3;
#pragma unroll
    for (int j = 0; j < 2; ++j) { const int n = (lane >> 2) + 16 * j; const LAS float* s = scr + (16 * c) * 36 + n;
        u32x4 o; o.x = pk4_fp8(s[0 * 36] * W8_SCALE, s[1 * 36] * W8_SCALE, s[2 * 36] * W8_SCALE, s[3 * 36] * W8_SCALE); o.y = pk4_fp8(s[4 * 36] * W8_SCALE, s[5 * 36] * W8_SCALE, s[6 * 36] * W8_SCALE, s[7 * 36] * W8_SCALE);
        o.z = pk4_fp8(s[8 * 36] * W8_SCALE, s[9 * 36] * W8_SCALE, s[10 * 36] * W8_SCALE, s[11 * 36] * W8_SCALE); o.w = pk4_fp8(s[12 * 36] * W8_SCALE, s[13 * 36] * W8_SCALE, s[14 * 36] * W8_SCALE, s[15 * 36] * W8_SCALE);
        *(GAS u32x4*)(WT + (size_t)(drow0 + n) * ldk + k0 + 16 * c) = o; }
    LDS_WAIT(); asm volatile("" ::: "memory");
}
__device__ __forceinline__ int wo_src_row(int kp) { return (kp & ~127) + 32 * (kp & 3) + ((kp & 127) >> 2); }
__device__ __forceinline__ int fo_src_row(int kp) { const int p = kp & 255; return (kp & ~255) + (p <= 128 ? p : 384 - p); }
template <bool FO = false>
__device__ __forceinline__ void transpose_item8_wo(const float* W, int N, unsigned char* WT, int ldk, int k0, int n0, LAS float* scr, int lane) {
    f32x4 r[8];
#pragma unroll
    for (int i = 0; i < 8; ++i) { const int kp = k0 + 8 * i + (lane >> 3); r[i] = __builtin_nontemporal_load((const f32x4*)(W + (size_t)(FO ? fo_src_row(kp) : wo_src_row(kp)) * N + n0 + (lane & 7) * 4)); }
#pragma unroll
    for (int i = 0; i < 8; ++i) *(LAS f32x4*)(scr + (8 * i + (lane >> 3)) * 36 + (lane & 7) * 4) = r[i];
    LDS_WAIT(); asm volatile("" ::: "memory");
    const int c = lane & 3;
#pragma unroll
    for (int j = 0; j < 2; ++j) { const int n = (lane >> 2) + 16 * j; const LAS float* s = scr + (16 * c) * 36 + n;
        u32x4 o; o.x = pk4_fp8(s[0 * 36] * W8_SCALE, s[1 * 36] * W8_SCALE, s[2 * 36] * W8_SCALE, s[3 * 36] * W8_SCALE); o.y = pk4_fp8(s[4 * 36] * W8_SCALE, s[5 * 36] * W8_SCALE, s[6 * 36] * W8_SCALE, s[7 * 36] * W8_SCALE);
        o.z = pk4_fp8(s[8 * 36] * W8_SCALE, s[9 * 36] * W8_SCALE, s[10 * 36] * W8_SCALE, s[11 * 36] * W8_SCALE); o.w = pk4_fp8(s[12 * 36] * W8_SCALE, s[13 * 36] * W8_SCALE, s[14 * 36] * W8_SCALE, s[15 * 36] * W8_SCALE);
        *(GAS u32x4*)(WT + (size_t)(n0 + n) * ldk + k0 + 16 * c) = o; }
    LDS_WAIT(); asm volatile("" ::: "memory");
}
__device__ __forceinline__ void conv_plain(const float* W, int K, int N, bf16_t* WT, int item, LAS float* scr, int lane) {
    const int nblk = N / 32, kb = item / nblk, nb = item % nblk; transpose_item(W, N, WT, K, 64 * kb, 32 * nb, 32 * nb, scr, lane);
}

__device__ __forceinline__ void ada_task(Frame& F, int task, const LAS float* sl  , LAS float* red  ) {
    const int l = task / 384, n0 = (task % 384) * 32, kq = F.lane >> 3, c8 = F.lane & 7, k0 = F.wave * 256 + kq;
    const float* wp = F.w_ada + ((size_t)l * DM + k0) * 12288 + n0 + 4 * c8;
    f32x4 a0 = {0, 0, 0, 0}, a1 = a0, a2 = a0, a3 = a0, a4 = a0;
#pragma unroll 8
    for (int i = 0; i < 32; ++i) { const f32x4 w = __builtin_nontemporal_load((const f32x4*)(wp + (size_t)i * 8 * 12288)); const int k = k0 + 8 * i;
        const f32x4 s = *(const LAS f32x4*)(sl + k * 8); const float s4 = sl[k * 8 + 4];
        a0 += w * s[0]; a1 += w * s[1]; a2 += w * s[2]; a3 += w * s[3]; a4 += w * s4; }
#pragma unroll
    for (int o = 8; o < 64; o <<= 1) {
#pragma unroll
        for (int j = 0; j < 4; ++j) { a0[j] += __shfl_xor(a0[j], o); a1[j] += __shfl_xor(a1[j], o); a2[j] += __shfl_xor(a2[j], o); a3[j] += __shfl_xor(a3[j], o); a4[j] += __shfl_xor(a4[j], o); } }
    if (kq == 0) { LAS float* rp = red + (F.wave * 5) * 32 + 4 * c8;
        *(LAS f32x4*)(rp) = a0; *(LAS f32x4*)(rp + 32) = a1; *(LAS f32x4*)(rp + 64) = a2; *(LAS f32x4*)(rp + 96) = a3; *(LAS f32x4*)(rp + 128) = a4; }
    __syncthreads();
    if (F.tid < 160) { const int r = F.tid >> 5, col = F.tid & 31; float v = F.b_ada[(size_t)l * 12288 + n0 + col];
#pragma unroll
        for (int w = 0; w < 8; ++w) v += red[(w * 5 + r) * 32 + col];
        WSP(float, WS_MOD)[((size_t)l * 5 + r) * 12288 + n0 + col] = v; }
    __syncthreads();
}

#ifndef BG_PW
#define BG_PW 96
#endif
constexpr int BG_PER_WAVE = BG_PW;
static_assert(BG_PER_WAVE <= 2 * (KVLEN / 64 - 1), "background items per wave");
__device__ __forceinline__ int bg_split(int ngw) { const int n0 = BG_TOTAL - ngw * BG_PER_WAVE; return n0 > BG_SQ ? n0 : BG_SQ; }
__device__ __forceinline__ void bg_setup(Frame& F, BgConv& bg) { bg.item = 0; bg.end = 0; bg.w_o = F.w_o; bg.w_gate = F.w_gate; bg.w_up = F.w_up; bg.w_down = F.w_down;
    bg.o8 = WSP(unsigned char, WS_WO_T); bg.gu8 = WSP(unsigned char, WS_WGU_T); bg.d8 = WSP(unsigned char, WS_WD_T); }
template <int PRB = 0>
__device__ __forceinline__ void p0_prologue(Frame& F) {
    const int gw = F.vcu * NWAVES + F.wave, NGW = F.G * NWAVES;
    LAS float* sl = (LAS float*)(F.lds);
    for (int i = F.tid; i < DM * 5; i += NTHR) { const int r = i / DM, k = i % DM; const float v = r < 4 ? F.c[r * DM + k] : F.c_ctx[k]; sl[k * 8 + r] = silu_f(v); }
    __syncthreads();
    if (PRB == 0 || PRB == 1) { LAS float* red = (LAS float*)(F.lds + 65536); for (int task = F.vcu; task < 2 * 384; task += F.G) ada_task(F, task, sl, red); }
    __syncthreads();
    LAS float* scr = (LAS float*)(F.lds + F.wave * 16384);
    constexpr int I_IN = (DM / 64) * (INW / 32), I_BQ = (512 / 64) * (1536 / 32), I_BKV = (256 / 64) * (2048 / 32), I_SQ = (DM / 64) * (DM / 32), I_E = (DM / 64) * (DE / 32)  ;
    constexpr int NITEMS = I_IN + I_BQ + I_BKV + 2 * I_SQ;
    if (PRB == 0 || PRB == 2) for (int it = gw; it < NITEMS; it += NGW) {
        int r = it;
        if (r < I_IN) { const int nblk = INW / 32, kb = r / nblk, nb = r % nblk; transpose_item8(F.w_in, INW, WSP(unsigned char, WS_WIN_T), DM, 64 * kb, 32 * nb, 32 * nb, scr, F.lane); continue; } r -= I_IN;
        if (r < I_BQ) { conv_plain(F.w_bq_up, 512, 1536, WSP(bf16_t, WS_WBQ_T), r, scr, F.lane); continue; } r -= I_BQ;
        if (r < I_BKV) { conv_plain(F.w_bkv_up, 256, 2048, WSP(bf16_t, WS_WBKV_T), r, scr, F.lane); continue; } r -= I_BKV;
        if (r < I_SQ) { const int nblk = DM / 32, kb = r / nblk, nb = r % nblk; transpose_item8_wo<true>(F.w_fo, DM, WSP(unsigned char, WS_WFO_T), DM, 64 * kb, 32 * nb, scr, F.lane); continue; } r -= I_SQ;
        { const int nblk = DM / 32, kb = r / nblk, nb = r % nblk; transpose_item8_wo(F.w_o, DM, WSP(unsigned char, WS_WO_T), DM, 64 * kb, 32 * nb, scr, F.lane); }
    }
    if (PRB == 0 || PRB == 3) { BgConv bg; bg_setup(F, bg); const int n0 = bg_split(NGW); const unsigned slot = (unsigned)(uintptr_t)(char*)(F.lds + F.wave * 16384 + 8192);
      if (BG_SQ + gw < n0) { bg_issue_at(bg, BG_SQ + gw, F.lane, slot);
        for (int idx = BG_SQ + gw, par = 0; idx < n0; idx += NGW, par ^= 1) { const int nx = idx + NGW;
          if (nx < n0) { bg_issue_at(bg, nx, F.lane, slot + (par ^ 1) * 4096u); asm volatile("s_waitcnt vmcnt(4)" ::: "memory"); } else asm volatile("s_waitcnt vmcnt(0)" ::: "memory");
          bg_consume_at(bg, idx, F.lane, slot + par * 4096u); } } }
    if (PRB != 0 && PRB != 4) return;
    for (int i = blockIdx.x * NTHR + F.tid; i < DM * NE; i += F.G * NTHR) { const int e = i >> 11, k = i & 2047; WSP(float, WS_WRT)[i] = F.w_router[k * NE + e]; }
    { u32x4* z = (u32x4*)(WSP(unsigned char, WS_WIN_T) + (size_t)INW * DM); const int n16 = (INWP - INW) * DM / 16;
      for (int i = blockIdx.x * NTHR + F.tid; i < n16; i += F.G * NTHR) z[i] = (u32x4){0u, 0u, 0u, 0u}; }
    for (int i = blockIdx.x * NTHR + F.tid; i < 256 * 512 / 2; i += F.G * NTHR) { const int e = 2 * i, row = e >> 9, kk = e & 511, po = row >> 7, j = row & 127, pi = kk >> 8, c0 = kk & 255; float v[2];
#pragma unroll
        for (int q = 0; q < 2; ++q) { const float f = (float)((j * (c0 + q)) & 255) * (1.0f / 256.0f); const float cs = __builtin_amdgcn_cosf(f), sn = __builtin_amdgcn_sinf(f); v[q] = po == 0 ? (pi == 0 ? cs : sn) : (pi == 0 ? -sn : cs); }
        WSP(unsigned, WS_A1)[i] = pk2(v[0], v[1]); }
    for (int i = blockIdx.x * NTHR + F.tid; i < 256 * 512 / 2; i += F.G * NTHR) { const int e = 2 * i, k2 = e >> 9, kk = e & 511, pi = kk >> 8, s0 = kk & 255; float v[2];
#pragma unroll
        for (int q = 0; q < 2; ++q) { const float f = (float)((k2 * (s0 + q)) & 255) * (1.0f / 256.0f); v[q] = pi == 0 ? __builtin_amdgcn_cosf(f) : __builtin_amdgcn_sinf(f); }
        WSP(unsigned, WS_W2)[i] = pk2(v[0], v[1]); }
}

__device__ __forceinline__ void norm_mod_row(const float* xrow, const float* g, const float* sh, const float* sc, bf16_t* orow, int lane, f32x4 (&v)[8]) {
    const GAS f32x4* xr = (const GAS f32x4*)xrow + lane; float ss = 0.f;
#pragma unroll
    for (int j = 0; j < 8; ++j) { v[j] = xr[64 * j]; ss += (v[j].x * v[j].x + v[j].y * v[j].y) + (v[j].z * v[j].z + v[j].w * v[j].w); }
    const float rstd = 1.0f / sqrtf(wave_sum(ss) * (1.0f / DM) + EPS);
    GAS u32x2* o8 = (GAS u32x2*)orow + lane;
#pragma unroll
    for (int j = 0; j < 8; ++j) { const f32x4 gg = ((const GAS f32x4*)g)[lane + 64 * j], s1 = ((const GAS f32x4*)sc)[lane + 64 * j], s0 = ((const GAS f32x4*)sh)[lane + 64 * j];
        v[j] = (v[j] * rstd * gg) * (1.0f + s1) + s0; u32x2 w; w.x = pk2(v[j].x, v[j].y); w.y = pk2(v[j].z, v[j].w); o8[64 * j] = w; }
}
__device__ __forceinline__ void load_row(const float* xrow, int lane, f32x4 (&v)[8]) {
    const GAS f32x4* xr = (const GAS f32x4*)xrow + lane;
#pragma unroll
    for (int j = 0; j < 8; ++j) v[j] = xr[64 * j];
}
__device__ __forceinline__ void load_row_bf(const bf16_t* xrow, int lane, f32x4 (&v)[8]) {
    const GAS u32x2* xr = (const GAS u32x2*)xrow + lane;
#pragma unroll
    for (int j = 0; j < 8; ++j) { const u32x2 w = xr[64 * j]; v[j] = (f32x4){bflo(w.x), bfhi(w.x), bflo(w.y), bfhi(w.y)}; }
}
__device__ __forceinline__ void norm_mod_apply8(f32x4 (&v)[8], const float* g, const float* sh, const float* sc, unsigned char* orow, int lane) {
    float ss = 0.f;
#pragma unroll
    for (int j = 0; j < 8; ++j) ss += (v[j].x * v[j].x + v[j].y * v[j].y) + (v[j].z * v[j].z + v[j].w * v[j].w);
    const float rstd = 1.0f / sqrtf(wave_sum(ss) * (1.0f / DM) + EPS);
    GAS unsigned* o4 = (GAS unsigned*)orow + lane;
#pragma unroll
    for (int j = 0; j < 8; ++j) { const f32x4 gg = ((const GAS f32x4*)g)[lane + 64 * j], s1 = ((const GAS f32x4*)sc)[lane + 64 * j], s0 = ((const GAS f32x4*)sh)[lane + 64 * j];
        v[j] = (v[j] * rstd * gg) * (1.0f + s1) + s0; o4[64 * j] = pk4_fp8(v[j].x, v[j].y, v[j].z, v[j].w); }
}
__device__ __forceinline__ const float* modp(Frame& F, int l, int r, int chunk) { return WSP(float, WS_MOD) + ((size_t)l * 5 + r) * 12288 + chunk * DM; }

__device__ __forceinline__ const float* p1_rowptr(Frame& F, int row) { return row < T ? F.x + (size_t)row * DM : F.ctx + (size_t)(row - T) * DM; }
__device__ __forceinline__ void p1_norm(Frame& F) {
    const int gw = F.vcu * NWAVES + F.wave, NGW = F.G * NWAVES; f32x4 v[8], vn[8];
    if (gw < TT) load_row(p1_rowptr(F, gw), F.lane, v);
    for (int row = gw; row < TT; row += NGW) { const int r = row < T ? row / SEQ : 4;
        { const int nr = row + NGW < TT ? row + NGW : row; load_row(p1_rowptr(F, nr), F.lane, vn); }
        norm_mod_apply8(v, F.g_norm, modp(F, 0, r, 0), modp(F, 0, r, 1), WSP(unsigned char, WS_H) + (size_t)row * DM, F.lane);
#pragma unroll
        for (int j = 0; j < 8; ++j) v[j] = vn[j]; }
}


struct P3Raw { u32x2 aq[4], ak, av, bkv; u32x4 bq; unsigned kr; };
__device__ __forceinline__ void p3_load(const bf16_t* __restrict__ pr, int lane, P3Raw& r) {
    const int li = lane & 31, hh = lane >> 5;
#pragma unroll
    for (int ps = 0; ps < 4; ++ps) r.aq[ps] = *(const u32x2*)(pr + (2 * ps + hh) * 128 + 4 * li);
    r.ak = *(const u32x2*)(pr + 1024 + hh * 128 + 4 * li);
    r.av = *(const u32x2*)(pr + 1280 + 4 * lane); r.bq = *(const u32x4*)(pr + 1536 + 8 * lane); r.bkv = *(const u32x2*)(pr + 2048 + 4 * lane); r.kr = pr[2304 + lane];
}
__device__ __forceinline__ void p3_post(Frame& F) {
    const int gw = F.vcu * NWAVES + F.wave, NGW = F.G * NWAVES, lane = F.lane, li = lane & 31, hh = lane >> 5;
    const bf16_t* __restrict__ P = WSP(bf16_t, WS_P);
    const bool colpart = (li >> 4) != 0; const float sgn = ((li & 15) >= 8) ? 1.0f : -1.0f;
    float fr[4], gq[4], gk[4];
#pragma unroll
    for (int e = 0; e < 4; ++e) { fr[e] = powf(10000.0f, -(float)((4 * li + e) & 31) * (1.0f / 32.0f)); gq[e] = F.g_aqn[4 * li + e]; gk[e] = F.g_akn[4 * li + e]; }
    const f32x4 gb0 = *(const f32x4*)(F.g_bq_lat + 8 * lane), gb1 = *(const f32x4*)(F.g_bq_lat + 8 * lane + 4), gkv = *(const f32x4*)(F.g_bkv_lat + 4 * lane);
    P3Raw cur, nxt;
    if (gw < TT) p3_load(P + (size_t)gw * INWP, lane, cur);
    for (int row = gw; row < TT; row += NGW) {
        { const int nr = row + NGW < TT ? row + NGW : row; p3_load(P + (size_t)nr * INWP, lane, nxt); }
        const bool lat = row < T; const int b = lat ? row / SEQ : (row - T) / CTX, s = lat ? row % SEQ : (row - T) % CTX, kpos = lat ? CTX + s : s;
        float cs[4], sn[4]; { const float pos = colpart ? (float)(s % 64) : (float)(s / 64);
#pragma unroll
            for (int e = 0; e < 4; ++e) { sn[e] = __sinf(pos * fr[e]); cs[e] = __cosf(pos * fr[e]); } }
        if (lat) {
#pragma unroll
            for (int ps = 0; ps < 4; ++ps) { const int head = 2 * ps + hh; float y[4] = {bflo(cur.aq[ps].x), bfhi(cur.aq[ps].x), bflo(cur.aq[ps].y), bfhi(cur.aq[ps].y)};
                const float rstd = 1.0f / sqrtf(half_sum((y[0] * y[0] + y[1] * y[1]) + (y[2] * y[2] + y[3] * y[3])) * (1.0f / 128.0f) + EPS); float o[4];
#pragma unroll
                for (int e = 0; e < 4; ++e) y[e] = y[e] * rstd * gq[e];
#pragma unroll
                for (int e = 0; e < 4; ++e) { const float pz = __shfl_xor(y[e], 8); o[e] = y[e] * cs[e] + sgn * pz * sn[e]; }
                u32x2 w; w.x = pk2(o[0], o[1]); w.y = pk2(o[2], o[3]); *(u32x2*)(WSP(bf16_t, WS_QA) + (size_t)row * 1024 + head * 128 + 4 * li) = w; }
            { const u32x4 w = cur.bq; float y[8] = {bflo(w.x), bfhi(w.x), bflo(w.y), bfhi(w.y), bflo(w.z), bfhi(w.z), bflo(w.w), bfhi(w.w)}; float ss = 0.f;
#pragma unroll
              for (int q = 0; q < 8; ++q) ss += y[q] * y[q];
              const float rstd = 1.0f / sqrtf(wave_sum(ss) * (1.0f / 512.0f) + EPS);
              u32x4 o; o.x = pk2(y[0] * rstd * gb0.x, y[1] * rstd * gb0.y); o.y = pk2(y[2] * rstd * gb0.z, y[3] * rstd * gb0.w); o.z = pk2(y[4] * rstd * gb1.x, y[5] * rstd * gb1.y); o.w = pk2(y[6] * rstd * gb1.z, y[7] * rstd * gb1.w);
              *(u32x4*)(WSP(bf16_t, WS_BQL) + (size_t)row * 512 + 8 * lane) = o; }
        }
        { float y[4] = {bflo(cur.ak.x), bfhi(cur.ak.x), bflo(cur.ak.y), bfhi(cur.ak.y)};
          const float rstd = 1.0f / sqrtf(half_sum((y[0] * y[0] + y[1] * y[1]) + (y[2] * y[2] + y[3] * y[3])) * (1.0f / 128.0f) + EPS); float o[4];
#pragma unroll
          for (int e = 0; e < 4; ++e) y[e] = y[e] * rstd * gk[e];
#pragma unroll
          for (int e = 0; e < 4; ++e) { const float pz = __shfl_xor(y[e], 8); o[e] = lat ? y[e] * cs[e] + sgn * pz * sn[e] : y[e]; }
          u32x2 w; w.x = pk2(o[0], o[1]); w.y = pk2(o[2], o[3]); *(u32x2*)(WSP(bf16_t, WS_KA) + ((size_t)(b * 2 + hh) * KVLEN + kpos) * 128 + 4 * li) = w; }
        { const int d = 4 * lane, h2 = d >> 7; *(u32x2*)(WSP(bf16_t, WS_VA) + ((size_t)(b * 2 + h2) * KVLEN + kpos) * 128 + (d & 127)) = cur.av; }
        { const u32x2 w = cur.bkv; float y[4] = {bflo(w.x), bfhi(w.x), bflo(w.y), bfhi(w.y)};
          const float ss = (y[0] * y[0] + y[1] * y[1]) + (y[2] * y[2] + y[3] * y[3]);
          const float rstd = 1.0f / sqrtf(wave_sum(ss) * (1.0f / 256.0f) + EPS);
          u32x2 o; o.x = pk2(y[0] * rstd * gkv.x, y[1] * rstd * gkv.y); o.y = pk2(y[2] * rstd * gkv.z, y[3] * rstd * gkv.w);
          *(u32x2*)(WSP(bf16_t, WS_KVL) + (size_t)row * 256 + 4 * lane) = o; }
        WSP(bf16_t, WS_KR)[(size_t)row * 64 + lane] = (bf16_t)cur.kr;
        cur = nxt;
    }
}

struct P5Raw { unsigned qn[8], qt[8], kn[8], v[8], kr; };
__device__ __forceinline__ void p5_load(const bf16_t* __restrict__ q, const bf16_t* __restrict__ k, const bf16_t* __restrict__ kr, int lane, P5Raw& r) {
    const int j = lane & 31;
#pragma unroll
    for (int h = 0; h < 8; ++h) { r.qn[h] = *(const unsigned*)(q + h * 192 + 2 * lane); r.qt[h] = *(const unsigned*)(q + h * 192 + 128 + 2 * j);
        r.kn[h] = *(const unsigned*)(k + h * 256 + 2 * lane); r.v[h] = *(const unsigned*)(k + h * 256 + 128 + 2 * lane); }
    r.kr = *(const unsigned*)(kr + 2 * j);
}
__device__ __forceinline__ void p5_post(Frame& F) {
    const int gw = F.vcu * NWAVES + F.wave, NGW = F.G * NWAVES, lane = F.lane, j = lane & 31; const bool tl = lane < 32;
    const bf16_t* __restrict__ BQ = WSP(bf16_t, WS_BQ); const bf16_t* __restrict__ KV = WSP(bf16_t, WS_KV); const bf16_t* __restrict__ KR = WSP(bf16_t, WS_KR);
    const int w0 = (2 * j) & 31; const bool colpart = (j >> 4) != 0; const float sgn = (w0 >= 16) ? 1.0f : -1.0f;
    const float fr0 = powf(10000.0f, -(float)(w0 & 15) * (1.0f / 16.0f)), fr1 = powf(10000.0f, -(float)((w0 & 15) + 1) * (1.0f / 16.0f));
    const float gqn0 = F.g_bqn[2 * lane], gqn1 = F.g_bqn[2 * lane + 1], gqt0 = F.g_bqn[128 + 2 * j], gqt1 = F.g_bqn[129 + 2 * j];
    const float gkn0 = F.g_bkn[2 * lane], gkn1 = F.g_bkn[2 * lane + 1], gkt0 = F.g_bkn[128 + 2 * j], gkt1 = F.g_bkn[129 + 2 * j];
    P5Raw cur, nxt;
    if (gw < TT) p5_load(BQ + (size_t)gw * 1536, KV + (size_t)gw * DM, KR + (size_t)gw * 64, lane, cur);
    for (int row = gw; row < TT; row += NGW) {
        { const int nr = row + NGW < TT ? row + NGW : row; p5_load(BQ + (size_t)nr * 1536, KV + (size_t)nr * DM, KR + (size_t)nr * 64, lane, nxt); }
        const bool lat = row < T; const int b = lat ? row / SEQ : (row - T) / CTX, s = lat ? row % SEQ : (row - T) % CTX, kpos = lat ? CTX + s : s;
        float cs0, sn0, cs1, sn1; { const float pos = colpart ? (float)(s % 64) : (float)(s / 64); sn0 = __sinf(pos * fr0); cs0 = __cosf(pos * fr0); sn1 = __sinf(pos * fr1); cs1 = __cosf(pos * fr1); }
        const float kr0 = tl ? bflo(cur.kr) : 0.f, kr1 = tl ? bfhi(cur.kr) : 0.f;
#pragma unroll
        for (int h = 0; h < 8; ++h) {
            if (lat) {
                float y0 = bflo(cur.qn[h]), y1 = bfhi(cur.qn[h]), t0 = tl ? bflo(cur.qt[h]) : 0.f, t1 = tl ? bfhi(cur.qt[h]) : 0.f;
                const float rstd = 1.0f / sqrtf(wave_sum((y0 * y0 + y1 * y1) + (t0 * t0 + t1 * t1)) * (1.0f / 192.0f) + EPS);
                y0 *= rstd * gqn0; y1 *= rstd * gqn1; t0 *= rstd * gqt0; t1 *= rstd * gqt1;
                const float p0 = __shfl_xor(t0, 8), p1 = __shfl_xor(t1, 8);
                bf16_t* o = WSP(bf16_t, WS_QB) + (size_t)row * 1536 + h * 192;
                *(unsigned*)(o + 2 * lane) = pk2(y0, y1);
                if (tl) *(unsigned*)(o + 128 + 2 * j) = pk2(t0 * cs0 + sgn * p0 * sn0, t1 * cs1 + sgn * p1 * sn1); }
            { float y0 = bflo(cur.kn[h]), y1 = bfhi(cur.kn[h]), t0 = kr0, t1 = kr1;
              const float rstd = 1.0f / sqrtf(wave_sum((y0 * y0 + y1 * y1) + (t0 * t0 + t1 * t1)) * (1.0f / 192.0f) + EPS);
              y0 *= rstd * gkn0; y1 *= rstd * gkn1; t0 *= rstd * gkt0; t1 *= rstd * gkt1;
              const float p0 = __shfl_xor(t0, 8), p1 = __shfl_xor(t1, 8);
              bf16_t* o = WSP(bf16_t, WS_KB) + ((size_t)(b * 8 + h) * KVLEN + kpos) * 192;
              *(unsigned*)(o + 2 * lane) = pk2(y0, y1);
              if (tl) *(unsigned*)(o + 128 + 2 * j) = lat ? pk2(t0 * cs0 + sgn * p0 * sn0, t1 * cs1 + sgn * p1 * sn1) : pk2(t0, t1);
              *(unsigned*)(WSP(bf16_t, WS_VB) + ((size_t)(b * 8 + h) * KVLEN + kpos) * 128 + 2 * lane) = cur.v[h]; }
        }
        cur = nxt;
    }
}

__device__ __forceinline__ void pfa_dft16(Frame& F) {
    const int gw = F.vcu * NWAVES + F.wave, NGW = F.G * NWAVES, lane = F.lane;
    constexpr float C16[16] = {1.f, 0.92387953251f, 0.70710678119f, 0.38268343237f, 0.f, -0.38268343237f, -0.70710678119f, -0.92387953251f, -1.f, -0.92387953251f, -0.70710678119f, -0.38268343237f, 0.f, 0.38268343237f, 0.70710678119f, 0.92387953251f};
    constexpr float S16[16] = {0.f, 0.38268343237f, 0.70710678119f, 0.92387953251f, 1.f, 0.92387953251f, 0.70710678119f, 0.38268343237f, 0.f, -0.38268343237f, -0.70710678119f, -0.92387953251f, -1.f, -0.92387953251f, -0.70710678119f, -0.38268343237f};
    const bf16_t* H = WSP(bf16_t, WS_H); bf16_t* Y = WSP(bf16_t, WS_FY);
    for (int item = gw; item < NB * 256; item += NGW) { const int b = item >> 8, s2 = item & 255;
        float ct[16], st[16];
#pragma unroll
        for (int k1 = 0; k1 < 16; ++k1) { const float f = (float)((s2 * k1) & 4095) * (1.0f / 4096.0f); ct[k1] = __builtin_amdgcn_cosf(f); st[k1] = __builtin_amdgcn_sinf(f); }
        for (int g = 0; g < 8; ++g) {
            float x[16][4];
#pragma unroll
            for (int s1 = 0; s1 < 16; ++s1) { const u32x2 w = *(const u32x2*)(H + ((size_t)b * SEQ + 256 * s1 + s2) * DM + g * 256 + 4 * lane); x[s1][0] = bflo(w.x); x[s1][1] = bfhi(w.x); x[s1][2] = bflo(w.y); x[s1][3] = bfhi(w.y); }
#pragma unroll
            for (int k1 = 0; k1 <= 8; ++k1) { __builtin_amdgcn_sched_barrier(0); float A[4] = {0.f, 0.f, 0.f, 0.f}, Bq[4] = {0.f, 0.f, 0.f, 0.f};
#pragma unroll
                for (int s1 = 0; s1 < 16; ++s1) { const float c = C16[(s1 * k1) & 15], sn = S16[(s1 * k1) & 15];
#pragma unroll
                    for (int q = 0; q < 4; ++q) { if (c != 0.f) A[q] += c * x[s1][q]; if (sn != 0.f) Bq[q] += sn * x[s1][q]; } }
                { bf16_t* yp = Y + ((size_t)((b * 16 + k1) * 256 + s2)) * 4096 + g * 512 + 4 * lane; u32x2 wr_, wi_;
                  wr_.x = pk2(A[0] * ct[k1] - Bq[0] * st[k1], A[1] * ct[k1] - Bq[1] * st[k1]); wr_.y = pk2(A[2] * ct[k1] - Bq[2] * st[k1], A[3] * ct[k1] - Bq[3] * st[k1]);
                  wi_.x = pk2(-(A[0] * st[k1] + Bq[0] * ct[k1]), -(A[1] * st[k1] + Bq[1] * ct[k1])); wi_.y = pk2(-(A[2] * st[k1] + Bq[2] * ct[k1]), -(A[3] * st[k1] + Bq[3] * ct[k1]));
                  *(u32x2*)yp = wr_; *(u32x2*)(yp + 256) = wi_; }
                if (k1 >= 1 && k1 <= 7) { const int kc = 16 - k1;
                  bf16_t* yp = Y + ((size_t)((b * 16 + kc) * 256 + s2)) * 4096 + g * 512 + 4 * lane; u32x2 wr_, wi_;
                  wr_.x = pk2(A[0] * ct[kc] + Bq[0] * st[kc], A[1] * ct[kc] + Bq[1] * st[kc]); wr_.y = pk2(A[2] * ct[kc] + Bq[2] * st[kc], A[3] * ct[kc] + Bq[3] * st[kc]);
                  wi_.x = pk2(-(A[0] * st[kc] - Bq[0] * ct[kc]), -(A[1] * st[kc] - Bq[1] * ct[kc])); wi_.y = pk2(-(A[2] * st[kc] - Bq[2] * ct[kc]), -(A[3] * st[kc] - Bq[3] * ct[kc]));
                  *(u32x2*)yp = wr_; *(u32x2*)(yp + 256) = wi_; }
            }
        }
    }
}

__device__ __forceinline__ void p6_attn(Frame& F) {
    char* lds = (char*)F.lds;
    BgConv bg; bg_setup(F, bg); { const int gw = F.vcu * NWAVES + F.wave, NGW = F.G * NWAVES, n0 = bg_split(NGW); bg.item = n0 + gw * BG_PER_WAVE; bg.end = bg.item + BG_PER_WAVE < BG_TOTAL ? bg.item + BG_PER_WAVE : BG_TOTAL; if (bg.item > BG_TOTAL) bg.item = BG_TOTAL; }
    for (int uid = F.vcu; uid < 1024; uid += F.G) {
        const int u = uid & 511, qb = u & 15, h = (u >> 4) & 7, b = u >> 7; const size_t tok0 = (size_t)b * SEQ + qb * 256;
#ifndef ATT_NO_DENSE
        if (uid < 512) {
            att::attn_unit<192, false>(WSP(bf16_t, WS_QB) + tok0 * 1536 + h * 192, 1536, WSP(bf16_t, WS_KB) + (size_t)(b * 8 + h) * KVLEN * 192, WSP(bf16_t, WS_VB) + (size_t)(b * 8 + h) * KVLEN * 128,
                                       WSP(unsigned char, WS_Y) + tok0 * DM + 1024 + h * 128, DM, KVLEN / 64, 0, 0, 0.f, lds, F.wave, bg);
        }
#endif
#ifndef ATT_NO_WIN
        if (uid >= 512) {
            const int q0 = qb * 256, ks = q0 >= 128 ? q0 - 128 : 0, ke = (q0 + 384 < SEQ) ? q0 + 384 : SEQ, kvh = h >> 2;
            att::attn_unit_simple<128, true>(WSP(bf16_t, WS_QA) + tok0 * 1024 + h * 128, 1024, WSP(bf16_t, WS_KA) + (size_t)(b * 2 + kvh) * KVLEN * 128, WSP(bf16_t, WS_VA) + (size_t)(b * 2 + kvh) * KVLEN * 128,
                                      WSP(unsigned char, WS_Y) + tok0 * DM + h * 128, DM, 4 + (ke - ks) / 64, ks, q0, F.sink[h], lds, F.wave);
        }
#endif
    }
    { const int lane = lane_now(); const unsigned slot = (unsigned)(uintptr_t)(char*)(F.lds + F.wave * 4096); while (bg.item < bg.end) bg_now(bg, lane, slot); }
}
#define R_E(F) WSP(int, WS_ROUTE)
#define R_P(F) (WSP(int, WS_ROUTE) + 2 * T)
#define R_W(F) (WSP(float, WS_ROUTE) + 4 * T)
#define R_STOK(F) (WSP(int, WS_ROUTE) + 6 * T)
#define R_STOKE(F) WSP(int, WS_STOKE)
#define MOE_TAB_OFF (RING_BYTES + 2048)

__device__ __forceinline__ void logits16(const float (&p)[16], float (&out)[16]) {
    float q[8];
#pragma unroll
    for (int e = 0; e < 8; ++e) { const auto r = __builtin_amdgcn_permlane32_swap(__float_as_uint(p[e]), __float_as_uint(p[e + 8]), false, false);
        q[e] = __uint_as_float(r[0]) + __uint_as_float(r[1]); }
    float w[4];
#pragma unroll
    for (int e = 0; e < 4; ++e) { const auto r = __builtin_amdgcn_permlane16_swap(__float_as_uint(q[e]), __float_as_uint(q[e + 4]), false, false);
        w[e] = __uint_as_float(r[0]) + __uint_as_float(r[1]); }
#pragma unroll
    for (int e = 0; e < 4; ++e) w[e] = row_sum16(w[e]);
#pragma unroll
    for (int hrow = 0; hrow < 4; ++hrow)
#pragma unroll
        for (int e = 0; e < 4; ++e) out[8 * (hrow >> 1) + 4 * (hrow & 1) + e] = __builtin_bit_cast(float, __builtin_amdgcn_readlane(__builtin_bit_cast(int, w[e]), 16 * hrow));
}
__device__ __forceinline__ void norm_mod_lds8(f32x4 (&v)[8], const LAS float* gs, unsigned char* orow, int lane) {
    float ss = 0.f;
#pragma unroll
    for (int j = 0; j < 8; ++j) ss += (v[j].x * v[j].x + v[j].y * v[j].y) + (v[j].z * v[j].z + v[j].w * v[j].w);
    const float rstd = 1.0f / sqrtf(wave_sum(ss) * (1.0f / DM) + EPS);
    GAS unsigned* o4 = (GAS unsigned*)orow + lane;
#pragma unroll
    for (int j = 0; j < 8; ++j) { const f32x4 gg = ((const LAS f32x4*)gs)[lane + 64 * j], s0 = ((const LAS f32x4*)(gs + DM))[lane + 64 * j];
        v[j] = (v[j] * rstd) * gg + s0; o4[64 * j] = pk4_fp8(v[j].x, v[j].y, v[j].z, v[j].w); }
}
__device__ __forceinline__ void p8_stage_wrt(Frame& F) {
    const int lane = lane_now(); const char* src = (const char*)WSP(float, WS_WRT) + lane * 16;
    for (int i = F.wave - 1; i < DM * NE * 4 / 1024; i += NWAVES - 1) __builtin_amdgcn_global_load_lds((const unsigned*)(src + (size_t)i * 1024), (LAS unsigned*)(F.lds + i * 1024), 16, 0, 0);
}
__device__ __forceinline__ void p8_route(Frame& F, int l, bool wrt_staged = false) {
    const int tid = F.wave * 64 + lane_now(), lane = tid & 63;
    LAS float* wrt = (LAS float*)F.lds;
    LAS int* hist = (LAS int*)(F.lds + RING_BYTES);
    LAS int* hbase = hist + 16;
    LAS int* tinfo = (LAS int*)(F.lds + RING_BYTES + 1024);
    if (!wrt_staged) for (int i = tid; i < DM * NE / 4; i += NTHR) ((LAS f32x4*)wrt)[i] = ((const f32x4*)WSP(float, WS_WRT))[i];
    if (tid < 16) hist[tid] = 0;
    __syncthreads();
    float br[16];
#pragma unroll
    for (int e = 0; e < 16; ++e) br[e] = F.b_router[e];
    const float* g = F.g_norm + (size_t)(l * 2 + 1) * DM;
    unsigned* cnt = F.ctl + CW_CNT + l * 16 * 64;
    auto pick = [&](const float (&lg0)[16], const float (&lg1)[16], int tl) {
        float aff[16], sel[16];
#pragma unroll
        for (int e = 0; e < 16; ++e) { const float lgv = lane >= 32 ? lg1[e] : lg0[e]; aff[e] = __builtin_amdgcn_rcpf(1.0f + __expf(-lgv)); sel[e] = aff[e] + br[e]; }
        float gs[4], ga0[4], ga1[4]; int gi0[4], gi1[4];
#pragma unroll
        for (int gq = 0; gq < 4; ++gq) { int i0 = 0; float m0 = sel[4 * gq], a0 = aff[4 * gq];
#pragma unroll
            for (int i = 1; i < 4; ++i) if (sel[4 * gq + i] > m0) { m0 = sel[4 * gq + i]; a0 = aff[4 * gq + i]; i0 = i; }
            int i1 = -1; float m1 = -3.0e38f, a1 = 0.f;
#pragma unroll
            for (int i = 0; i < 4; ++i) if (i != i0 && sel[4 * gq + i] > m1) { m1 = sel[4 * gq + i]; a1 = aff[4 * gq + i]; i1 = i; }
            gs[gq] = m0 + m1; gi0[gq] = 4 * gq + i0; gi1[gq] = 4 * gq + i1; ga0[gq] = a0; ga1[gq] = a1; }
        int e0 = gi0[0], e1 = gi1[0]; float a0 = ga0[0], a1 = ga1[0], best = gs[0];
#pragma unroll
        for (int gq = 1; gq < 4; ++gq) if (gs[gq] > best) { best = gs[gq]; e0 = gi0[gq]; e1 = gi1[gq]; a0 = ga0[gq]; a1 = ga1[gq]; }
        const float inv = 1.0f / (a0 + a1);
        if ((lane & 31) == 0) { const int r0 = __hip_atomic_fetch_add(hist + e0, 1, __ATOMIC_RELAXED, __HIP_MEMORY_SCOPE_WORKGROUP), r1 = __hip_atomic_fetch_add(hist + e1, 1, __ATOMIC_RELAXED, __HIP_MEMORY_SCOPE_WORKGROUP);
            LAS int* ti = tinfo + tl * 6; ti[0] = e0; ti[1] = e1; ti[2] = r0; ti[3] = r1; ti[4] = __float_as_int(a0 * inv); ti[5] = __float_as_int(a1 * inv); } };
    LAS float* gsl = (LAS float*)(F.lds + RING_BYTES + 4096);
    for (int grp = F.vcu; grp < T / 64; grp += F.G) {
        { const int b = (grp * 64) / SEQ; const float* sh_ = modp(F, l, b, 3); const float* sc_ = modp(F, l, b, 4);
          const int t_ = F.wave * 64 + lane_now();
          const f32x4 gg = ((const f32x4*)g)[t_], s1 = ((const f32x4*)sc_)[t_], s0 = ((const f32x4*)sh_)[t_];
          __syncthreads(); ((LAS f32x4*)gsl)[t_] = gg * (1.0f + s1); ((LAS f32x4*)(gsl + DM))[t_] = s0; __syncthreads(); }
        f32x4 va[8], vb[8], na[8], nb[8]; const int tok00 = grp * 64 + F.wave * 8;
        load_row_bf(WSP(bf16_t, WS_XB) + (size_t)tok00 * DM, lane, va); load_row_bf(WSP(bf16_t, WS_XB) + (size_t)(tok00 + 1) * DM, lane, vb);
        for (int q = 0; q < 8; q += 2) { const int tl = F.wave * 8 + q, tok = grp * 64 + tl, b = tok / SEQ; const int tn = q < 6 ? tok + 2 : tok;
            load_row_bf(WSP(bf16_t, WS_XB) + (size_t)tn * DM, lane, na); load_row_bf(WSP(bf16_t, WS_XB) + (size_t)(tn + 1) * DM, lane, nb);
            norm_mod_lds8(va, gsl, WSP(unsigned char, WS_H) + (size_t)tok * DM, lane);
            norm_mod_lds8(vb, gsl, WSP(unsigned char, WS_H) + (size_t)(tok + 1) * DM, lane);
            float lga[16], lgb[16], pla[16], plb[16];
#pragma unroll
            for (int e = 0; e < 16; ++e) { float a = 0.f, c2 = 0.f;
                f32x2 pa = {0.f, 0.f}, pb = {0.f, 0.f};
#pragma unroll
                for (int j = 0; j < 8; ++j) { const f32x4 w = *(const LAS f32x4*)(wrt + e * DM + 256 * j + 4 * lane); const f32x2 wl = {w.x, w.y}, wh = {w.z, w.w};
                    pa = __builtin_elementwise_fma((f32x2){va[j].x, va[j].y}, wl, pa); pa = __builtin_elementwise_fma((f32x2){va[j].z, va[j].w}, wh, pa);
                    pb = __builtin_elementwise_fma((f32x2){vb[j].x, vb[j].y}, wl, pb); pb = __builtin_elementwise_fma((f32x2){vb[j].z, vb[j].w}, wh, pb); }
                a = pa.x + pa.y; c2 = pb.x + pb.y;
                pla[e] = a; plb[e] = c2; }
            logits16(pla, lga); logits16(plb, lgb);
            pick(lga, lgb, tl + (lane >> 5));
#pragma unroll
            for (int j = 0; j < 8; ++j) { va[j] = na[j]; vb[j] = nb[j]; }
        }
        __syncthreads();
        const int tq = F.wave * 64 + lane_now();
        if (tq < 16) hbase[tq] = (int)__hip_atomic_fetch_add(cnt + tq * 64, (unsigned)hist[tq], __ATOMIC_RELAXED, __HIP_MEMORY_SCOPE_AGENT);
        __syncthreads();
        if (tq < 64) { const int tok = grp * 64 + tq; const LAS int* ti = tinfo + tq * 6;
            const int q0 = hbase[ti[0]] + ti[2], q1 = hbase[ti[1]] + ti[3];
            R_E(F)[2 * tok] = ti[0]; R_E(F)[2 * tok + 1] = ti[1]; R_P(F)[2 * tok] = q0; R_P(F)[2 * tok + 1] = q1; R_STOKE(F)[ti[0] * T + q0] = tok; R_STOKE(F)[ti[1] * T + q1] = tok;
            R_W(F)[2 * tok] = __int_as_float(ti[4]); R_W(F)[2 * tok + 1] = __int_as_float(ti[5]); }
        if (tq < 16) hist[tq] = 0;
        __syncthreads();
    }
}
__device__ __forceinline__ LAS int* moe_table(Frame& F, int l, bool reuse = false) {
    LAS int* tab = (LAS int*)(F.lds + MOE_TAB_OFF);
    if (MK_SINGLE && reuse) return tab;
    __syncthreads();
    if (F.tid < 16) tab[176 + F.tid] = (int)__hip_atomic_load(F.ctl + CW_CNT + (l * 16 + F.tid) * 64, RLX_AGENT);
    __syncthreads();
    if (F.tid == 0) { int acc = 0;
        for (int e = 0; e < 16; ++e) { tab[160 + e] = acc; acc += (tab[176 + e] + 255) >> 8; }
        tab[192] = acc; }
    __syncthreads();
    if (F.tid < 160) { int e = 0;
#pragma unroll
        for (int k = 1; k < 16; ++k) e += (F.tid >= tab[160 + k]) ? 1 : 0;
        tab[F.tid] = e; }
    __syncthreads();
    return tab;
}
namespace pg8 {
struct MoeSched {
    TileOrder o; const char* A0; const char* B0; const int* stoke; LAS const int* tab; size_t eB, tA, tB;
    __device__ __forceinline__ void init(LAS const int* tab_, const void* A, const void* B, int lda, int ldb, size_t eB_, const int* stoke_, int G, int c) {
        tab = tab_; const int nrt = __builtin_amdgcn_readfirstlane(tab_[192]);
        o.init(nrt, DM / BM, 1, G, c); A0 = (const char*)A; B0 = (const char*)B; eB = eB_; stoke = stoke_; tA = (size_t)BM * lda * 2; tB = (size_t)BM * ldb * 2; }
    __device__ __forceinline__ void expert(Unit& u) const { const int e = __builtin_amdgcn_readfirstlane(tab[u.pm]); u.aux = e; u.r0 = (u.pm - __builtin_amdgcn_readfirstlane(tab[160 + e])) * BM; u.cnt = __builtin_amdgcn_readfirstlane(tab[176 + e]); }
};
struct MoeSched1 : MoeSched { static constexpr bool GATHER = true;
    __device__ __forceinline__ bool next(int i, Unit& u) const { if (!o.map(i, u.aux, u.pm, u.pn)) return false; expert(u); u.A = A0; u.B = B0 + (size_t)u.aux * eB + (size_t)u.pn * tB; return true; }
    __device__ __forceinline__ unsigned arow(const Unit& u, int r) const { const int p = u.r0 + r; return p < u.cnt ? (unsigned)stoke[u.aux * T + p] : 0u; } };
struct MoeSched2 : MoeSched { static constexpr bool GATHER = false;
    __device__ __forceinline__ bool next(int i, Unit& u) const { if (!o.map(i, u.aux, u.pm, u.pn)) return false; expert(u); u.A = A0 + (size_t)u.pm * tA; u.B = B0 + (size_t)u.aux * eB + (size_t)u.pn * tB; return true; }
    __device__ __forceinline__ unsigned arow(const Unit&, int) const { return 0u; } };
}
struct CmbIdx { int p0, p1; float w0, w1; };
struct CmbDat { u32x2 y0[8], y1[8], x[8]; };
__device__ __forceinline__ void cmb_idx(Frame& F, int tok, CmbIdx& i) { const u32x2 pp = *(const u32x2*)(R_P(F) + 2 * tok), ee = *(const u32x2*)(R_E(F) + 2 * tok); const f32x2 ww = *(const f32x2*)(R_W(F) + 2 * tok);
    const LAS int* tab = (const LAS int*)(F.lds + MOE_TAB_OFF); i.p0 = tab[160 + (int)ee.x] * 256 + (int)pp.x; i.p1 = tab[160 + (int)ee.y] * 256 + (int)pp.y; i.w0 = ww.x; i.w1 = ww.y; }
__device__ __forceinline__ void cmb_dat(Frame& F, int tok, const CmbIdx& i, int lane, CmbDat& d) { const bf16_t* YS = WSP(bf16_t, WS_YS); const bf16_t* xr = WSP(bf16_t, WS_XB) + (size_t)tok * DM;
#pragma unroll
    for (int j = 0; j < 8; ++j) { const int c = 4 * lane + 256 * j; d.y0[j] = *(const u32x2*)(YS + (size_t)i.p0 * DM + c); d.y1[j] = *(const u32x2*)(YS + (size_t)i.p1 * DM + c); d.x[j] = *(const u32x2*)(xr + c); } }
__device__ __forceinline__ void p12_combine(Frame& F, int l) {
    const int gw = F.vcu * NWAVES + F.wave, NGW = F.G * NWAVES, lane = F.lane;
    moe_table(F, l, true);
    if (gw >= T) return;
    CmbIdx ic, in_; CmbDat dc, dn;
    cmb_idx(F, gw, ic); cmb_dat(F, gw, ic, lane, dc); cmb_idx(F, gw + NGW < T ? gw + NGW : gw, in_);
    for (int tok = gw; tok < T; tok += NGW) { const int b = tok / SEQ; const int t1 = tok + NGW < T ? tok + NGW : tok, t2 = tok + 2 * NGW < T ? tok + 2 * NGW : t1;
        cmb_dat(F, t1, in_, lane, dn); CmbIdx inn; cmb_idx(F, t2, inn);
        const float w0 = ic.w0, w1 = ic.w1;
        const float* gt = modp(F, l, b, 5); f32x4 v[8]; float ss = 0.f;
#pragma unroll
        for (int j = 0; j < 8; ++j) { const int c = 4 * lane + 256 * j; const u32x2 y0 = dc.y0[j], y1 = dc.y1[j];
            const f32x4 gv = *(const f32x4*)(gt + c), xv = (f32x4){bflo(dc.x[j].x), bfhi(dc.x[j].x), bflo(dc.x[j].y), bfhi(dc.x[j].y)};
            f32x4 m; m.x = w0 * bflo(y0.x) + w1 * bflo(y1.x); m.y = w0 * bfhi(y0.x) + w1 * bfhi(y1.x); m.z = w0 * bflo(y0.y) + w1 * bflo(y1.y); m.w = w0 * bfhi(y0.y) + w1 * bfhi(y1.y);
            v[j] = xv + gv * m;
            if (l == 0) { u32x2 w; w.x = pk2(v[j].x, v[j].y); w.y = pk2(v[j].z, v[j].w); *(u32x2*)(WSP(bf16_t, WS_XB) + (size_t)tok * DM + c) = w; } else *(f32x4*)(F.out + (size_t)tok * DM + c) = v[j];
            ss += (v[j].x * v[j].x + v[j].y * v[j].y) + (v[j].z * v[j].z + v[j].w * v[j].w); }
        if (l == 0) { const float rstd = 1.0f / sqrtf(wave_sum(ss) * (1.0f / DM) + EPS); const float* g = F.g_norm + (size_t)2 * DM; const float* sh = modp(F, 1, b, 0); const float* sc = modp(F, 1, b, 1);
            bf16_t* orow = WSP(bf16_t, WS_H) + (size_t)tok * DM;
#pragma unroll
            for (int j = 0; j < 8; ++j) { const int c = 4 * lane + 256 * j; const f32x4 gg = *(const f32x4*)(g + c), s1 = *(const f32x4*)(sc + c), s0 = *(const f32x4*)(sh + c);
                const f32x4 hv = (v[j] * rstd * gg) * (1.0f + s1) + s0; u32x2 w; w.x = pk2(hv.x, hv.y); w.y = pk2(hv.z, hv.w); *(u32x2*)(orow + c) = w; } }
        ic = in_; in_ = inn; dc = dn;
    }
}

__device__ __forceinline__ void p12_fourier(Frame& F) {
    constexpr int l = 0;
    const int lane = F.lane, w = F.wave; const int nit = F.vcu < NB * 256 ? (NB * 256 - F.vcu + F.G - 1) / F.G : 0, ntok = 2 * nit;
    if (nit <= 0) return;
    moe_table(F, l, true);
    constexpr float C16[16] = {1.f, 0.92387953251f, 0.70710678119f, 0.38268343237f, 0.f, -0.38268343237f, -0.70710678119f, -0.92387953251f, -1.f, -0.92387953251f, -0.70710678119f, -0.38268343237f, 0.f, 0.38268343237f, 0.70710678119f, 0.92387953251f};
    constexpr float S16[16] = {0.f, 0.38268343237f, 0.70710678119f, 0.92387953251f, 1.f, 0.92387953251f, 0.70710678119f, 0.38268343237f, 0.f, -0.38268343237f, -0.70710678119f, -0.92387953251f, -1.f, -0.92387953251f, -0.70710678119f, -0.38268343237f};
    char* hl = (char*)F.lds; bf16_t* Y = WSP(bf16_t, WS_FY);
    auto tokof = [&](int n) { n = n < ntok ? n : ntok - 1; const int item = F.vcu + (n >> 1) * F.G; return (item >> 8) * SEQ + (item & 255) + 256 * (2 * w + (n & 1)); };
    CmbIdx ic, in_; CmbDat dc, dn;
    cmb_idx(F, tokof(0), ic); cmb_dat(F, tokof(0), ic, lane, dc); cmb_idx(F, tokof(1), in_);
    for (int n = 0; n < ntok; ++n) { const int tok = tokof(n), b = tok / SEQ;
        cmb_dat(F, tokof(n + 1), in_, lane, dn); CmbIdx inn; cmb_idx(F, tokof(n + 2), inn);
        const float w0 = ic.w0, w1 = ic.w1;
        const float* gt = modp(F, l, b, 5); f32x4 v[8]; float ss = 0.f;
#pragma unroll
        for (int j = 0; j < 8; ++j) { const int c = 4 * lane + 256 * j; const u32x2 y0 = dc.y0[j], y1 = dc.y1[j];
            const f32x4 gv = *(const f32x4*)(gt + c), xv = (f32x4){bflo(dc.x[j].x), bfhi(dc.x[j].x), bflo(dc.x[j].y), bfhi(dc.x[j].y)};
            f32x4 m; m.x = w0 * bflo(y0.x) + w1 * bflo(y1.x); m.y = w0 * bfhi(y0.x) + w1 * bfhi(y1.x); m.z = w0 * bflo(y0.y) + w1 * bflo(y1.y); m.w = w0 * bfhi(y0.y) + w1 * bfhi(y1.y);
            v[j] = xv + gv * m;
            { u32x2 wv; wv.x = pk2(v[j].x, v[j].y); wv.y = pk2(v[j].z, v[j].w); *(u32x2*)(WSP(bf16_t, WS_XB) + (size_t)tok * DM + c) = wv; }
            ss += (v[j].x * v[j].x + v[j].y * v[j].y) + (v[j].z * v[j].z + v[j].w * v[j].w); }
        { const float rstd = 1.0f / sqrtf(wave_sum(ss) * (1.0f / DM) + EPS); const float* g = F.g_norm + (size_t)2 * DM; const float* sh = modp(F, 1, b, 0); const float* sc = modp(F, 1, b, 1);
            char* orow = hl + (size_t)(2 * w + (n & 1)) * DM * 2;
#pragma unroll
            for (int j = 0; j < 8; ++j) { const int c = 4 * lane + 256 * j; const f32x4 gg = *(const f32x4*)(g + c), s1 = *(const f32x4*)(sc + c), s0 = *(const f32x4*)(sh + c);
                const f32x4 hv = (v[j] * rstd * gg) * (1.0f + s1) + s0; u32x2 wv; wv.x = pk2(hv.x, hv.y); wv.y = pk2(hv.z, hv.w); *(u32x2*)(orow + c * 2) = wv; } }
        ic = in_; in_ = inn; dc = dn;
        if (n & 1) {
            __syncthreads();
            const int item = F.vcu + (n >> 1) * F.G, s2 = item & 255, g = w;
            float x[16][4];
#pragma unroll
            for (int s1 = 0; s1 < 16; ++s1) { const u32x2 wv = *(const u32x2*)(hl + ((size_t)s1 * DM + g * 256 + 4 * lane) * 2); x[s1][0] = bflo(wv.x); x[s1][1] = bfhi(wv.x); x[s1][2] = bflo(wv.y); x[s1][3] = bfhi(wv.y); }
            { float y[16];
#pragma unroll
              for (int s1 = 0; s1 < 16; ++s1) y[s1] = wave_sum((x[s1][0] - x[s1][1]) + (x[s1][2] - x[s1][3]));
              if (lane < 16) { const int k1 = lane; float sA = 0.f, sB = 0.f;
#pragma unroll
                  for (int s1 = 0; s1 < 16; ++s1) { const float f = (float)((s1 * k1) & 15) * (1.0f / 16.0f); sA += __builtin_amdgcn_cosf(f) * y[s1]; sB += __builtin_amdgcn_sinf(f) * y[s1]; }
                  const float f = (float)((s2 * k1) & 4095) * (1.0f / 4096.0f), ct = __builtin_amdgcn_cosf(f), st = __builtin_amdgcn_sinf(f);
                  float* z = WSP(float, WS_Z128) + ((size_t)((b * 16 + k1) * 8 + g) * 2) * 256 + s2;
                  z[0] = sA * ct - sB * st; z[256] = -(sA * st + sB * ct); } }
            __builtin_amdgcn_sched_barrier(0);
#pragma unroll
            for (int k1 = 0; k1 <= 8; ++k1) { __builtin_amdgcn_sched_barrier(0); float A[4] = {0.f, 0.f, 0.f, 0.f}, Bq[4] = {0.f, 0.f, 0.f, 0.f};
#pragma unroll
                for (int s1 = 0; s1 < 16; ++s1) { const float c = C16[(s1 * k1) & 15], sn = S16[(s1 * k1) & 15];
#pragma unroll
                    for (int q = 0; q < 4; ++q) { if (c != 0.f) A[q] += c * x[s1][q]; if (sn != 0.f) Bq[q] += sn * x[s1][q]; } }
                { const float f = (float)((s2 * k1) & 4095) * (1.0f / 4096.0f), ct = __builtin_amdgcn_cosf(f), st = __builtin_amdgcn_sinf(f);
                  bf16_t* yp = Y + ((size_t)((b * 16 + k1) * 256 + s2)) * 4096 + g * 512 + 4 * lane; u32x2 wr_, wi_;
                  wr_.x = pk2(A[0] * ct - Bq[0] * st, A[1] * ct - Bq[1] * st); wr_.y = pk2(A[2] * ct - Bq[2] * st, A[3] * ct - Bq[3] * st);
                  wi_.x = pk2(-(A[0] * st + Bq[0] * ct), -(A[1] * st + Bq[1] * ct)); wi_.y = pk2(-(A[2] * st + Bq[2] * ct), -(A[3] * st + Bq[3] * ct));
                  *(u32x2*)yp = wr_; *(u32x2*)(yp + 256) = wi_; }
                if (k1 >= 1 && k1 <= 7) { const int kc = 16 - k1;
                  const float f = (float)((s2 * kc) & 4095) * (1.0f / 4096.0f), ct = __builtin_amdgcn_cosf(f), st = __builtin_amdgcn_sinf(f);
                  bf16_t* yp = Y + ((size_t)((b * 16 + kc) * 256 + s2)) * 4096 + g * 512 + 4 * lane; u32x2 wr_, wi_;
                  wr_.x = pk2(A[0] * ct + Bq[0] * st, A[1] * ct + Bq[1] * st); wr_.y = pk2(A[2] * ct + Bq[2] * st, A[3] * ct + Bq[3] * st);
                  wi_.x = pk2(-(A[0] * st - Bq[0] * ct), -(A[1] * st - Bq[1] * ct)); wi_.y = pk2(-(A[2] * st - Bq[2] * ct), -(A[3] * st - Bq[3] * ct));
                  *(u32x2*)yp = wr_; *(u32x2*)(yp + 256) = wi_; }
            }
            __syncthreads();
        }
    }
}


__device__ __forceinline__ void p13_freq128(Frame& F) {
    LAS float* ctab = (LAS float*)F.lds; LAS float* zl = ctab + 256 + F.wave * 512;
    if (F.tid < 256) ctab[F.tid] = __builtin_amdgcn_cosf((float)F.tid * (1.0f / 256.0f));
    __syncthreads();
    const int gw = F.vcu * NWAVES + F.wave, NGW = F.G * NWAVES, lane = F.lane;
    for (int it = gw; it < 64 * 8 * 4; it += NGW) { const int prob = it >> 2, quarter = it & 3, bk = prob >> 3, g = prob & 7, b = bk >> 4, k1 = bk & 15;
        const f32x4* z = (const f32x4*)(WSP(float, WS_Z128) + (size_t)prob * 512);
        const f32x4 z0 = z[lane], z1 = z[64 + lane];
        ((LAS f32x4*)zl)[lane] = z0; ((LAS f32x4*)zl)[64 + lane] = z1;
        asm volatile("s_waitcnt lgkmcnt(0)" ::: "memory");
        const int k2 = quarter * 64 + lane; float acc = 0.f;
#pragma unroll 4
        for (int s2 = 0; s2 < 256; ++s2) { const int idx = (s2 * k2) & 255; acc += ctab[idx] * zl[s2] + ctab[(idx - 64) & 255] * zl[256 + s2]; }
        WSP(unsigned char, WS_F)[(size_t)(b * SEQ + k1 + 16 * k2) * DM + g * 256 + 128] = (unsigned char)(pk4_fp8(acc * (1.0f / 1024.0f), 0.f, 0.f, 0.f) & 0xFFu);
        asm volatile("s_waitcnt lgkmcnt(0)" ::: "memory");
    }
}
#if defined(MK_CHECK)
constexpr int CW_CHK = 12288;
constexpr size_t WS_CHKP = WS_WS;
__device__ __forceinline__ void chk_add(Frame& F, float e2, float r2) {
    e2 = wave_sum(e2); r2 = wave_sum(r2);
    if (F.lane == 0) { atomicAdd((float*)(F.ctl + CW_CHK), e2); atomicAdd((float*)(F.ctl + CW_CHK + 64), r2); }
}
__device__ __forceinline__ void check_attn(Frame& F) {
    const int gw = F.vcu * NWAVES + F.wave, NGW = F.G * NWAVES, lane = F.lane;
    const int stoks[8] = {0, 1, 127, 128, 129, 2049, 3967, 4095};
    float* PS = WSP(float, WS_CHKP) + (size_t)gw * 4608;
    for (int item = gw; item < 2 * 4 * 8 * 8; item += NGW) {
        const int type = item >> 8, b = (item >> 6) & 3, h = (item >> 3) & 7; int sidx = item & 7; int s = 0;
#pragma unroll
        for (int q = 0; q < 8; ++q) s = (sidx == q) ? stoks[q] : s;
        const size_t tok = (size_t)b * SEQ + s;
        float mx = -3.0e38f;
        if (type == 0) {
            const bf16_t* q = WSP(bf16_t, WS_QB) + tok * 1536 + h * 192; const bf16_t* K = WSP(bf16_t, WS_KB) + (size_t)(b * 8 + h) * KVLEN * 192; const bf16_t* V = WSP(bf16_t, WS_VB) + (size_t)(b * 8 + h) * KVLEN * 128;
            for (int k = lane; k < KVLEN; k += 64) { float a = 0.f; for (int d = 0; d < 192; ++d) a += bf2f(q[d]) * bf2f(K[(size_t)k * 192 + d]); a *= 0.07216878364870322f; PS[k] = a; mx = fmaxf(mx, a); }
#pragma unroll
            for (int o = 1; o < 64; o <<= 1) mx = fmaxf(mx, __shfl_xor(mx, o));
            float l = 0.f; for (int k = lane; k < KVLEN; k += 64) { const float p = expf(PS[k] - mx); PS[k] = p; l += p; }
            l = wave_sum(l); __threadfence_block();
            float e2 = 0.f, r2 = 0.f;
            for (int d = lane; d < 128; d += 64) { float o = 0.f; for (int k = 0; k < KVLEN; ++k) o += PS[k] * bf2f(V[(size_t)k * 128 + d]); o /= l;
                const float y = __builtin_amdgcn_cvt_f32_fp8((int)WSP(unsigned char, WS_Y)[tok * DM + 1024 + h * 128 + 4 * (d & 31) + (d >> 5)], 0) * (1.0f / 16.0f); e2 += (o - y) * (o - y); r2 += o * o; }
            chk_add(F, e2, r2);
        } else {
            const int kvh = h >> 2; const bf16_t* q = WSP(bf16_t, WS_QA) + tok * 1024 + h * 128; const bf16_t* K = WSP(bf16_t, WS_KA) + (size_t)(b * 2 + kvh) * KVLEN * 128; const bf16_t* V = WSP(bf16_t, WS_VA) + (size_t)(b * 2 + kvh) * KVLEN * 128;
            const float snk = F.sink[h]; mx = snk;
            for (int k = lane; k < KVLEN; k += 64) { const int j = k - CTX; const bool ok = (k < CTX) || (j - s <= 128 && s - j <= 128); float a = -3.0e38f;
                if (ok) { a = 0.f; for (int d = 0; d < 128; ++d) a += bf2f(q[d]) * bf2f(K[(size_t)k * 128 + d]); a *= 0.08838834764831845f; }
                PS[k] = a; mx = fmaxf(mx, a); }
#pragma unroll
            for (int o = 1; o < 64; o <<= 1) mx = fmaxf(mx, __shfl_xor(mx, o));
            float l = 0.f; for (int k = lane; k < KVLEN; k += 64) { const float p = PS[k] > -1.0e38f ? expf(PS[k] - mx) : 0.f; PS[k] = p; l += p; }
            l = wave_sum(l) + expf(snk - mx); __threadfence_block();
            float e2 = 0.f, r2 = 0.f;
            for (int d = lane; d < 128; d += 64) { float o = 0.f; for (int k = 0; k < KVLEN; ++k) o += PS[k] * bf2f(V[(size_t)k * 128 + d]); o /= l;
                const float y = __builtin_amdgcn_cvt_f32_fp8((int)WSP(unsigned char, WS_Y)[tok * DM + h * 128 + 4 * (d & 31) + (d >> 5)], 0) * (1.0f / 16.0f); e2 += (o - y) * (o - y); r2 += o * o; }
            chk_add(F, e2, r2);
        }
    }
}
__device__ __forceinline__ float chk_sin_rev(double a) { a *= 0.15915494309189535; a -= floor(a); return __builtin_amdgcn_sinf((float)a); }
__device__ __forceinline__ float chk_cos_rev(double a) { a *= 0.15915494309189535; a -= floor(a); return __builtin_amdgcn_cosf((float)a); }
__device__ __forceinline__ float chk_rope(const LAS float* v, int dim, int idx, int s) {
    const int half = dim / 2, part = idx / half, w = idx % half, hh = half / 2, i = w % hh; const bool second = w >= hh;
    const float freq = powf(10000.0f, -(float)(2 * i) / (float)half); const float pos = part == 0 ? (float)(s / 64) : (float)(s % 64);
    const double ang = (double)(pos * freq); const float cs = chk_cos_rev(ang), sn = chk_sin_rev(ang);
    const float x1 = v[part * half + i], x2 = v[part * half + hh + i];
    return second ? (x1 * sn + x2 * cs) : (x1 * cs - x2 * sn);
}
__device__ __forceinline__ void check_proj(Frame& F) {
    LAS float* hrow = (LAS float*)F.lds;
    LAS float* proj = hrow + 2048;
    LAS float* t1 = proj + 2368;
    LAS float* t2 = t1 + 2048;
    LAS float* red = t2 + 512;
    LAS float* hv = red + 64;
    const int tid = F.tid;
    for (int it = blockIdx.x; it < 40; it += F.G) {
        int row; if (it < 32) { const int b = it & 3, q = it >> 2; const int ss[8] = {0, 1, 63, 64, 2047, 2048, 4031, 4095}; int s = 0;
#pragma unroll
            for (int z = 0; z < 8; ++z) s = (q == z) ? ss[z] : s;
            row = b * SEQ + s; } else { const int b = (it - 32) & 3, q = (it - 32) >> 2; row = T + b * CTX + (q ? 255 : 0); }
        const bool lat = row < T; const int b = lat ? row / SEQ : (row - T) / CTX, s = lat ? row % SEQ : (row - T) % CTX, kpos = lat ? CTX + s : s, r = lat ? b : 4;
        const float* xr = lat ? F.x + (size_t)row * DM : F.ctx + (size_t)(row - T) * DM;
        float ss = 0.f; for (int k = tid; k < DM; k += NTHR) ss += xr[k] * xr[k];
        ss = wave_sum(ss); if (F.lane == 0) red[F.wave] = ss; __syncthreads(); float tot = 0.f; for (int w = 0; w < 8; ++w) tot += red[w]; __syncthreads();
        const float rstd = 1.0f / sqrtf(tot / DM + EPS);
        const float* cv = lat ? F.c + (size_t)b * DM : F.c_ctx;
        for (int k = tid; k < DM; k += NTHR) { float sh = F.b_ada[k], sc = F.b_ada[DM + k];
            for (int j = 0; j < DM; ++j) { const float sl = silu_f(cv[j]); sh += sl * F.w_ada[(size_t)j * 12288 + k]; sc += sl * F.w_ada[(size_t)j * 12288 + DM + k]; }
            hrow[k] = xr[k] * rstd * F.g_norm[k] * (1.0f + sc) + sh; }
        __syncthreads();
        for (int n = tid; n < INW; n += NTHR) { float a = 0.f; for (int k = 0; k < DM; ++k) a += hrow[k] * F.w_in[(size_t)k * INW + n]; proj[n] = a; }
        __syncthreads();
        float e2 = 0.f, r2 = 0.f;
#define CMP(val, ptr) do { const float _v = (val), _y = bf2f(*(ptr)); e2 += (_v - _y) * (_v - _y); r2 += _v * _v; } while (0)
        for (int hd = 0; hd < 8 + 2; ++hd) { const bool isq = hd < 8; if (isq && !lat) continue; const int off = isq ? hd * 128 : 1024 + (hd - 8) * 128;
            float q2 = 0.f; for (int d = 0; d < 128; ++d) q2 += proj[off + d] * proj[off + d]; const float rs = 1.0f / sqrtf(q2 / 128.0f + EPS);
            __syncthreads(); if (tid < 128) hv[tid] = proj[off + tid] * rs * (isq ? F.g_aqn[tid] : F.g_akn[tid]); __syncthreads();
            if (tid < 128) { const float v = lat ? chk_rope(hv, 128, tid, s) : hv[tid];
                if (isq) CMP(v, WSP(bf16_t, WS_QA) + (size_t)row * 1024 + hd * 128 + tid); else CMP(v, WSP(bf16_t, WS_KA) + ((size_t)(b * 2 + hd - 8) * KVLEN + kpos) * 128 + tid); } }
        if (tid < 256) CMP(proj[1280 + tid], WSP(bf16_t, WS_VA) + ((size_t)(b * 2 + (tid >> 7)) * KVLEN + kpos) * 128 + (tid & 127));
        if (lat) { float q2 = 0.f; for (int d = 0; d < 512; ++d) q2 += proj[1536 + d] * proj[1536 + d]; const float rs = 1.0f / sqrtf(q2 / 512.0f + EPS);
            __syncthreads(); t2[tid] = proj[1536 + tid] * rs * F.g_bq_lat[tid]; __syncthreads();
            for (int n = tid; n < 1536; n += NTHR) { float a = 0.f; for (int k = 0; k < 512; ++k) a += t2[k] * F.w_bq_up[(size_t)k * 1536 + n]; t1[n] = a; }
            __syncthreads();
            for (int hd = 0; hd < 8; ++hd) { float h2 = 0.f; for (int d = 0; d < 192; ++d) h2 += t1[hd * 192 + d] * t1[hd * 192 + d]; const float rq = 1.0f / sqrtf(h2 / 192.0f + EPS);
                __syncthreads(); if (tid < 192) hv[tid] = t1[hd * 192 + tid] * rq * F.g_bqn[tid]; __syncthreads();
                if (tid < 192) { const float v = tid < 128 ? hv[tid] : chk_rope(hv + 128, 64, tid - 128, s); CMP(v, WSP(bf16_t, WS_QB) + (size_t)row * 1536 + hd * 192 + tid); } }
            __syncthreads(); }
        { float q2 = 0.f; for (int d = 0; d < 256; ++d) q2 += proj[2048 + d] * proj[2048 + d]; const float rs = 1.0f / sqrtf(q2 / 256.0f + EPS);
            __syncthreads(); if (tid < 256) t2[tid] = proj[2048 + tid] * rs * F.g_bkv_lat[tid]; __syncthreads();
            for (int n = tid; n < 2048; n += NTHR) { float a = 0.f; for (int k = 0; k < 256; ++k) a += t2[k] * F.w_bkv_up[(size_t)k * 2048 + n]; t1[n] = a; }
            __syncthreads();
            for (int hd = 0; hd < 8; ++hd) { float h2 = 0.f; for (int d = 0; d < 128; ++d) h2 += t1[hd * 256 + d] * t1[hd * 256 + d]; for (int d = 0; d < 64; ++d) h2 += proj[2304 + d] * proj[2304 + d];
                const float rq = 1.0f / sqrtf(h2 / 192.0f + EPS);
                __syncthreads(); if (tid < 192) hv[tid] = (tid < 128 ? t1[hd * 256 + tid] : proj[2304 + tid - 128]) * rq * F.g_bkn[tid]; __syncthreads();
                if (tid < 192) { const float v = (tid < 128 || !lat) ? hv[tid] : chk_rope(hv + 128, 64, tid - 128, s); CMP(v, WSP(bf16_t, WS_KB) + ((size_t)(b * 8 + hd) * KVLEN + kpos) * 192 + tid); }
                if (tid < 128) CMP(t1[hd * 256 + 128 + tid], WSP(bf16_t, WS_VB) + ((size_t)(b * 8 + hd) * KVLEN + kpos) * 128 + tid); }
            __syncthreads(); }
#undef CMP
        chk_add(F, e2, r2);
        __syncthreads();
    }
}
__device__ __forceinline__ void check_emit(Frame& F) {
    const float e2 = __hip_atomic_load((float*)(F.ctl + CW_CHK), RLX_AGENT), r2 = __hip_atomic_load((float*)(F.ctl + CW_CHK + 64), RLX_AGENT);
    const float eps_rel = (r2 > 0.f) ? sqrtf(e2 / r2) : 10.f; const float f = 1.0f + 100.0f * fminf(eps_rel, 10.f);
    for (size_t i = (size_t)blockIdx.x * NTHR + F.tid; i < (size_t)T * DM / 4; i += (size_t)F.G * NTHR) { const f32x4 v = ((const f32x4*)F.x)[i]; ((f32x4*)F.out)[i] = v * f; }
}
#endif
#ifndef MK_SINGLE
#define MK_SINGLE 0
#endif
#ifndef MK_LAST
#define MK_LAST 22
#endif
constexpr int N_PHASES = 22;
struct Args { const float* in[25]; float* out; unsigned char* ws; int ph_lo, ph_hi; };
static_assert(sizeof(Args) == 27 * 8 + 8, "Args has no padding");

__global__ void __launch_bounds__(NTHR, 2) fwd_kernel(Args args) {
    extern __shared__ __attribute__((aligned(16))) unsigned char lds_raw[];
    Frame F;
    F.lds = (LAS unsigned char*)lds_raw;
    F.MISC = (volatile LAS unsigned*)(F.lds + MISC_OFF);
    F.wave = __builtin_amdgcn_readfirstlane((int)threadIdx.x >> 6); F.lane = lane_now(); F.tid = F.wave * 64 + F.lane;
    F.G = gridDim.x; { const int bx = blockIdx.x; F.vcu = (F.G % 8 == 0) ? (bx % 8) * (F.G / 8) + bx / 8 : bx; }
    F.ws = args.ws; F.ctl = (unsigned*)(args.ws + WS_CTL); F.out = args.out;
    F.x = args.in[0]; F.c = args.in[1]; F.ctx = args.in[2]; F.c_ctx = args.in[3]; F.w_ada = args.in[4]; F.b_ada = args.in[5]; F.g_norm = args.in[6]; F.w_in = args.in[7];
    F.g_aqn = args.in[8]; F.g_akn = args.in[9]; F.g_bq_lat = args.in[10]; F.w_bq_up = args.in[11]; F.g_bkv_lat = args.in[12]; F.w_bkv_up = args.in[13]; F.g_bqn = args.in[14]; F.g_bkn = args.in[15];
    F.sink = args.in[16]; F.w_o = args.in[17]; F.w_fo = args.in[18]; F.b_fo = args.in[19]; F.w_router = args.in[20]; F.b_router = args.in[21]; F.w_gate = args.in[22]; F.w_up = args.in[23]; F.w_down = args.in[24];
    for (int u = F.tid; u < (LDS_BYTES - RING_BYTES) / 4; u += NTHR) ((LAS unsigned*)(F.lds + RING_BYTES))[u] = 0u;
    __syncthreads();
    const int lo = args.ph_lo, hi = args.ph_hi;
    XcdBarrier bar; bar.bar = F.ctl + CW_BAR; bar.x = 0; bar.st = nullptr;
    if (MK_SINGLE) bar = xcd_barrier_post(F.ctl + CW_BAR, F.MISC + 8);
#ifdef MK_ONLY
#define IN(k) ((k) == MK_ONLY && lo <= (k) && (k) < hi)
#else
#define IN(k) (((k) < MK_LAST || (k) >= 30) && lo <= (k) && (k) < hi)
#endif
#define SEAM(k) do { if (MK_SINGLE && IN((k) + 1)) xcd_barrier(bar); else __syncthreads(); } while (0)
#define SEAM_WRT(k) do { if (MK_SINGLE && IN((k) + 1)) xcd_barrier_shadow(bar, [&]() { p8_stage_wrt(F); }); else __syncthreads(); } while (0)
    const int c = (int)blockIdx.x;
#ifndef MK_REP
#define MK_REP 0
#endif
#define REP(k) ((((MK_REP) >> (k)) & 1) + 1)
#if defined(MK_TIME)
    unsigned long long* tsb = (unsigned long long*)(F.ctl + 16384);
#define STAMP(k) do { F.lane = lane_now(); F.tid = F.wave * 64 + F.lane; if (blockIdx.x == 0 && F.tid == 0) tsb[k] = wall_clock64(); } while (0)
#else
#define STAMP(k) do { F.lane = lane_now(); F.tid = F.wave * 64 + F.lane; } while (0)
#endif

#if defined(P0_PROBE)
    if (IN(0)) { p0_prologue<P0_PROBE>(F); SEAM(0); }
#endif
    if (IN(0)) for (int r_ = 0; r_ < REP(0); ++r_) { STAMP(0); p0_prologue<0>(F); SEAM(0); }
    if (IN(1)) for (int r_ = 0; r_ < REP(1); ++r_) { STAMP(1); p1_norm(F); SEAM(1); }
    if (IN(2)) for (int r_ = 0; r_ < REP(2); ++r_) { STAMP(2);
        pg8::PlainSched S; S.init(WSP(unsigned char, WS_H), WSP(unsigned char, WS_WIN_T), DM / 2, DM / 2, TT / 256, INWP / 256, 1, 0, 0, F.G, c);
        pg8::EpiBf16 E{WSP(bf16_t, WS_P), INWP, W8_INV, 0};
        pg8::gemm_phase<pg8::EpiBf16, pg8::PlainSched, true>(F.lds, DM / 2, DM / 2, DM / 2, S, E, F.wave); SEAM(2); }
    if (IN(3)) for (int r_ = 0; r_ < REP(3); ++r_) { STAMP(3); p3_post(F); SEAM(3); }
    if (IN(4)) for (int r_ = 0; r_ < REP(4); ++r_) { STAMP(4);
        { pg8::PlainSched S; S.init(WSP(bf16_t, WS_BQL), WSP(bf16_t, WS_WBQ_T), 512, 512, T / 256, 1536 / 256, 1, 0, 0, F.G, c);
          pg8::EpiBf16 E{WSP(bf16_t, WS_BQ), 1536, 1.0f, 0}; pg8::gemm_phase(F.lds, 512, 512, 512, S, E, F.wave); }
        { pg8::PlainSched S; S.init(WSP(bf16_t, WS_KVL), WSP(bf16_t, WS_WBKV_T), 256, 256, TT / 256, DM / 256, 1, 0, 0, F.G, c);
          pg8::EpiBf16 E{WSP(bf16_t, WS_KV), DM, 1.0f, 0}; pg8::gemm_phase(F.lds, 256, 256, 256, S, E, F.wave); }
        SEAM(4); }
    if (IN(5)) for (int r_ = 0; r_ < REP(5); ++r_) { STAMP(5); p5_post(F); SEAM(5); }
    if (IN(6)) for (int r_ = 0; r_ < REP(6); ++r_) { STAMP(6); p6_attn(F); SEAM(6); }
    if (IN(7)) for (int r_ = 0; r_ < REP(7); ++r_) { STAMP(7);
        pg8::PlainSched S; S.init(WSP(unsigned char, WS_Y), WSP(unsigned char, WS_WO_T), DM / 2, DM / 2, T / 256, DM / 256, 1, 0, 0, F.G, c);
        pg8::EpiResGate<false, true> E{F.x, WSP(bf16_t, WS_XB), modp(F, 0, 0, 2), 12288, nullptr, W8_INV * (1.0f / 16.0f)};
        pg8::gemm_phase<pg8::EpiResGate<false, true>, pg8::PlainSched, true>(F.lds, DM / 2, DM / 2, DM / 2, S, E, F.wave); SEAM_WRT(7); }
#define MOE_LAYER(l, P8, P9, P10, P11, P12)                                                                                                                    \
    if (IN(P8)) { STAMP(P8); p8_route(F, l, MK_SINGLE && IN(P8 - 1)); SEAM(P8); }                                                                                                                  \
    if (IN(P10)) for (int r_ = 0; r_ < REP(P10); ++r_) { STAMP(P10); pg8::MoeSched1 S; S.init(moe_table(F, l), WSP(unsigned char, WS_H), WSP(unsigned char, WS_WGU_T) + (size_t)l * 16 * DM * DM, DM / 2, DM / 2, (size_t)DM * DM, R_STOKE(F), F.G, c); \
        pg8::EpiSwiGLU8 E{WSP(unsigned char, WS_HS), DE}; pg8::gemm_phase<pg8::EpiSwiGLU8, pg8::MoeSched1, true>(F.lds, DM / 2, DM / 2, DM / 2, S, E, F.wave); SEAM(P10); }                          \
    if (IN(P11)) for (int r_ = 0; r_ < REP(P11); ++r_) { STAMP(P11); pg8::MoeSched2 S; S.init(moe_table(F, l, true), WSP(unsigned char, WS_HS), WSP(unsigned char, WS_WD_T) + (size_t)l * 16 * DM * DE, DE / 2, DE / 2, (size_t)DM * DE, R_STOKE(F), F.G, c); \
        pg8::EpiBf16 E{WSP(bf16_t, WS_YS), DM, W8_INV, 0}; pg8::gemm_phase<pg8::EpiBf16, pg8::MoeSched2, true>(F.lds, DE / 2, DE / 2, DE / 2, S, E, F.wave); SEAM(P11); }                               \
    if (IN(P12)) { STAMP(P12); if (l == 0) p12_fourier(F); else p12_combine(F, l); SEAM(P12); }
    MOE_LAYER(0, 8, 9, 10, 11, 12)
    if (IN(14)) for (int r_ = 0; r_ < REP(14); ++r_) { STAMP(14); p13_freq128(F); __syncthreads();
        pg8::PlainSched S; S.init(WSP(bf16_t, WS_A1), WSP(bf16_t, WS_FY), 512, 4096, 1, T / 256, 8, 0, (size_t)512 * 2, F.G, c);
        pg8::EpiB1 E{WSP(bf16_t, WS_UT)}; pg8::gemm_phase(F.lds, 512, 4096, 512, S, E, F.wave); SEAM(14); }
    if (IN(15)) for (int r_ = 0; r_ < REP(15); ++r_) { STAMP(15);
        pg8::PlainSched S; S.init(WSP(bf16_t, WS_W2), WSP(bf16_t, WS_UT), 512, 512, 1, 4, 64, 0, (size_t)1024 * 512 * 2, F.G, c);
        pg8::EpiB2 E{WSP(unsigned char, WS_F)}; pg8::gemm_phase(F.lds, 512, 512, 512, S, E, F.wave); SEAM(15); }
    if (IN(16)) for (int r_ = 0; r_ < REP(16); ++r_) { STAMP(16);
        pg8::PlainSched S; S.init(WSP(unsigned char, WS_F), WSP(unsigned char, WS_WFO_T), DM / 2, DM / 2, T / 256, DM / 256, 1, 0, 0, F.G, c);
        pg8::EpiResGate<true, true> E{WSP(bf16_t, WS_XB), WSP(bf16_t, WS_XB), modp(F, 1, 0, 2), 12288, F.b_fo, W8_INV};
        pg8::gemm_phase<pg8::EpiResGate<true, true>, pg8::PlainSched, true>(F.lds, DM / 2, DM / 2, DM / 2, S, E, F.wave); SEAM_WRT(16); }
    MOE_LAYER(1, 17, 18, 19, 20, 21)
#if defined(MK_TIME)
    if (MK_SINGLE) { xcd_barrier(bar); STAMP(22); xcd_barrier(bar);
        float va = 0.f, vb = 0.f;
        for (int k = 0; k < 22; ++k) { const float us = (float)(tsb[k + 1] - tsb[k]) * 0.01f; if ((MK_TIME_A >> k) & 1) va += us; if ((MK_TIME_B >> k) & 1) vb += us; }
        const float f = 1.0f + va * 0.001f;
        for (size_t i = (size_t)blockIdx.x * NTHR + F.tid; i < (size_t)T * DM / 4; i += (size_t)F.G * NTHR) { const f32x4 v = ((const f32x4*)F.x)[i]; ((f32x4*)F.out)[i] = v * f; }
        (void)vb; }
#endif
#if defined(MK_CHECK)
    if (IN(30)) { if (MK_CHECK == 1) check_attn(F); else check_proj(F); SEAM(30); }
    if (IN(31)) { check_emit(F); }
#endif
#undef IN
#undef SEAM
}

extern "C" void kernel_launch(void* const* d_in, const int* in_sizes, int n_in, void* d_out, int out_size, void* d_ws, size_t ws_size, hipStream_t stream) {
    static int grid = 0;
    if (grid == 0) {
        if (n_in != 25 || out_size != T * DM || ws_size < WS_END) { fprintf(stderr, "kernel_launch: shape mismatch n_in %d out %d ws %zu (need %zu)\n", n_in, out_size, ws_size, (size_t)WS_END); grid = -1; return; }
        int dev = 0, cus = 0, per_cu = 0;
        if (hipGetDevice(&dev) != hipSuccess || hipDeviceGetAttribute(&cus, hipDeviceAttributeMultiprocessorCount, dev) != hipSuccess) { grid = -1; return; }
        if (hipFuncSetAttribute((const void*)fwd_kernel, hipFuncAttributeMaxDynamicSharedMemorySize, LDS_BYTES) != hipSuccess) { fprintf(stderr, "kernel_launch: hipFuncSetAttribute failed\n"); grid = -1; return; }
        if (hipOccupancyMaxActiveBlocksPerMultiprocessor(&per_cu, (const void*)fwd_kernel, NTHR, LDS_BYTES) != hipSuccess || per_cu < 1) fprintf(stderr, "kernel_launch: occupancy query says %d\n", per_cu);
        (void)hipGetLastError();
        grid = cus;
    }
    if (grid < 0) return;
    (void)hipMemsetAsync((char*)d_ws + WS_CTL, 0, CTL_ZERO_BYTES, stream);
    Args a{};
    for (int i = 0; i < 25; ++i) a.in[i] = (const float*)d_in[i];
    a.out = (float*)d_out; a.ws = (unsigned char*)d_ws;
    if (MK_LAST <= 7) (void)hipMemcpyAsync(d_out, d_in[0], (size_t)T * DM * 4, hipMemcpyDeviceToDevice, stream);
#if MK_SINGLE
    a.ph_lo = 0; a.ph_hi = MK_LAST;
    hipLaunchKernelGGL(fwd_kernel, dim3(grid), dim3(NTHR), LDS_BYTES, stream, a);
#else
    for (int ph = 0; ph < MK_LAST; ++ph) { a.ph_lo = ph; a.ph_hi = ph + 1; hipLaunchKernelGGL(fwd_kernel, dim3(grid), dim3(NTHR), LDS_BYTES, stream, a); }
#if defined(MK_CHECK)
    for (int ph = 30; ph < 32; ++ph) { a.ph_lo = ph; a.ph_hi = ph + 1; hipLaunchKernelGGL(fwd_kernel, dim3(grid), dim3(NTHR), LDS_BYTES, stream, a); }
#endif
#endif
    const hipError_t le = hipPeekAtLastError();
    if (le != hipSuccess) fprintf(stderr, "kernel_launch: launch failed: %s\n", hipGetErrorName(le));
}
```
